# Optimizing an MI355X kernel written in HIP

```python
import jax, jax.numpy as jnp
from jax import lax
import numpy as np

D_MODEL = 1024
BATCH = 8
SEQ = 2048
DEPTH = 2

N_MIXERS = 2
N_MLA_LAYERS = (DEPTH + 1) // 2
N_SB_LAYERS = DEPTH // 2
BLOCK_Q = 128
EPS = 1e-6
MLA_HEADS = 8
MLA_Q_LORA = 384
MLA_KV_LORA = 256
MLA_NOPE = 128
MLA_ROPE = 64
MLA_V = 128
ROPE_THETA = 10000.0
POS_OFFSET_MAX = 4096
SB_HEADS = 8
SB_HEAD_DIM = D_MODEL // SB_HEADS
MEM_LEN = 256
MEM_HEADS = 4
MEM_HEAD_DIM = 128
D_FF = 4 * D_MODEL

kernel_name = "hybrid_mla_stickbreaking_memxattn_sqrelu"

NEG_BIG = -1e30


def rmsnorm(x, g):
    xf = x.astype(jnp.float32)
    y = xf * lax.rsqrt(jnp.mean(xf * xf, axis=-1, keepdims=True) + EPS)
    return (y * g.astype(jnp.float32)).astype(x.dtype)


def rope_tables(positions):
    inv_freq = ROPE_THETA ** (-jnp.arange(0, MLA_ROPE, 2, dtype=jnp.float32) / MLA_ROPE)
    ang = positions.astype(jnp.float32)[..., None] * inv_freq
    return jnp.cos(ang)[:, :, None, :], jnp.sin(ang)[:, :, None, :]


def apply_rope(x, cos, sin):
    half = x.shape[-1] // 2
    x1, x2 = x[..., :half], x[..., half:]
    c = cos.astype(x.dtype)
    s = sin.astype(x.dtype)
    return jnp.concatenate([x1 * c - x2 * s, x1 * s + x2 * c], axis=-1)


def blocked_causal_softmax_attn(q, k, v, scale):
    S = q.shape[1]
    outs = []
    for i in range(S // BLOCK_Q):
        lo, hi = i * BLOCK_Q, (i + 1) * BLOCK_Q
        s = jnp.einsum('bqhd,bkhd->bhqk', q[:, lo:hi], k[:, :hi]).astype(jnp.float32) * scale
        causal = (lo + jnp.arange(BLOCK_Q))[:, None] >= jnp.arange(hi)[None, :]
        p = jax.nn.softmax(jnp.where(causal, s, NEG_BIG), axis=-1).astype(v.dtype)
        outs.append(jnp.einsum('bhqk,bkhd->bqhd', p, v[:, :hi]))
    return jnp.concatenate(outs, axis=1)


def mla_mixer(h, cos, sin, w_dkv, g_q, g_kv, w_uq, w_ukv, w_o):
    B, S, _ = h.shape
    lat = h @ w_dkv
    c_q = rmsnorm(lat[..., :MLA_Q_LORA], g_q)
    c_kv = rmsnorm(lat[..., MLA_Q_LORA:MLA_Q_LORA + MLA_KV_LORA], g_kv)
    k_pe = lat[..., MLA_Q_LORA + MLA_KV_LORA:][:, :, None, :]
    q = (c_q @ w_uq).reshape(B, S, MLA_HEADS, MLA_NOPE + MLA_ROPE)
    kv = (c_kv @ w_ukv).reshape(B, S, MLA_HEADS, MLA_NOPE + MLA_V)
    q_pe = apply_rope(q[..., MLA_NOPE:], cos, sin)
    k_pe = apply_rope(k_pe, cos, sin)
    q = jnp.concatenate([q[..., :MLA_NOPE], q_pe], axis=-1)
    k = jnp.concatenate([kv[..., :MLA_NOPE],
                         jnp.broadcast_to(k_pe, (B, S, MLA_HEADS, MLA_ROPE))], axis=-1)
    v = kv[..., MLA_NOPE:]
    o = blocked_causal_softmax_attn(q, k, v, (MLA_NOPE + MLA_ROPE) ** -0.5)
    return o.reshape(B, S, MLA_HEADS * MLA_V) @ w_o


def stick_breaking_mixer(h, w_qkv, w_o):
    B, S, _ = h.shape
    qkv = (h @ w_qkv).reshape(B, S, 3, SB_HEADS, SB_HEAD_DIM)
    q, k, v = qkv[:, :, 0], qkv[:, :, 1], qkv[:, :, 2]
    scale = SB_HEAD_DIM ** -0.5
    outs = []
    for i in range(S // BLOCK_Q):
        lo, hi = i * BLOCK_Q, (i + 1) * BLOCK_Q
        z = jnp.einsum('bqhd,bkhd->bhqk', q[:, lo:hi], k[:, :hi]).astype(jnp.float32) * scale
        strict = jnp.arange(hi)[None, :] < (lo + jnp.arange(BLOCK_Q))[:, None]
        log_fail = jnp.where(strict, -jax.nn.softplus(z), 0.0)
        excl = lax.cumsum(log_fail, axis=3, reverse=True) - log_fail
        a = jnp.where(strict, jnp.exp(jax.nn.log_sigmoid(z) + excl), 0.0)
        outs.append(jnp.einsum('bhqk,bkhd->bqhd', a.astype(v.dtype), v[:, :hi]))
    o = jnp.concatenate(outs, axis=1)
    return o.reshape(B, S, SB_HEADS * SB_HEAD_DIM) @ w_o


def mem_cross_attn(h, m, w_q, w_kv, w_o):
    B, S, _ = h.shape
    q = (h @ w_q).reshape(B, S, MEM_HEADS, MEM_HEAD_DIM)
    kv = (m @ w_kv).reshape(B, m.shape[1], 2, MEM_HEADS, MEM_HEAD_DIM)
    s = jnp.einsum('bqhd,bmhd->bhqm', q, kv[:, :, 0]).astype(jnp.float32) * MEM_HEAD_DIM ** -0.5
    p = jax.nn.softmax(s, axis=-1).astype(h.dtype)
    o = jnp.einsum('bhqm,bmhd->bqhd', p, kv[:, :, 1])
    return o.reshape(B, S, MEM_HEADS * MEM_HEAD_DIM) @ w_o


def sq_relu_mlp(h, w_in, w_out):
    return jnp.square(jax.nn.relu(h @ w_in)) @ w_out


def setup_inputs(seed: int = 0) -> dict:
    key = jax.random.key(seed)
    ks = iter(jax.random.split(key, 32))
    f32 = jnp.float32

    def w(shape, fan_in):
        return jax.random.normal(next(ks), shape, f32) * (fan_in ** -0.5)

    def gain(shape):
        return 1.0 + 0.02 * jax.random.normal(next(ks), shape, f32)

    x = jax.random.normal(next(ks), (BATCH, SEQ, D_MODEL), f32)
    mem = jax.random.normal(next(ks), (BATCH, MEM_LEN, D_MODEL), f32)
    offset = jax.random.randint(next(ks), (BATCH, 1), 0, POS_OFFSET_MAX, dtype=jnp.int32)
    positions = (offset + jnp.arange(SEQ, dtype=jnp.int32)[None, :]).astype(jnp.int32)
    return {
        "x": x,
        "mem": mem,
        "positions": positions,
        "norm_mix": gain((DEPTH, D_MODEL)),
        "norm_cross": gain((DEPTH, D_MODEL)),
        "norm_mem": gain((DEPTH, D_MODEL)),
        "norm_mlp": gain((DEPTH, D_MODEL)),
        "norm_final": gain((D_MODEL,)),
        "mla_w_dkv": w((N_MLA_LAYERS, D_MODEL, MLA_Q_LORA + MLA_KV_LORA + MLA_ROPE), D_MODEL),
        "mla_g_q": gain((N_MLA_LAYERS, MLA_Q_LORA)),
        "mla_g_kv": gain((N_MLA_LAYERS, MLA_KV_LORA)),
        "mla_w_uq": w((N_MLA_LAYERS, MLA_Q_LORA, MLA_HEADS * (MLA_NOPE + MLA_ROPE)), MLA_Q_LORA),
        "mla_w_ukv": w((N_MLA_LAYERS, MLA_KV_LORA, MLA_HEADS * (MLA_NOPE + MLA_V)), MLA_KV_LORA),
        "mla_w_o": w((N_MLA_LAYERS, MLA_HEADS * MLA_V, D_MODEL), MLA_HEADS * MLA_V),
        "sb_w_qkv": w((N_SB_LAYERS, D_MODEL, 3 * SB_HEADS * SB_HEAD_DIM), D_MODEL),
        "sb_w_o": w((N_SB_LAYERS, SB_HEADS * SB_HEAD_DIM, D_MODEL), SB_HEADS * SB_HEAD_DIM),
        "xa_w_q": w((DEPTH, D_MODEL, MEM_HEADS * MEM_HEAD_DIM), D_MODEL),
        "xa_w_kv": w((DEPTH, D_MODEL, 2 * MEM_HEADS * MEM_HEAD_DIM), D_MODEL),
        "xa_w_o": w((DEPTH, MEM_HEADS * MEM_HEAD_DIM, D_MODEL), MEM_HEADS * MEM_HEAD_DIM),
        "mlp_w_in": w((DEPTH, D_MODEL, D_FF), D_MODEL),
        "mlp_w_out": w((DEPTH, D_FF, D_MODEL), D_FF),
    }


def reference(x, mem, positions, norm_mix, norm_cross, norm_mem, norm_mlp, norm_final,
              mla_w_dkv, mla_g_q, mla_g_kv, mla_w_uq, mla_w_ukv, mla_w_o,
              sb_w_qkv, sb_w_o, xa_w_q, xa_w_kv, xa_w_o, mlp_w_in, mlp_w_out):
    cos, sin = rope_tables(positions)
    h = x
    for i in range(DEPTH):
        a = rmsnorm(h, norm_mix[i])
        j = i // N_MIXERS
        if i % N_MIXERS == 0:
            h = h + mla_mixer(a, cos, sin, mla_w_dkv[j], mla_g_q[j], mla_g_kv[j],
                              mla_w_uq[j], mla_w_ukv[j], mla_w_o[j])
        else:
            h = h + stick_breaking_mixer(a, sb_w_qkv[j], sb_w_o[j])
        h = h + mem_cross_attn(rmsnorm(h, norm_cross[i]), rmsnorm(mem, norm_mem[i]),
                               xa_w_q[i], xa_w_kv[i], xa_w_o[i])
        h = h + sq_relu_mlp(rmsnorm(h, norm_mlp[i]), mlp_w_in[i], mlp_w_out[i])
    return rmsnorm(h, norm_final)
```

```cpp
#include <hip/hip_runtime.h>
#include <cstdio>
#include <cstdint>
namespace pg8 {
#define PG8_LAS __attribute__((address_space(3)))
typedef unsigned short bf16_t;
typedef short bf16x8 __attribute__((ext_vector_type(8)));
typedef float f32x4 __attribute__((ext_vector_type(4)));
typedef unsigned u32x4 __attribute__((ext_vector_type(4)));
constexpr int BM = 256, BK = 64, HALF = 128, HTB = HALF * BK * 2  , STAGE_BYTES = 8 * HTB, NXCD = 8, WGM = 8;

__host__ __device__ __forceinline__ int lds_byte(int r, int c) { const int st = (r >> 4) * 2 + (c >> 5), rr = r & 15, cc = c & 31, ob = rr * 64 + cc * 2; return st * 1024 + (ob ^ (((ob >> 9) & 1) << 5)); }
__host__ __device__ __forceinline__ void stage_rc(int b, int& R, int& C) { const int st = b / 1024, sb = b % 1024, swz = sb ^ (((sb >> 9) & 1) << 5); R = (st >> 1) * 16 + swz / 64; C = (st & 1) * 32 + (swz % 64) / 2; }
__host__ __device__ __forceinline__ int perm32(int rho) { const int n = rho >> 4, i = rho & 15; return 8 * (i >> 2) + 4 * n + (i & 3); }

struct Unit { int pm, pn; };
struct Gemm { const bf16_t* A; const bf16_t* Bt; int M, N, K, lda; };

struct StaticOrder {
    int nM, nN, nwg, G, c;
    __host__ __device__ void init(int M, int N, int G_, int c_) { nM = M / BM; nN = N / BM; nwg = nM * nN; G = G_; c = c_; }
    __host__ __device__ bool next(int i, Unit& u) const {
        const long L = (long)i * G + c; if (L >= nwg) return false;
        int wgid = (int)L; { const int q = nwg / NXCD, r = nwg % NXCD, xcd = wgid % NXCD, off = wgid / NXCD; wgid = (xcd < r ? xcd * (q + 1) : r * (q + 1) + (xcd - r) * q) + off; }
        const int nig = WGM * nN, gid = wgid / nig, fm = gid * WGM, gsz = (nM - fm) < WGM ? (nM - fm) : WGM;
        u.pm = fm + ((wgid % nig) % gsz); u.pn = (wgid % nig) / gsz; return true;
    }
};

__device__ __forceinline__ unsigned cvt_pk_bf16(float lo, float hi) { unsigned r; asm volatile("v_cvt_pk_bf16_f32 %0, %1, %2" : "=v"(r) : "v"(lo), "v"(hi)); return r; }

template <class F> struct EpiB {
    static constexpr bool PERM = true;
    F f;
    __device__ __forceinline__ void operator()(const f32x4 (&acc)[2][2][4][2], const Unit& u, int wr, int wc, int fr, int fq) const {
        const int row0 = u.pm * BM + wr * 64 + fr, col0 = u.pn * BM + wc * 32 + 8 * fq;
#pragma unroll
        for (int ai = 0; ai < 2; ++ai)
#pragma unroll
            for (int m = 0; m < 4; ++m) { const int row = row0 + ai * HALF + m * 16;
#pragma unroll
                for (int bj = 0; bj < 2; ++bj) f(row, col0 + bj * HALF, acc[ai][bj][m][0], acc[ai][bj][m][1]); }
    }
};
struct EpiRes {
    static constexpr bool PERM = false;
    const float* base; float* out; int ldc;
    __device__ __forceinline__ void operator()(const f32x4 (&acc)[2][2][4][2], const Unit& u, int wr, int wc, int fr, int fq) const {
        const int row0 = u.pm * BM + wr * 64 + fr, col0 = u.pn * BM + wc * 32 + 4 * fq;
#pragma unroll
        for (int ai = 0; ai < 2; ++ai)
#pragma unroll
            for (int m = 0; m < 4; ++m) { const size_t off = (size_t)(row0 + ai * HALF + m * 16) * ldc + col0;
#pragma unroll
                for (int bj = 0; bj < 2; ++bj)
#pragma unroll
                    for (int n = 0; n < 2; ++n) { const size_t o = off + bj * HALF + n * 16; *(f32x4*)(out + o) = *(const f32x4*)(base + o) + acc[ai][bj][m][n]; } }
    }
};

template <class Epi, class Sched, bool ALIGN_EPI>
__device__ __forceinline__ void gemm_phase(PG8_LAS unsigned char* lds, const Gemm g, const Sched& S, const Epi& E) {
    int tid = threadIdx.x; asm volatile("" : "+v"(tid));
    const int wid = __builtin_amdgcn_readfirstlane(tid >> 6), lane = tid & 63, wr = wid >> 2, wc = wid & 3, fr = lane & 15, fq = lane >> 4;
    const int K = g.K, nt = K / BK;
    unsigned voffA[2], voffB[2];
#pragma unroll
    for (int i = 0; i < 2; ++i) { int R, C; stage_rc(tid * 16 + i * 8192, R, C); const int Rb = Epi::PERM ? ((R & ~31) + perm32(R & 31)) : R;
        voffA[i] = (unsigned)(R * g.lda + C) * 2u; voffB[i] = (unsigned)(Rb * K + C) * 2u; }
    const size_t kstep = (size_t)(BK * 2);
    const size_t hstepA = (size_t)HALF * g.lda * 2, hstepB = (size_t)HALF * K * 2;
    const size_t tstepA = 2 * hstepA, tstepB = 2 * hstepB;
    const unsigned ldsw = (unsigned)wid * 1024u;
    const int aoff = lds_byte(wr * 64 + fr, fq * 8), boff = lds_byte(wc * 32 + fr, fq * 8);
#define PG8_SA(b, h) (((b) * 2 + (h)) * HTB)
#define PG8_SB(b, h) ((4 + (b) * 2 + (h)) * HTB)
#define PG8_STAGE(bufoff, gbase, voff) do { _Pragma("unroll") for (int _i = 0; _i < 2; ++_i) \
        __builtin_amdgcn_global_load_lds((const unsigned*)((const char*)(gbase) + (voff)[_i]), (PG8_LAS unsigned*)(lds + (bufoff) + ldsw + _i * 8192), 16, 0, 0); } while (0)
#define PG8_LDA(dst, b, h) do { _Pragma("unroll") for (int m = 0; m < 4; ++m) _Pragma("unroll") for (int k = 0; k < 2; ++k) dst[m][k] = *(const PG8_LAS bf16x8*)(lds + PG8_SA(b, h) + aoff + m * 2048 + k * 1024); } while (0)
#define PG8_LDB(dst, b, h) do { _Pragma("unroll") for (int n = 0; n < 2; ++n) _Pragma("unroll") for (int k = 0; k < 2; ++k) dst[n][k] = *(const PG8_LAS bf16x8*)(lds + PG8_SB(b, h) + boff + n * 2048 + k * 1024); } while (0)
#define PG8_MMA(ai, bj, At, Bt) do { __builtin_amdgcn_s_setprio(1); _Pragma("unroll") for (int m = 0; m < 4; ++m) _Pragma("unroll") for (int n = 0; n < 2; ++n) _Pragma("unroll") for (int k = 0; k < 2; ++k) \
        acc[ai][bj][m][n] = __builtin_amdgcn_mfma_f32_16x16x32_bf16(Bt[n][k], At[m][k], acc[ai][bj][m][n], 0, 0, 0); __builtin_amdgcn_s_setprio(0); } while (0)
#define PG8_WAIT_V(n) asm volatile("s_waitcnt vmcnt(" #n ")" ::: "memory")
#define PG8_WAIT_L(n) asm volatile("s_waitcnt lgkmcnt(" #n ")" ::: "memory")
#define PG8_BAR __builtin_amdgcn_s_barrier()
#define PG8_SCHED __builtin_amdgcn_sched_barrier(0)
    Unit cur, nxt; int ui = 0;
    if (!S.next(0, cur)) return;
    f32x4 acc[2][2][4][2];
#pragma unroll
    for (int a = 0; a < 2; ++a)
#pragma unroll
        for (int b = 0; b < 2; ++b)
#pragma unroll
            for (int m = 0; m < 4; ++m)
#pragma unroll
                for (int n = 0; n < 2; ++n) acc[a][b][m][n] = (f32x4){0.f, 0.f, 0.f, 0.f};
    bf16x8 At[4][2], B0[2][2], B1[2][2];
    const char* cA = (const char*)g.A + (size_t)cur.pm * tstepA; const char* cB = (const char*)g.Bt + (size_t)cur.pn * tstepB;
    PG8_STAGE(PG8_SB(0, 0), cB, voffB); PG8_STAGE(PG8_SB(0, 1), cB + hstepB, voffB); PG8_STAGE(PG8_SA(0, 0), cA, voffA); PG8_STAGE(PG8_SA(0, 1), cA + hstepA, voffA);
    if (wr == 1) PG8_BAR;
    PG8_WAIT_V(2); PG8_BAR;
    PG8_STAGE(PG8_SB(1, 0), cB + kstep, voffB); PG8_STAGE(PG8_SA(1, 0), cA + kstep, voffA); PG8_STAGE(PG8_SB(1, 1), cB + hstepB + kstep, voffB);
    PG8_WAIT_V(6); PG8_BAR;
    for (;;) {
        const bool has_next = S.next(ui + 1, nxt);
        const char* nA = has_next ? (const char*)g.A + (size_t)nxt.pm * tstepA : cA; const char* nB = has_next ? (const char*)g.Bt + (size_t)nxt.pn * tstepB : cB;
#pragma nounroll
        for (int t = 0; t < nt; t += 2) {
            const bool last = (t == nt - 2);
            const char* a1 = cA + (size_t)(t + 1) * kstep;
            const char* a2 = last ? nA : cA + (size_t)(t + 2) * kstep; const char* b2 = last ? nB : cB + (size_t)(t + 2) * kstep;
            const char* a3 = a2 + kstep; const char* b3 = b2 + kstep;
            PG8_LDB(B0, 0, 0); PG8_LDB(B1, 0, 1); PG8_SCHED; PG8_LDA(At, 0, 0); PG8_STAGE(PG8_SA(1, 1), a1 + hstepA, voffA);
            PG8_WAIT_V(8); PG8_WAIT_L(0); PG8_BAR; PG8_MMA(0, 0, At, B0); PG8_MMA(0, 1, At, B1); PG8_BAR; PG8_SCHED;
            PG8_LDA(At, 0, 1); PG8_STAGE(PG8_SB(0, 0), b2, voffB); PG8_STAGE(PG8_SB(0, 1), b2 + hstepB, voffB); PG8_STAGE(PG8_SA(0, 0), a2, voffA);
            PG8_WAIT_V(8); PG8_WAIT_L(0); PG8_BAR; PG8_MMA(1, 0, At, B0); PG8_MMA(1, 1, At, B1); PG8_BAR; PG8_SCHED;
            PG8_LDB(B0, 1, 0); PG8_LDB(B1, 1, 1); PG8_SCHED; PG8_LDA(At, 1, 0); PG8_STAGE(PG8_SA(0, 1), a2 + hstepA, voffA);
            PG8_WAIT_V(8); PG8_WAIT_L(0); PG8_BAR; PG8_MMA(0, 0, At, B0); PG8_MMA(0, 1, At, B1); PG8_BAR; PG8_SCHED;
            PG8_LDA(At, 1, 1); PG8_STAGE(PG8_SB(1, 0), b3, voffB); PG8_STAGE(PG8_SB(1, 1), b3 + hstepB, voffB); PG8_STAGE(PG8_SA(1, 0), a3, voffA);
            PG8_WAIT_V(8); PG8_WAIT_L(0); PG8_BAR; PG8_MMA(1, 0, At, B0); PG8_MMA(1, 1, At, B1); PG8_BAR; PG8_SCHED;
        }
        if constexpr (ALIGN_EPI) { if (wr == 0) PG8_BAR; }
        E(acc, cur, wr, wc, fr, fq);
        if (!has_next) break;
#pragma unroll
        for (int a = 0; a < 2; ++a)
#pragma unroll
            for (int b = 0; b < 2; ++b)
#pragma unroll
                for (int m = 0; m < 4; ++m)
#pragma unroll
                    for (int n = 0; n < 2; ++n) acc[a][b][m][n] = (f32x4){0.f, 0.f, 0.f, 0.f};
        cur = nxt; cA = nA; cB = nB; ++ui;
        if constexpr (ALIGN_EPI) { if (wr == 1) PG8_BAR; }
    }
    PG8_WAIT_V(0);
    if constexpr (!ALIGN_EPI) { if (wr == 0) PG8_BAR; }
    PG8_BAR;
#undef PG8_SA
#undef PG8_SB
#undef PG8_STAGE
#undef PG8_LDA
#undef PG8_LDB
#undef PG8_MMA
#undef PG8_WAIT_V
#undef PG8_WAIT_L
#undef PG8_BAR
#undef PG8_SCHED
}
}
namespace att {
typedef unsigned short bf16_t;
typedef short bf16x8 __attribute__((ext_vector_type(8)));
typedef short s16x4 __attribute__((ext_vector_type(4)));
typedef float f32x16 __attribute__((ext_vector_type(16)));
typedef float f32x4 __attribute__((ext_vector_type(4)));
typedef unsigned u32x4 __attribute__((ext_vector_type(4)));
#define ATT_LAS __attribute__((address_space(3)))
constexpr int KVBLK = 64, QBLK = 32, QB = 256;
constexpr int L_K = 0, L_V = 16384, L_PE = 32768, L_WS = 40960, L_FLAG = 40960 + 2048, LDS_BYTES = 40960 + 2048 + 64;
enum { MODE_MLA = 0, MODE_CROSS = 1, MODE_SB = 2 };

#define ATT_KSWZ(row, colB) ((row) * 256 + ((colB) ^ (((row) & 7) << 4)))
#define ATT_PESWZ(row, ch) ((row) * 128 + ((((ch) ^ (((row) >> 1) & 7))) << 4))
#define ATT_SBAR() __builtin_amdgcn_sched_barrier(0)
__device__ __forceinline__ int v_st(int k, int c) { const int kk = (k & ~0xC) | ((k & 4) << 1) | ((k & 8) >> 1); return ((kk >> 3) * 4 + (c >> 5)) * 512 + ((kk & 7) * 32 + (c & 31)) * 2; }
__device__ __forceinline__ int v_rd_base(int lane) { return ((lane & 3) << 3) | (((lane >> 2) & 3) << 6) | (((lane >> 4) & 1) << 5) | (((lane >> 5) & 1) << 8); }
__device__ __forceinline__ int crow(int r, int hi) { return (r & 3) + 8 * (r >> 2) + 4 * hi; }
__device__ __forceinline__ unsigned cvtpk(float lo, float hi) { unsigned r; asm volatile("v_cvt_pk_bf16_f32 %0, %1, %2" : "=v"(r) : "v"(lo), "v"(hi)); return r; }
__device__ __forceinline__ float swap_add(float v) { auto rr = __builtin_amdgcn_permlane32_swap(__float_as_uint(v), __float_as_uint(v), false, false); return __uint_as_float(rr[0]) + __uint_as_float(rr[1]); }
__device__ __forceinline__ float swap_max(float v) { auto rr = __builtin_amdgcn_permlane32_swap(__float_as_uint(v), __float_as_uint(v), false, false); return fmaxf(__uint_as_float(rr[0]), __uint_as_float(rr[1])); }
__device__ __forceinline__ float swap_other(float v, int hi) { auto rr = __builtin_amdgcn_permlane32_swap(__float_as_uint(v), __float_as_uint(v), false, false);
    const float a = __uint_as_float(rr[0]), b = __uint_as_float(rr[1]); return hi ? a : b; }

__device__ __forceinline__ void pack_p(const f32x16& p0, const f32x16& p1, bf16x8& pa0, bf16x8& pa1, bf16x8& pa2, bf16x8& pa3) {
#define ATT_PK4(P, B_, OUT) do { unsigned a0 = cvtpk(P[B_+0], P[B_+1]), a1 = cvtpk(P[B_+2], P[B_+3]);                          \
        unsigned b0 = cvtpk(P[B_+4], P[B_+5]), b1 = cvtpk(P[B_+6], P[B_+7]);                                             \
        auto r0 = __builtin_amdgcn_permlane32_swap(a0, b0, false, false); auto r1 = __builtin_amdgcn_permlane32_swap(a1, b1, false, false); \
        u32x4 w = {r0[0], r1[0], r0[1], r1[1]}; OUT = *reinterpret_cast<bf16x8*>(&w); } while (0)
    ATT_PK4(p0, 0, pa0); ATT_PK4(p0, 8, pa1); ATT_PK4(p1, 0, pa2); ATT_PK4(p1, 8, pa3);
#undef ATT_PK4
}
__device__ __forceinline__ void pv_tile(f32x16* o, int vb0, bf16x8 pa0, bf16x8 pa1, bf16x8 pa2, bf16x8 pa3) {
#define ATT_TRRD(dst, off) asm volatile("ds_read_b64_tr_b16 %0, %1 offset:%2" : "=&v"(dst) : "v"(vb0), "i"(off) : "memory")
#define ATT_PV_D0(d0) do { s16x4 l0, l1, l2, l3, h0, h1, h2, h3; constexpr int b_ = (d0) * 512;   \
        ATT_TRRD(l0, b_); ATT_TRRD(h0, b_ + 2048); ATT_TRRD(l1, b_ + 4096); ATT_TRRD(h1, b_ + 6144); ATT_TRRD(l2, b_ + 8192); ATT_TRRD(h2, b_ + 10240); ATT_TRRD(l3, b_ + 12288); ATT_TRRD(h3, b_ + 14336); \
        asm volatile("s_waitcnt lgkmcnt(0)" ::: "memory"); ATT_SBAR();   \
        o[d0] = __builtin_amdgcn_mfma_f32_32x32x16_bf16(pa0, (bf16x8){l0[0], l0[1], l0[2], l0[3], h0[0], h0[1], h0[2], h0[3]}, o[d0], 0, 0, 0);   \
        o[d0] = __builtin_amdgcn_mfma_f32_32x32x16_bf16(pa1, (bf16x8){l1[0], l1[1], l1[2], l1[3], h1[0], h1[1], h1[2], h1[3]}, o[d0], 0, 0, 0);   \
        o[d0] = __builtin_amdgcn_mfma_f32_32x32x16_bf16(pa2, (bf16x8){l2[0], l2[1], l2[2], l2[3], h2[0], h2[1], h2[2], h2[3]}, o[d0], 0, 0, 0);   \
        o[d0] = __builtin_amdgcn_mfma_f32_32x32x16_bf16(pa3, (bf16x8){l3[0], l3[1], l3[2], l3[3], h3[0], h3[1], h3[2], h3[3]}, o[d0], 0, 0, 0); } while (0)
    ATT_PV_D0(0); ATT_PV_D0(1); ATT_PV_D0(2); ATT_PV_D0(3);
#undef ATT_PV_D0
#undef ATT_TRRD
}

template <int MODE>
__device__ __forceinline__ void attn_unit(ATT_LAS unsigned char* lds, const bf16_t* Qb, const bf16_t* Kn, const bf16_t* Kpe, const bf16_t* Vp, bf16_t* Ob, int ostride, int q0, int nkeys) {
    constexpr int DKQ = (MODE == MODE_MLA) ? 192 : 128, NQF = DKQ / 16;
    int tid = threadIdx.x; asm volatile("" : "+v"(tid));
    const int wid = __builtin_amdgcn_readfirstlane(tid >> 6), lane = tid & 63, r32 = lane & 31, hi = lane >> 5;
    ATT_LAS float* ws = (ATT_LAS float*)(lds + L_WS) + wid * 64; ATT_LAS float* li_l = ws; ATT_LAS float* al_l = ws + 32;
    volatile ATT_LAS int* flags = (volatile ATT_LAS int*)(lds + L_FLAG);
    const int vb0 = (int)(unsigned)(uintptr_t)(lds + L_V) + v_rd_base(lane);
    bf16x8 qr[NQF];
#pragma unroll
    for (int d0 = 0; d0 < NQF; ++d0) qr[d0] = *(const bf16x8*)(Qb + (size_t)(wid * QBLK + r32) * DKQ + d0 * 16 + hi * 8);
    const int qlo = q0 + wid * QBLK;
    const int qpos = qlo + r32;
    float m_reg = -1e30f, l_reg = 0.f, Rrun = 0.f;
    f32x16 o[4]; o[0] = f32x16{}; o[1] = f32x16{}; o[2] = f32x16{}; o[3] = f32x16{};
    const int sr = tid >> 4, sc = (tid & 15) * 8;
    const int kws = ATT_KSWZ(sr, sc * 2), vst0 = v_st(sr, sc), vst1 = v_st(32 + sr, sc);
    const int per = tid >> 3, pech = tid & 7, pews = ATT_PESWZ(per, pech);
    int NT;
    if (MODE == MODE_CROSS) NT = nkeys / KVBLK; else NT = (q0 + QB) / KVBLK;
    if (MODE == MODE_SB) { if (tid < 8) flags[tid] = 0; }
    for (int it = 0; it < NT; ++it) {
        const int t = (MODE == MODE_SB) ? (NT - 1 - it) : it;
        const int kb = t * KVBLK;
        __syncthreads();
        if (MODE == MODE_SB && it > 0) { int alld = 1;
#pragma unroll
            for (int w = 0; w < 8; ++w) alld &= flags[w];
            if (alld) break; }
        {
            const u32x4 k0v = *(const u32x4*)(Kn + (size_t)(kb + sr) * 128 + sc), k1v = *(const u32x4*)(Kn + (size_t)(kb + 32 + sr) * 128 + sc);
            const u32x4 v0v = *(const u32x4*)(Vp + (size_t)(kb + sr) * 128 + sc), v1v = *(const u32x4*)(Vp + (size_t)(kb + 32 + sr) * 128 + sc);
            u32x4 pev; if (MODE == MODE_MLA) pev = *(const u32x4*)(Kpe + (size_t)(kb + per) * 64 + pech * 8);
            *(ATT_LAS u32x4*)(lds + L_K + kws) = k0v; *(ATT_LAS u32x4*)(lds + L_K + kws + 32 * 256) = k1v;
            *(ATT_LAS u32x4*)(lds + L_V + vst0) = v0v; *(ATT_LAS u32x4*)(lds + L_V + vst1) = v1v;
            if (MODE == MODE_MLA) *(ATT_LAS u32x4*)(lds + L_PE + pews) = pev;
        }
        __syncthreads();
        bool act = true;
        if (MODE == MODE_MLA) act = (kb <= qlo + QBLK - 1);
        if (MODE == MODE_SB) act = (kb < qlo + QBLK - 1);
        if (act && MODE != MODE_SB) {
            f32x16 p0 = f32x16{}, p1 = f32x16{};
#pragma unroll
            for (int d0 = 0; d0 < 8; ++d0) {
                const int off = ATT_KSWZ(r32, ((d0 & 3) * 16 + hi * 8) * 2) + (d0 >> 2) * 128;
                const bf16x8 b0 = *(const ATT_LAS bf16x8*)(lds + L_K + off);
                const bf16x8 b1 = *(const ATT_LAS bf16x8*)(lds + L_K + off + 32 * 256);
                p0 = __builtin_amdgcn_mfma_f32_32x32x16_bf16(b0, qr[d0], p0, 0, 0, 0);
                p1 = __builtin_amdgcn_mfma_f32_32x32x16_bf16(b1, qr[d0], p1, 0, 0, 0);
            }
            if (MODE == MODE_MLA) {
#pragma unroll
                for (int d0 = 8; d0 < NQF; ++d0) {
                    const int off = ATT_PESWZ(r32, (d0 - 8) * 2 + hi);
                    const bf16x8 b0 = *(const ATT_LAS bf16x8*)(lds + L_PE + off);
                    const bf16x8 b1 = *(const ATT_LAS bf16x8*)(lds + L_PE + off + 32 * 128);
                    p0 = __builtin_amdgcn_mfma_f32_32x32x16_bf16(b0, qr[d0], p0, 0, 0, 0);
                    p1 = __builtin_amdgcn_mfma_f32_32x32x16_bf16(b1, qr[d0], p1, 0, 0, 0);
                }
            }
            bf16x8 pa0, pa1, pa2, pa3;
            if (MODE == MODE_MLA && kb + KVBLK - 1 > qlo) {
                const float NEG = -__builtin_inff();
#pragma unroll
                for (int r = 0; r < 16; ++r) { const int key = kb + crow(r, hi); if (key > qpos) p0[r] = NEG; if (key + 32 > qpos) p1[r] = NEG; }
            }
            float pmax = p0[0];
#pragma unroll
            for (int r = 1; r < 16; ++r) pmax = fmaxf(pmax, p0[r]);
#pragma unroll
            for (int r = 0; r < 16; ++r) pmax = fmaxf(pmax, p1[r]);
            pmax = swap_max(pmax);
            const float mn = fmaxf(m_reg, pmax), alpha = __builtin_amdgcn_exp2f(m_reg - mn); m_reg = mn;
            float ps = 0.f;
#pragma unroll
            for (int r = 0; r < 16; ++r) { p0[r] = __builtin_amdgcn_exp2f(p0[r] - mn); ps += p0[r]; }
#pragma unroll
            for (int r = 0; r < 16; ++r) { p1[r] = __builtin_amdgcn_exp2f(p1[r] - mn); ps += p1[r]; }
            ps = swap_add(ps);
            l_reg = l_reg * alpha + ps;
            if (__any(alpha < 1.f)) {
                if (hi == 0) al_l[r32] = alpha;
                asm volatile("s_waitcnt lgkmcnt(0)" ::: "memory");
#pragma unroll
                for (int r = 0; r < 16; ++r) { const float a = al_l[crow(r, hi)];
#pragma unroll
                    for (int d_ = 0; d_ < 4; ++d_) o[d_][r] *= a; }
            }
            pack_p(p0, p1, pa0, pa1, pa2, pa3);
            ATT_SBAR();
            pv_tile(o, vb0, pa0, pa1, pa2, pa3);
        }
        if (act && MODE == MODE_SB) {
            const bool needmask = (kb + KVBLK - 1 >= qlo);
            bf16x8 pa[4];
#pragma unroll
            for (int half = 1; half >= 0; --half) {
                f32x16 p = f32x16{};
#pragma unroll
                for (int d0 = 0; d0 < 8; ++d0) {
                    const int off = ATT_KSWZ(r32, ((d0 & 3) * 16 + hi * 8) * 2) + (d0 >> 2) * 128 + half * 32 * 256;
                    const bf16x8 b0 = *(const ATT_LAS bf16x8*)(lds + L_K + off);
                    p = __builtin_amdgcn_mfma_f32_32x32x16_bf16(b0, qr[d0], p, 0, 0, 0);
                }
                f32x16 L;
#pragma unroll
                for (int r = 0; r < 16; ++r) { const float z = p[r], az = fabsf(z); const float sp = fmaxf(z, 0.f) + __builtin_amdgcn_logf(1.f + __builtin_amdgcn_exp2f(-az)); L[r] = -sp; p[r] = z - sp; }
                if (needmask) {
#pragma unroll
                    for (int r = 0; r < 16; ++r) { const int key = kb + half * 32 + crow(r, hi); if (key >= qpos) L[r] = 0.f; }
                }
                float g[4], h[4];
#pragma unroll
                for (int i = 0; i < 4; ++i) g[i] = (L[4 * i] + L[4 * i + 1]) + (L[4 * i + 2] + L[4 * i + 3]);
#pragma unroll
                for (int i = 0; i < 4; ++i) h[i] = swap_other(g[i], hi);
                float os[4]; float run = Rrun;
#pragma unroll
                for (int i = 3; i >= 0; --i) { os[i] = run; run += g[i] + h[i]; }
#pragma unroll
                for (int i = 0; i < 4; ++i) {
                    float e = os[i] + (hi == 0 ? h[i] : 0.f);
#pragma unroll
                    for (int j = 3; j >= 0; --j) { const float lsg = p[4 * i + j]; p[4 * i + j] = __builtin_amdgcn_exp2f(lsg + e); e += L[4 * i + j]; }
                }
                if (needmask) {
#pragma unroll
                    for (int r = 0; r < 16; ++r) { const int key = kb + half * 32 + crow(r, hi); if (key >= qpos) p[r] = 0.f; }
                }
                Rrun = run;
#define ATT_PK4(P, B_, OUT) do { unsigned a0 = cvtpk(P[B_+0], P[B_+1]), a1 = cvtpk(P[B_+2], P[B_+3]);                          \
        unsigned b0 = cvtpk(P[B_+4], P[B_+5]), b1 = cvtpk(P[B_+6], P[B_+7]);                                             \
        auto r0 = __builtin_amdgcn_permlane32_swap(a0, b0, false, false); auto r1 = __builtin_amdgcn_permlane32_swap(a1, b1, false, false); \
        u32x4 w = {r0[0], r1[0], r0[1], r1[1]}; OUT = *reinterpret_cast<bf16x8*>(&w); } while (0)
                ATT_PK4(p, 0, pa[2 * half]); ATT_PK4(p, 8, pa[2 * half + 1]);
#undef ATT_PK4
            }
            ATT_SBAR();
            pv_tile(o, vb0, pa[0], pa[1], pa[2], pa[3]);
        }
        if (MODE == MODE_SB) { const int dn = (act && __all(Rrun < -152.0f)) ? 1 : 0; if (lane == 0) flags[wid] = dn; }
    }
    float rli[16];
    if (MODE != MODE_SB) {
        if (hi == 0) li_l[r32] = l_reg;
        asm volatile("s_waitcnt lgkmcnt(0)" ::: "memory");
#pragma unroll
        for (int r = 0; r < 16; ++r) rli[r] = 1.0f / li_l[crow(r, hi)];
    } else {
#pragma unroll
        for (int r = 0; r < 16; ++r) rli[r] = 1.0f;
    }
    bf16_t* Ow = Ob + (size_t)(wid * QBLK) * ostride;
#pragma unroll
    for (int r = 0; r < 16; ++r) { const int orow = crow(r, hi);
#pragma unroll
        for (int d0 = 0; d0 < 4; ++d0) { const float v = o[d0][r] * rli[r]; const float vn = __shfl_xor(v, 1);
            if ((r32 & 1) == 0) *(unsigned*)(Ow + (size_t)orow * ostride + d0 * 32 + r32) = cvtpk(v, vn); } }
    __syncthreads();
}
}
constexpr int NWAVES = 8;
constexpr int BATCH = 8, SEQ = 2048, DM = 1024, T = BATCH * SEQ;
constexpr int MEMLEN = 256, TM = BATCH * MEMLEN;
constexpr int QLORA = 384, KVLORA = 256, ROPE = 64, NLAT = 704, NLATP = 768;
constexpr int HEADS = 8, NOPE = 128, DQK = 192, DV = 128;
constexpr int XH = 4, DFF = 4096;
constexpr float EPS = 1e-6f;
constexpr float LOG2E = 1.4426950408889634f;
constexpr float QSCALE_MLA = 0.07216878364870322f * LOG2E;
constexpr float QSCALE_128 = 0.08838834764831845f * LOG2E;

constexpr size_t MiB = 1u << 20;
constexpr size_t WS_CTL = 0, CTL_ZERO_BYTES = 64 * 1024;
constexpr size_t WS_RS = 1 * MiB / 2;
constexpr size_t WS_WDKV = 1 * MiB;
constexpr size_t WS_WUQ = WS_WDKV + (size_t)NLATP * DM * 2;
constexpr size_t WS_WUKV = WS_WUQ + (size_t)1536 * 384 * 2;
constexpr size_t WS_WO0 = WS_WUKV + (size_t)2048 * 256 * 2;
constexpr size_t WS_WXQ = WS_WO0 + (size_t)DM * DM * 2;
constexpr size_t WS_WXKV = WS_WXQ + 2 * (size_t)512 * DM * 2;
constexpr size_t WS_WXO = WS_WXKV + 2 * (size_t)DM * DM * 2;
constexpr size_t WS_WIN = WS_WXO + 2 * (size_t)DM * 512 * 2;
constexpr size_t WS_WOUT = WS_WIN + 2 * (size_t)DFF * DM * 2;
constexpr size_t WS_WQKV = WS_WOUT + 2 * (size_t)DM * DFF * 2;
constexpr size_t WS_WO1 = WS_WQKV + (size_t)3072 * DM * 2;
constexpr size_t WS_WEND = WS_WO1 + (size_t)DM * DM * 2;
static_assert(WS_WEND <= 56 * MiB, "weights");
constexpr size_t WS_HB = 56 * MiB;
constexpr size_t WS_KVX = 88 * MiB;
constexpr size_t WS_CS = 96 * MiB;
constexpr size_t WS_KPE = 100 * MiB;
constexpr size_t WS_MEMB = 102 * MiB;
constexpr size_t WS_X = 106 * MiB;
constexpr size_t WS_LAT = WS_X;
constexpr size_t WS_OB = WS_X;
constexpr size_t WS_Q = WS_X + 32 * MiB;
constexpr size_t WS_KN = WS_X + 80 * MiB;
constexpr size_t WS_V = WS_X + 112 * MiB;
constexpr size_t WS_K1 = WS_X + 64 * MiB, WS_V1 = WS_X + 96 * MiB;
constexpr size_t WS_QX = WS_X, WS_OX = WS_X + 16 * MiB;
constexpr size_t WS_U = WS_X;
constexpr size_t WS_END = WS_X + 144 * MiB;
static_assert(WS_END <= 256 * MiB, "d_ws map");
constexpr int RS_X = 0, RS_Q = T, RS_KV = 2 * T, RS_H = 3 * T, RS_MEM = 4 * T;
constexpr int CW_BAR = 1024;

constexpr int RING_OFF = 0, RING_BYTES = 131072;
constexpr int LDSCTL_OFF = RING_BYTES, MISC_OFF = LDSCTL_OFF + 320;
constexpr int LDS_BYTES = 147456;

#define GAS __attribute__((address_space(1)))
#define LAS __attribute__((address_space(3)))
typedef unsigned short bf16;
typedef unsigned v4u __attribute__((ext_vector_type(4)));
typedef float f32x4 __attribute__((ext_vector_type(4)));
typedef GAS unsigned gu32;
#define RLX_AGENT __ATOMIC_RELAXED, __HIP_MEMORY_SCOPE_AGENT
#define LDS_WAIT() asm volatile("s_waitcnt lgkmcnt(0)" ::: "memory")
#define VM_WAIT() asm volatile("s_waitcnt vmcnt(0)" ::: "memory")
__device__ __forceinline__ unsigned f2bf(float f) { unsigned u = __builtin_bit_cast(unsigned, f); return (u + 0x7fffu + ((u >> 16) & 1u)) >> 16; }
__device__ __forceinline__ unsigned pk2(float lo, float hi) { return f2bf(lo) | (f2bf(hi) << 16); }
__device__ __forceinline__ float bf2f(unsigned short b) { return __builtin_bit_cast(float, (unsigned)b << 16); }
__device__ __forceinline__ void store8(bf16* p, f32x4 a, f32x4 b) { v4u w; w.x = pg8::cvt_pk_bf16(a[0], a[1]); w.y = pg8::cvt_pk_bf16(a[2], a[3]); w.z = pg8::cvt_pk_bf16(b[0], b[1]); w.w = pg8::cvt_pk_bf16(b[2], b[3]); *(v4u*)p = w; }

#define XB_TMO      128
#define XB_XCNT(j)  (256  + 64 * (j))
#define XB_XSUB(j)  (1280 + 64 * (j))
#define XB_XGEN(j)  (2304 + 64 * (j))
#define XB_TOP      3328
#define XB_TOPGEN   3392
#define XCD_BAR_WORDS 3456
#define XB_SPIN_CAP (1u << 18)
__device__ __forceinline__ unsigned xb_ld(unsigned* p)              { return __hip_atomic_load(p, __ATOMIC_RELAXED, __HIP_MEMORY_SCOPE_AGENT); }
__device__ __forceinline__ unsigned xb_add(unsigned* p, unsigned v) { return __hip_atomic_fetch_add(p, v, __ATOMIC_RELAXED, __HIP_MEMORY_SCOPE_AGENT); }
__device__ __forceinline__ unsigned xb_xcc_id() { return (unsigned)__builtin_amdgcn_s_getreg((3 << 11) | 20) & 0xFu; }
#define XB_SPIN(cond, bar) do { unsigned _sp = 0; while (cond) { __builtin_amdgcn_s_sleep(1); \
    if ((++_sp & 255u) == 0u) { if (xb_ld(&(bar)[XB_TMO])) break; if (_sp > XB_SPIN_CAP) { atomicAdd(&(bar)[XB_TMO], 1u); break; } } } } while (0)
struct XcdBarrier { unsigned* bar; unsigned x; volatile LAS unsigned* st; };
__device__ __forceinline__ XcdBarrier xcd_barrier_post(unsigned* bar, volatile LAS unsigned* st) {
    XcdBarrier b; b.bar = bar; b.x = xb_xcc_id(); b.st = st;
    if (threadIdx.x == 0) (void)xb_add(&bar[XB_XCNT(b.x)], 1u);
    return b;
}
__device__ __forceinline__ void xcd_barrier_complete(unsigned* bar, unsigned x, unsigned& nloc, unsigned& nx) {
    const unsigned G = gridDim.x * gridDim.y * gridDim.z;
    unsigned sum, cnt, mine, sp = 0u;
    for (;;) {
        sum = 0u; cnt = 0u; mine = 0u;
#pragma unroll
        for (unsigned j = 0; j < 16; ++j) { const unsigned c = xb_ld(&bar[XB_XCNT(j)]); sum += c; cnt += (c > 0u) ? 1u : 0u; mine = (j == x) ? c : mine; }
        if (sum == G) break;
        __builtin_amdgcn_s_sleep(1);
        if ((++sp & 255u) == 0u) { if (xb_ld(&bar[XB_TMO])) break; if (sp > XB_SPIN_CAP) { atomicAdd(&bar[XB_TMO], 1u); break; } }
    }
    nloc = mine > 0u ? mine : 1u; nx = cnt > 0u ? cnt : 1u;
}
__device__ __forceinline__ void xcd_barrier(const XcdBarrier& b) {
    asm volatile("s_waitcnt vmcnt(0)" ::: "memory");
    __syncthreads();
    if (threadIdx.x == 0) {
        unsigned* bar = b.bar;
        __builtin_amdgcn_s_waitcnt(0);
        unsigned nloc = b.st[0], nx = b.st[1];
        if (nloc == 0u) { xcd_barrier_complete(bar, b.x, nloc, nx); b.st[0] = nloc; b.st[1] = nx; }
        const unsigned old = xb_add(&bar[XB_XSUB(b.x)], 1u);
        const unsigned gen = old / nloc;
        if (old + 1u == (gen + 1u) * nloc) {
            __builtin_amdgcn_fence(__ATOMIC_RELEASE, "agent");
            asm volatile("s_waitcnt vmcnt(0)" ::: "memory");
            const unsigned og = xb_add(&bar[XB_TOP], 1u);
            const unsigned tg = og / nx;
            if (og + 1u == (tg + 1u) * nx) xb_add(&bar[XB_TOPGEN], 1u);
            else XB_SPIN(xb_ld(&bar[XB_TOPGEN]) == tg, bar);
            __builtin_amdgcn_fence(__ATOMIC_ACQUIRE, "agent");
            xb_add(&bar[XB_XGEN(b.x)], 1u);
            asm volatile("s_waitcnt vmcnt(0)" ::: "memory");
        } else {
            XB_SPIN(xb_ld(&bar[XB_XGEN(b.x)]) == gen, bar);
            __builtin_amdgcn_fence(__ATOMIC_ACQUIRE, "agent");
            asm volatile("s_waitcnt vmcnt(0)" ::: "memory");
        }
    }
    __syncthreads();
}

__device__ __forceinline__ float wave_sum(float v) {
#pragma unroll
    for (int o = 1; o < 64; o <<= 1) v += __shfl_xor(v, o);
    return v;
}
__device__ __forceinline__ void transpose_item(const float* W, int K, int N, bf16* WT, const float* gain, int permq, LAS float* scr, int item, int lane) {
    const int nblk = N / 32, kb = item / nblk, nb = item % nblk, k0 = 64 * kb, n0 = 32 * nb;
    int src = n0 + (lane & 31);
    if (permq) { const int h = src / DQK; int d = src - h * DQK; if (d >= NOPE) { const int j = d - NOPE; d = NOPE + (j & 1) * 32 + (j >> 1); } src = h * DQK + d; }
#pragma unroll 8
    for (int i = 0; i < 32; ++i) { const int kk = 2 * i + (lane >> 5); const float g = gain ? gain[k0 + kk] : 1.0f; scr[kk * 33 + (lane & 31)] = W[(size_t)(k0 + kk) * N + src] * g; }
    LDS_WAIT(); asm volatile("" ::: "memory");
    const int c = lane & 7;
#pragma unroll
    for (int j = 0; j < 4; ++j) { const int n = (lane >> 3) + 8 * j; const LAS float* s = scr + (8 * c) * 33 + n;
        v4u o; o.x = pk2(s[0 * 33], s[1 * 33]); o.y = pk2(s[2 * 33], s[3 * 33]); o.z = pk2(s[4 * 33], s[5 * 33]); o.w = pk2(s[6 * 33], s[7 * 33]);
        *(GAS v4u*)(WT + (size_t)(n0 + n) * K + k0 + 8 * c) = o; }
    LDS_WAIT(); asm volatile("" ::: "memory");
}
__device__ __forceinline__ void rowstat_1024(const float* xrow, bf16* orow, float* rs, int lane) {
    const GAS f32x4* xr = (const GAS f32x4*)xrow + lane;
    f32x4 v[4]; float s = 0.f;
#pragma unroll
    for (int j = 0; j < 4; ++j) { v[j] = xr[64 * j]; s += (v[j].x * v[j].x + v[j].y * v[j].y) + (v[j].z * v[j].z + v[j].w * v[j].w); }
    const float r = 1.0f / sqrtf(wave_sum(s) * (1.0f / 1024.0f) + EPS);
    if (lane == 0) *rs = r;
    GAS unsigned long long* o8 = (GAS unsigned long long*)orow + lane;
#pragma unroll
    for (int j = 0; j < 4; ++j) o8[64 * j] = (unsigned long long)pk2(v[j].x, v[j].y) | ((unsigned long long)pk2(v[j].z, v[j].w) << 32);
}

struct FLat { bf16* lat; const float* rs;
    __device__ __forceinline__ void operator()(int row, int col, f32x4 v0, f32x4 v1) const { const float s = rs[row]; store8(lat + (size_t)row * NLATP + col, v0 * s, v1 * s); } };
struct FMemKV { bf16* kx; bf16* vx; const float* rs;
    __device__ __forceinline__ void operator()(int row, int col, f32x4 v0, f32x4 v1) const { const float s = rs[row];
        const int b = row >> 8, m = row & 255, t = col >> 9, c = col & 511, h = c >> 7, d = c & 127;
        bf16* p = (t ? vx : kx) + ((size_t)((b * XH + h) * MEMLEN + m)) * 128 + d; store8(p, v0 * s, v1 * s); } };
struct FQ0 { bf16* q; const float* rs; const float2* cs;
    __device__ __forceinline__ void operator()(int row, int col, f32x4 v0, f32x4 v1) const { const float s = rs[row] * QSCALE_MLA; v0 = v0 * s; v1 = v1 * s;
        const int h = col / DQK, d = col - h * DQK;
        if (d >= NOPE) { const float2* c = cs + (size_t)row * 32 + ((d - NOPE) >> 1);
            const float2 c0 = c[0], c1 = c[1], c2 = c[2], c3 = c[3];
            const f32x4 a = v0, b = v1;
            v0[0] = a[0] * c0.x - a[1] * c0.y; v0[1] = a[0] * c0.y + a[1] * c0.x; v0[2] = a[2] * c1.x - a[3] * c1.y; v0[3] = a[2] * c1.y + a[3] * c1.x;
            v1[0] = b[0] * c2.x - b[1] * c2.y; v1[1] = b[0] * c2.y + b[1] * c2.x; v1[2] = b[2] * c3.x - b[3] * c3.y; v1[3] = b[2] * c3.y + b[3] * c3.x; }
        const int bb = row >> 11, si = row & 2047;
        store8(q + ((size_t)((bb * HEADS + h) * SEQ + si)) * DQK + d, v0, v1); } };
struct FKV0 { bf16* kn; bf16* v; const float* rs;
    __device__ __forceinline__ void operator()(int row, int col, f32x4 v0, f32x4 v1) const { const float s = rs[row];
        const int h = col >> 8, j = col & 255, bb = row >> 11, si = row & 2047;
        bf16* p = (j < 128 ? kn : v) + ((size_t)((bb * HEADS + h) * SEQ + si)) * 128 + (j & 127); store8(p, v0 * s, v1 * s); } };
struct FXQ { bf16* qx; const float* rs;
    __device__ __forceinline__ void operator()(int row, int col, f32x4 v0, f32x4 v1) const { const float s = rs[row] * QSCALE_128;
        const int h = col >> 7, d = col & 127, bb = row >> 11, si = row & 2047;
        store8(qx + ((size_t)((bb * XH + h) * SEQ + si)) * 128 + d, v0 * s, v1 * s); } };
struct FUp { bf16* u; const float* rs;
    __device__ __forceinline__ void operator()(int row, int col, f32x4 v0, f32x4 v1) const { const float s = rs[row]; v0 = v0 * s; v1 = v1 * s;
#pragma unroll
        for (int j = 0; j < 4; ++j) { const float a = fmaxf(v0[j], 0.f), b = fmaxf(v1[j], 0.f); v0[j] = a * a; v1[j] = b * b; }
        store8(u + (size_t)row * DFF + col, v0, v1); } };
struct FQKV1 { bf16* q; bf16* k; bf16* v; const float* rs;
    __device__ __forceinline__ void operator()(int row, int col, f32x4 v0, f32x4 v1) const { const int t = col >> 10, c = col & 1023, h = c >> 7, d = c & 127, bb = row >> 11, si = row & 2047;
        const float s = rs[row] * (t == 0 ? QSCALE_128 : 1.0f);
        bf16* p = q + (size_t)t * (32u << 19) + ((size_t)((bb * HEADS + h) * SEQ + si)) * 128 + d; store8(p, v0 * s, v1 * s); } };

struct Args { const float* in[21]; float* out; unsigned char* ws; int ph_lo, ph_hi; };
static_assert(sizeof(Args) == 21 * 8 + 8 + 8 + 8, "Args has no padding");

enum { PH_PRO = 0, PH_DKV, PH_LATSTAT, PH_UQKV, PH_ATT0, PH_WO0, PH_ST1, PH_XQ0, PH_XA0, PH_XO0, PH_ST2, PH_UP0, PH_DN0, PH_ST3,
       PH_QKV1, PH_ATT1, PH_WO1, PH_ST4, PH_XQ1, PH_XA1, PH_XO1, PH_ST5, PH_UP1, PH_DN1, PH_FINAL, NPH };

__global__ void __launch_bounds__(NWAVES * 64, 2) mk_fwd(Args args) {
    extern __shared__ __attribute__((aligned(16))) unsigned char lds_raw[];
    LAS unsigned char* lds = (LAS unsigned char*)lds_raw;
    volatile LAS unsigned* MISC = (volatile LAS unsigned*)(lds + MISC_OFF);
    const int tid = threadIdx.x, lane = tid & 63, wave = __builtin_amdgcn_readfirstlane(tid >> 6);
    const int G = gridDim.x; int vcu; { const int bx = blockIdx.x; vcu = (G % 8 == 0) ? (bx % 8) * (G / 8) + bx / 8 : bx; }
    unsigned char* ws = args.ws;
    gu32* ctl = (gu32*)(ws + WS_CTL);
    for (int u = tid; u < (LDS_BYTES - LDSCTL_OFF) / 4; u += NWAVES * 64) ((LAS unsigned*)(lds + LDSCTL_OFF))[u] = 0u;
    __syncthreads();
    const int lo = args.ph_lo, hi = args.ph_hi;
    const bool one_phase = (hi - lo == 1);
    XcdBarrier bar; bar.bar = (unsigned*)(ctl + CW_BAR); bar.x = 0; bar.st = nullptr;
    if (!one_phase) bar = xcd_barrier_post((unsigned*)(ctl + CW_BAR), MISC + 8);
#define IN(k) (lo <= (k) && (k) < hi)
#define SEAM(k) do { if (IN(k) && IN((k) + 1)) xcd_barrier(bar); } while (0)

    const float* x = args.in[0]; const float* mem = args.in[1]; const int* positions = (const int*)args.in[2];
    const float* norm_mix = args.in[3]; const float* norm_cross = args.in[4]; const float* norm_mem = args.in[5]; const float* norm_mlp = args.in[6]; const float* norm_final = args.in[7];
#define WSL() ({ unsigned char* _p = ws; asm volatile("" : "+s"(_p)); _p; })
#define rsb ((float*)(WSL() + WS_RS))
#define HB ((bf16*)(WSL() + WS_HB))
#define MEMB ((bf16*)(WSL() + WS_MEMB))
#define LAT ((bf16*)(WSL() + WS_LAT))
#define CS ((float2*)(WSL() + WS_CS))
#define KPE ((bf16*)(WSL() + WS_KPE))
#define OB ((bf16*)(WSL() + WS_OB))
#define QB_ ((bf16*)(WSL() + WS_Q))
#define KN ((bf16*)(WSL() + WS_KN))
#define VV ((bf16*)(WSL() + WS_V))
#define K1 ((bf16*)(WSL() + WS_K1))
#define V1 ((bf16*)(WSL() + WS_V1))
#define QX ((bf16*)(WSL() + WS_QX))
#define OX ((bf16*)(WSL() + WS_OX))
#define U ((bf16*)(WSL() + WS_U))
    float* hres = args.out;
    const int gw = vcu * NWAVES + wave, NGW = G * NWAVES;

    if (IN(PH_PRO)) {
        LAS float* scr = (LAS float*)(lds + RING_OFF + wave * 16384);
        struct Job { const float* W; int K, N; size_t dst; const float* gain; int permq; };
        constexpr int NJ = 16;
        for (int j = 0; j < NJ; ++j) {
            Job jb;
            switch (j) {
                case 0: jb = {args.in[8], DM, NLAT, WS_WDKV, norm_mix, 0}; break;
                case 1: jb = {args.in[11], QLORA, 1536, WS_WUQ, args.in[9], 1}; break;
                case 2: jb = {args.in[12], KVLORA, 2048, WS_WUKV, args.in[10], 0}; break;
                case 3: jb = {args.in[13], DM, DM, WS_WO0, nullptr, 0}; break;
                case 4: jb = {args.in[16], DM, 512, WS_WXQ, norm_cross, 0}; break;
                case 5: jb = {args.in[16] + (size_t)DM * 512, DM, 512, WS_WXQ + (size_t)512 * DM * 2, norm_cross + DM, 0}; break;
                case 6: jb = {args.in[17], DM, DM, WS_WXKV, norm_mem, 0}; break;
                case 7: jb = {args.in[17] + (size_t)DM * DM, DM, DM, WS_WXKV + (size_t)DM * DM * 2, norm_mem + DM, 0}; break;
                case 8: jb = {args.in[18], 512, DM, WS_WXO, nullptr, 0}; break;
                case 9: jb = {args.in[18] + (size_t)512 * DM, 512, DM, WS_WXO + (size_t)DM * 512 * 2, nullptr, 0}; break;
                case 10: jb = {args.in[19], DM, DFF, WS_WIN, norm_mlp, 0}; break;
                case 11: jb = {args.in[19] + (size_t)DM * DFF, DM, DFF, WS_WIN + (size_t)DFF * DM * 2, norm_mlp + DM, 0}; break;
                case 12: jb = {args.in[20], DFF, DM, WS_WOUT, nullptr, 0}; break;
                case 13: jb = {args.in[20] + (size_t)DFF * DM, DFF, DM, WS_WOUT + (size_t)DM * DFF * 2, nullptr, 0}; break;
                case 14: jb = {args.in[14], DM, 3072, WS_WQKV, norm_mix + DM, 0}; break;
                default: jb = {args.in[15], DM, DM, WS_WO1, nullptr, 0}; break;
            }
            const int nitems = (jb.K / 64) * (jb.N / 32);
            for (int it = gw; it < nitems; it += NGW) transpose_item(jb.W, jb.K, jb.N, (bf16*)(WSL() + jb.dst), jb.gain, jb.permq, scr, it, lane);
        }
        { GAS v4u* z = (GAS v4u*)(WSL() + WS_WDKV + (size_t)NLAT * DM * 2); const int n16 = (NLATP - NLAT) * DM * 2 / 16;
            for (int i = blockIdx.x * (NWAVES * 64) + tid; i < n16; i += G * NWAVES * 64) z[i] = (v4u){0u, 0u, 0u, 0u}; }
        for (int i = blockIdx.x * (NWAVES * 64) + tid; i < T * 32; i += G * NWAVES * 64) {
            const int tok = i >> 5, f = i & 31;
            const float inv = powf(10000.0f, -(float)(2 * f) / 64.0f);
            const float ang = (float)positions[tok] * inv;
            CS[i] = make_float2(cosf(ang), sinf(ang));
        }
        for (int m = gw; m < T; m += NGW) rowstat_1024(x + (size_t)m * DM, HB + (size_t)m * DM, rsb + RS_X + m, lane);
        for (int m = gw; m < TM; m += NGW) rowstat_1024(mem + (size_t)m * DM, MEMB + (size_t)m * DM, rsb + RS_MEM + m, lane);
    }
    SEAM(PH_PRO);

    if (IN(PH_DKV)) {
        { pg8::Gemm g{HB, (const bf16*)(WSL() + WS_WDKV), T, NLATP, DM, DM}; pg8::StaticOrder S; S.init(T, NLATP, G, (int)blockIdx.x);
          pg8::EpiB<FLat> E{{LAT, rsb + RS_X}}; pg8::gemm_phase<pg8::EpiB<FLat>, pg8::StaticOrder, true>(lds + RING_OFF, g, S, E); }
        for (int l = 0; l < 2; ++l) {
          pg8::Gemm g{MEMB, (const bf16*)(WSL() + WS_WXKV + (size_t)l * DM * DM * 2), TM, DM, DM, DM}; pg8::StaticOrder S; S.init(TM, DM, G, (int)((blockIdx.x + 64 - 32 * l) % G));
          bf16* kx = (bf16*)(WSL() + WS_KVX + (size_t)l * 4 * MiB);
          pg8::EpiB<FMemKV> E{{kx, kx + (size_t)TM * 512, rsb + RS_MEM}}; pg8::gemm_phase<pg8::EpiB<FMemKV>, pg8::StaticOrder, true>(lds + RING_OFF, g, S, E); }
    }
    SEAM(PH_DKV);

    if (IN(PH_LATSTAT)) {
        for (int m = gw; m < T; m += NGW) {
            const bf16* lr = LAT + (size_t)m * NLATP; float sq = 0.f, skv = 0.f;
#pragma unroll
            for (int j = 0; j < 3; ++j) { const int c = j * 64 + lane; const unsigned long long w = *(const GAS unsigned long long*)(lr + 4 * c);
                const float a0 = bf2f((unsigned short)w), a1 = bf2f((unsigned short)(w >> 16)), a2 = bf2f((unsigned short)(w >> 32)), a3 = bf2f((unsigned short)(w >> 48));
                const float s = (a0 * a0 + a1 * a1) + (a2 * a2 + a3 * a3);
                if (c < 96) sq += s; else if (c < 160) skv += s; }
            sq = wave_sum(sq); skv = wave_sum(skv);
            if (lane == 0) { rsb[RS_Q + m] = 1.0f / sqrtf(sq * (1.0f / QLORA) + EPS); rsb[RS_KV + m] = 1.0f / sqrtf(skv * (1.0f / KVLORA) + EPS); }
            if (lane < 32) { const float x1 = bf2f(lr[640 + lane]), x2 = bf2f(lr[672 + lane]); const float2 c = CS[(size_t)m * 32 + lane];
                *(GAS unsigned*)(KPE + (size_t)m * 64 + 2 * lane) = pk2(x1 * c.x - x2 * c.y, x1 * c.y + x2 * c.x); }
        }
    }
    SEAM(PH_LATSTAT);

    if (IN(PH_UQKV)) {
        { pg8::Gemm g{LAT, (const bf16*)(WSL() + WS_WUQ), T, 1536, QLORA, NLATP}; pg8::StaticOrder S; S.init(T, 1536, G, (int)blockIdx.x);
          pg8::EpiB<FQ0> E{{QB_, rsb + RS_Q, CS}}; pg8::gemm_phase<pg8::EpiB<FQ0>, pg8::StaticOrder, true>(lds + RING_OFF, g, S, E); }
        { pg8::Gemm g{LAT + QLORA, (const bf16*)(WSL() + WS_WUKV), T, 2048, KVLORA, NLATP}; pg8::StaticOrder S; S.init(T, 2048, G, (int)((blockIdx.x + 128) % G));
          pg8::EpiB<FKV0> E{{KN, VV, rsb + RS_KV}}; pg8::gemm_phase<pg8::EpiB<FKV0>, pg8::StaticOrder, true>(lds + RING_OFF, g, S, E); }
    }
    SEAM(PH_UQKV);

    if (IN(PH_ATT0)) {
        for (int pu = vcu; pu < 256; pu += G) { const int bh = pu >> 2, s = pu & 3, b = bh >> 3, h = bh & 7;
            for (int pass = 0; pass < 2; ++pass) { const int qb = pass ? s : 7 - s;
                att::attn_unit<att::MODE_MLA>(lds + RING_OFF, QB_ + ((size_t)bh * SEQ + qb * 256) * DQK, KN + (size_t)bh * SEQ * 128, KPE + (size_t)b * SEQ * 64, VV + (size_t)bh * SEQ * 128,
                    OB + ((size_t)b * SEQ + qb * 256) * DM + h * 128, DM, qb * 256, 0); } }
    }
    SEAM(PH_ATT0);

    for (int layer = 0; layer < 2; ++layer) {
        const int PB = layer ? PH_WO1 : PH_WO0;
        if (layer == 1) {
            if (IN(PH_QKV1)) { pg8::Gemm g{HB, (const bf16*)(WSL() + WS_WQKV), T, 3072, DM, DM}; pg8::StaticOrder S; S.init(T, 3072, G, (int)blockIdx.x);
                pg8::EpiB<FQKV1> E{{QB_, K1, V1, rsb + RS_H}}; pg8::gemm_phase<pg8::EpiB<FQKV1>, pg8::StaticOrder, true>(lds + RING_OFF, g, S, E); }
            SEAM(PH_QKV1);
            if (IN(PH_ATT1)) {
                for (int u = vcu; u < 512; u += G) { const int bh = u >> 3, qb = u & 7, b = bh >> 3, h = bh & 7;
                    att::attn_unit<att::MODE_SB>(lds + RING_OFF, QB_ + ((size_t)bh * SEQ + qb * 256) * 128, K1 + (size_t)bh * SEQ * 128, nullptr, V1 + (size_t)bh * SEQ * 128,
                        OB + ((size_t)b * SEQ + qb * 256) * DM + h * 128, DM, qb * 256, 0); }
            }
            SEAM(PH_ATT1);
        }
        if (IN(PB)) { pg8::Gemm g{OB, (const bf16*)(ws + (layer ? WS_WO1 : WS_WO0)), T, DM, DM, DM}; pg8::StaticOrder S; S.init(T, DM, G, (int)blockIdx.x);
            pg8::EpiRes E{layer ? hres : x, hres, DM}; pg8::gemm_phase<pg8::EpiRes, pg8::StaticOrder, true>(lds + RING_OFF, g, S, E); }
        SEAM(PB);
        if (IN(PB + 1)) { for (int m = gw; m < T; m += NGW) rowstat_1024(hres + (size_t)m * DM, HB + (size_t)m * DM, rsb + RS_H + m, lane); }
        SEAM(PB + 1);
        if (IN(PB + 2)) { pg8::Gemm g{HB, (const bf16*)(WSL() + WS_WXQ + (size_t)layer * 512 * DM * 2), T, 512, DM, DM}; pg8::StaticOrder S; S.init(T, 512, G, (int)blockIdx.x);
            pg8::EpiB<FXQ> E{{QX, rsb + RS_H}}; pg8::gemm_phase<pg8::EpiB<FXQ>, pg8::StaticOrder, true>(lds + RING_OFF, g, S, E); }
        SEAM(PB + 2);
        if (IN(PB + 3)) { const bf16* kx = (const bf16*)(WSL() + WS_KVX + (size_t)layer * 4 * MiB); const bf16* vx = kx + (size_t)TM * 512;
            for (int u = vcu; u < 256; u += G) { const int bh = u >> 3, qb = u & 7, b = bh >> 2, h = bh & 3;
                att::attn_unit<att::MODE_CROSS>(lds + RING_OFF, QX + ((size_t)bh * SEQ + qb * 256) * 128, kx + (size_t)bh * MEMLEN * 128, nullptr, vx + (size_t)bh * MEMLEN * 128,
                    OX + ((size_t)b * SEQ + qb * 256) * 512 + h * 128, 512, 0, MEMLEN); } }
        SEAM(PB + 3);
        if (IN(PB + 4)) { pg8::Gemm g{OX, (const bf16*)(WSL() + WS_WXO + (size_t)layer * DM * 512 * 2), T, DM, 512, 512}; pg8::StaticOrder S; S.init(T, DM, G, (int)blockIdx.x);
            pg8::EpiRes E{hres, hres, DM}; pg8::gemm_phase<pg8::EpiRes, pg8::StaticOrder, true>(lds + RING_OFF, g, S, E); }
        SEAM(PB + 4);
        if (IN(PB + 5)) { for (int m = gw; m < T; m += NGW) rowstat_1024(hres + (size_t)m * DM, HB + (size_t)m * DM, rsb + RS_H + m, lane); }
        SEAM(PB + 5);
        if (IN(PB + 6)) { pg8::Gemm g{HB, (const bf16*)(WSL() + WS_WIN + (size_t)layer * DFF * DM * 2), T, DFF, DM, DM}; pg8::StaticOrder S; S.init(T, DFF, G, (int)blockIdx.x);
            pg8::EpiB<FUp> E{{U, rsb + RS_H}}; pg8::gemm_phase<pg8::EpiB<FUp>, pg8::StaticOrder, true>(lds + RING_OFF, g, S, E); }
        SEAM(PB + 6);
        if (IN(PB + 7)) { pg8::Gemm g{U, (const bf16*)(WSL() + WS_WOUT + (size_t)layer * DM * DFF * 2), T, DM, DFF, DFF}; pg8::StaticOrder S; S.init(T, DM, G, (int)blockIdx.x);
            pg8::EpiRes E{hres, hres, DM}; pg8::gemm_phase<pg8::EpiRes, pg8::StaticOrder, true>(lds + RING_OFF, g, S, E); }
        SEAM(PB + 7);
        if (layer == 0) {
            if (IN(PH_ST3)) { for (int m = gw; m < T; m += NGW) rowstat_1024(hres + (size_t)m * DM, HB + (size_t)m * DM, rsb + RS_H + m, lane); }
            SEAM(PH_ST3);
        } else {
            if (IN(PH_FINAL)) {
                for (int m = gw; m < T; m += NGW) {
                    GAS f32x4* xr = (GAS f32x4*)(hres + (size_t)m * DM) + lane; const GAS f32x4* gr = (const GAS f32x4*)norm_final + lane;
                    f32x4 v[4]; float s = 0.f;
#pragma unroll
                    for (int j = 0; j < 4; ++j) { v[j] = xr[64 * j]; s += (v[j].x * v[j].x + v[j].y * v[j].y) + (v[j].z * v[j].z + v[j].w * v[j].w); }
                    const float r = 1.0f / sqrtf(wave_sum(s) * (1.0f / 1024.0f) + EPS);
#pragma unroll
                    for (int j = 0; j < 4; ++j) xr[64 * j] = v[j] * r * gr[64 * j];
                }
            }
        }
    }
#undef IN
#undef SEAM
}

#ifndef MK_N_LAUNCHES
#define MK_N_LAUNCHES 1
#endif
extern "C" void kernel_launch(void* const* d_in, const int* in_sizes, int n_in, void* d_out, int out_size, void* d_ws, size_t ws_size, hipStream_t stream) {
    static int grid = 0;
    if (grid == 0) {
        if (n_in != 21 || in_sizes[0] != T * DM || out_size != T * DM || ws_size < WS_END) { fprintf(stderr, "kernel_launch: unexpected shapes (n_in %d, in0 %d, out %d, ws %zu)\n", n_in, n_in > 0 ? in_sizes[0] : -1, out_size, ws_size); grid = -1; return; }
        int dev = 0, cus = 0, per_cu = 0;
        if (hipGetDevice(&dev) != hipSuccess || hipDeviceGetAttribute(&cus, hipDeviceAttributeMultiprocessorCount, dev) != hipSuccess) { grid = -1; return; }
        if (hipFuncSetAttribute((const void*)mk_fwd, hipFuncAttributeMaxDynamicSharedMemorySize, LDS_BYTES) != hipSuccess) { fprintf(stderr, "kernel_launch: hipFuncSetAttribute failed\n"); grid = -1; return; }
        if (hipOccupancyMaxActiveBlocksPerMultiprocessor(&per_cu, (const void*)mk_fwd, NWAVES * 64, LDS_BYTES) != hipSuccess || per_cu < 1)
            fprintf(stderr, "kernel_launch: note: occupancy query reports %d workgroups per CU\n", per_cu);
        (void)hipGetLastError();
        grid = cus;
    }
    if (grid < 0) return;
    (void)hipMemsetAsync((char*)d_ws + WS_CTL, 0, CTL_ZERO_BYTES, stream);
    Args a{};
    for (int i = 0; i < 21; ++i) a.in[i] = (const float*)d_in[i];
    a.out = (float*)d_out; a.ws = (unsigned char*)d_ws;
#if MK_N_LAUNCHES == 1
    a.ph_lo = 0; a.ph_hi = NPH;
    hipLaunchKernelGGL(mk_fwd, dim3(grid), dim3(NWAVES * 64), LDS_BYTES, stream, a);
#else
    for (int p = 0; p < NPH; ++p) { a.ph_lo = p; a.ph_hi = p + 1; hipLaunchKernelGGL(mk_fwd, dim3(grid), dim3(NWAVES * 64), LDS_BYTES, stream, a); }
#endif
}
```

```cpp
#include <hip/hip_runtime.h>
#include <cstdio>
#include <cstdint>
namespace pg8 {
#define PG8_LAS __attribute__((address_space(3)))
typedef unsigned short bf16_t;
typedef short bf16x8 __attribute__((ext_vector_type(8)));
typedef float f32x4 __attribute__((ext_vector_type(4)));
typedef unsigned u32x4 __attribute__((ext_vector_type(4)));
constexpr int BM = 256, BK = 64, HALF = 128, HTB = HALF * BK * 2  , STAGE_BYTES = 8 * HTB, NXCD = 8, WGM = 8;

__host__ __device__ __forceinline__ int lds_byte(int r, int c) { const int st = (r >> 4) * 2 + (c >> 5), rr = r & 15, cc = c & 31, ob = rr * 64 + cc * 2; return st * 1024 + (ob ^ (((ob >> 9) & 1) << 5)); }
__host__ __device__ __forceinline__ void stage_rc(int b, int& R, int& C) { const int st = b / 1024, sb = b % 1024, swz = sb ^ (((sb >> 9) & 1) << 5); R = (st >> 1) * 16 + swz / 64; C = (st & 1) * 32 + (swz % 64) / 2; }
__host__ __device__ __forceinline__ int perm32(int rho) { const int n = rho >> 4, i = rho & 15; return 8 * (i >> 2) + 4 * n + (i & 3); }

struct Unit { int pm, pn; };
struct Gemm { const bf16_t* A; const bf16_t* Bt; int M, N, K, lda; };

struct StaticOrder {
    int nM, nN, nwg, G, c;
    __host__ __device__ void init(int M, int N, int G_, int c_) { nM = M / BM; nN = N / BM; nwg = nM * nN; G = G_; c = c_; }
    __host__ __device__ bool next(int i, Unit& u) const {
        const long L = (long)i * G + c; if (L >= nwg) return false;
        int wgid = (int)L; { const int q = nwg / NXCD, r = nwg % NXCD, xcd = wgid % NXCD, off = wgid / NXCD; wgid = (xcd < r ? xcd * (q + 1) : r * (q + 1) + (xcd - r) * q) + off; }
        const int nig = WGM * nN, gid = wgid / nig, fm = gid * WGM, gsz = (nM - fm) < WGM ? (nM - fm) : WGM;
        u.pm = fm + ((wgid % nig) % gsz); u.pn = (wgid % nig) / gsz; return true;
    }
};

__device__ __forceinline__ unsigned cvt_pk_bf16(float lo, float hi) { unsigned r; asm volatile("v_cvt_pk_bf16_f32 %0, %1, %2" : "=v"(r) : "v"(lo), "v"(hi)); return r; }

template <class F> struct EpiB {
    static constexpr bool PERM = true;
    F f;
    __device__ __forceinline__ void operator()(const f32x4 (&acc)[2][2][4][2], const Unit& u, int wr, int wc, int fr, int fq) const {
        const int row0 = u.pm * BM + wr * 64 + fr, col0 = u.pn * BM + wc * 32 + 8 * fq;
#pragma unroll
        for (int ai = 0; ai < 2; ++ai)
#pragma unroll
            for (int m = 0; m < 4; ++m) { const int row = row0 + ai * HALF + m * 16; const float rsc = f.rowscale(row);
#pragma unroll
                for (int bj = 0; bj < 2; ++bj) f(row, col0 + bj * HALF, acc[ai][bj][m][0] * rsc, acc[ai][bj][m][1] * rsc); }
    }
};
struct EpiRes {
    static constexpr bool PERM = false;
    const float* base; float* out; int ldc;
    __device__ __forceinline__ void operator()(const f32x4 (&acc)[2][2][4][2], const Unit& u, int wr, int wc, int fr, int fq) const {
        const int row0 = u.pm * BM + wr * 64 + fr, col0 = u.pn * BM + wc * 32 + 4 * fq;
#pragma unroll
        for (int ai = 0; ai < 2; ++ai)
#pragma unroll
            for (int m = 0; m < 4; ++m) { const size_t off = (size_t)(row0 + ai * HALF + m * 16) * ldc + col0;
#pragma unroll
                for (int bj = 0; bj < 2; ++bj)
#pragma unroll
                    for (int n = 0; n < 2; ++n) { const size_t o = off + bj * HALF + n * 16; *(f32x4*)(out + o) = *(const f32x4*)(base + o) + acc[ai][bj][m][n]; } }
    }
};

struct EpiResN {
    static constexpr bool PERM = true;
    const float* base; float* out; bf16_t* hb; float* ssqp;
    __device__ __forceinline__ void operator()(const f32x4 (&acc)[2][2][4][2], const Unit& u, int wr, int wc, int fr, int fq) const {
        const int row0 = u.pm * BM + wr * 64 + fr, col0 = u.pn * BM + wc * 32 + 8 * fq;
#pragma unroll
        for (int ai = 0; ai < 2; ++ai)
#pragma unroll
            for (int m = 0; m < 4; ++m) { const int row = row0 + ai * HALF + m * 16; float ss = 0.f;
#pragma unroll
                for (int bj = 0; bj < 2; ++bj) { const size_t o = (size_t)row * 1024 + col0 + bj * HALF;
                    const f32x4 a = *(const f32x4*)(base + o) + acc[ai][bj][m][0], b = *(const f32x4*)(base + o + 4) + acc[ai][bj][m][1];
                    *(f32x4*)(out + o) = a; *(f32x4*)(out + o + 4) = b;
                    u32x4 w; w.x = cvt_pk_bf16(a[0], a[1]); w.y = cvt_pk_bf16(a[2], a[3]); w.z = cvt_pk_bf16(b[0], b[1]); w.w = cvt_pk_bf16(b[2], b[3]); *(u32x4*)(hb + o) = w;
                    ss += ((a[0] * a[0] + a[1] * a[1]) + (a[2] * a[2] + a[3] * a[3])) + ((b[0] * b[0] + b[1] * b[1]) + (b[2] * b[2] + b[3] * b[3])); }
                ss += __shfl_xor(ss, 16); ss += __shfl_xor(ss, 32);
                if (fq == 0) ssqp[(size_t)row * 16 + u.pn * 4 + wc] = ss; }
    }
};

template <class Epi, class Sched, bool ALIGN_EPI>
__device__ __forceinline__ void gemm_phase(PG8_LAS unsigned char* lds, const Gemm g, const Sched& S, const Epi& E) {
    int tid = threadIdx.x; asm volatile("" : "+v"(tid));
    const int wid = __builtin_amdgcn_readfirstlane(tid >> 6), lane = tid & 63, wr = wid >> 2, wc = wid & 3, fr = lane & 15, fq = lane >> 4;
    const int K = g.K, nt = K / BK;
    unsigned voffA[2], voffB[2];
#pragma unroll
    for (int i = 0; i < 2; ++i) { int R, C; stage_rc(tid * 16 + i * 8192, R, C); const int Rb = Epi::PERM ? ((R & ~31) + perm32(R & 31)) : R;
        voffA[i] = (unsigned)(R * g.lda + C) * 2u; voffB[i] = (unsigned)(Rb * K + C) * 2u; }
    const size_t kstep = (size_t)(BK * 2);
    const size_t hstepA = (size_t)HALF * g.lda * 2, hstepB = (size_t)HALF * K * 2;
    const size_t tstepA = 2 * hstepA, tstepB = 2 * hstepB;
    const unsigned ldsw = (unsigned)wid * 1024u;
    const int aoff = lds_byte(wr * 64 + fr, fq * 8), boff = lds_byte(wc * 32 + fr, fq * 8);
#define PG8_SA(b, h) (((b) * 2 + (h)) * HTB)
#define PG8_SB(b, h) ((4 + (b) * 2 + (h)) * HTB)
#define PG8_STAGE(bufoff, gbase, voff) do { _Pragma("unroll") for (int _i = 0; _i < 2; ++_i) \
        __builtin_amdgcn_global_load_lds((const unsigned*)((const char*)(gbase) + (voff)[_i]), (PG8_LAS unsigned*)(lds + (bufoff) + ldsw + _i * 8192), 16, 0, 0); } while (0)
#define PG8_LDA(dst, b, h) do { _Pragma("unroll") for (int m = 0; m < 4; ++m) _Pragma("unroll") for (int k = 0; k < 2; ++k) dst[m][k] = *(const PG8_LAS bf16x8*)(lds + PG8_SA(b, h) + aoff + m * 2048 + k * 1024); } while (0)
#define PG8_LDB(dst, b, h) do { _Pragma("unroll") for (int n = 0; n < 2; ++n) _Pragma("unroll") for (int k = 0; k < 2; ++k) dst[n][k] = *(const PG8_LAS bf16x8*)(lds + PG8_SB(b, h) + boff + n * 2048 + k * 1024); } while (0)
#define PG8_MMA(ai, bj, At, Bt) do { __builtin_amdgcn_s_setprio(1); _Pragma("unroll") for (int m = 0; m < 4; ++m) _Pragma("unroll") for (int n = 0; n < 2; ++n) _Pragma("unroll") for (int k = 0; k < 2; ++k) \
        acc[ai][bj][m][n] = __builtin_amdgcn_mfma_f32_16x16x32_bf16(Bt[n][k], At[m][k], acc[ai][bj][m][n], 0, 0, 0); __builtin_amdgcn_s_setprio(0); } while (0)
#define PG8_WAIT_V(n) asm volatile("s_waitcnt vmcnt(" #n ")" ::: "memory")
#define PG8_WAIT_L(n) asm volatile("s_waitcnt lgkmcnt(" #n ")" ::: "memory")
#define PG8_BAR __builtin_amdgcn_s_barrier()
#define PG8_SCHED __builtin_amdgcn_sched_barrier(0)
    Unit cur, nxt; int ui = 0;
    if (!S.next(0, cur)) return;
    f32x4 acc[2][2][4][2];
#pragma unroll
    for (int a = 0; a < 2; ++a)
#pragma unroll
        for (int b = 0; b < 2; ++b)
#pragma unroll
            for (int m = 0; m < 4; ++m)
#pragma unroll
                for (int n = 0; n < 2; ++n) acc[a][b][m][n] = (f32x4){0.f, 0.f, 0.f, 0.f};
    bf16x8 At[4][2], B0[2][2], B1[2][2];
    const char* cA = (const char*)g.A + (size_t)cur.pm * tstepA; const char* cB = (const char*)g.Bt + (size_t)cur.pn * tstepB;
    PG8_STAGE(PG8_SB(0, 0), cB, voffB); PG8_STAGE(PG8_SB(0, 1), cB + hstepB, voffB); PG8_STAGE(PG8_SA(0, 0), cA, voffA); PG8_STAGE(PG8_SA(0, 1), cA + hstepA, voffA);
    if (wr == 1) PG8_BAR;
    PG8_WAIT_V(2); PG8_BAR;
    PG8_STAGE(PG8_SB(1, 0), cB + kstep, voffB); PG8_STAGE(PG8_SA(1, 0), cA + kstep, voffA); PG8_STAGE(PG8_SB(1, 1), cB + hstepB + kstep, voffB);
    PG8_WAIT_V(6); PG8_BAR;
    for (;;) {
        const bool has_next = S.next(ui + 1, nxt);
        const char* nA = has_next ? (const char*)g.A + (size_t)nxt.pm * tstepA : cA; const char* nB = has_next ? (const char*)g.Bt + (size_t)nxt.pn * tstepB : cB;
#pragma nounroll
        for (int t = 0; t < nt; t += 2) {
            const bool last = (t == nt - 2);
            const char* a1 = cA + (size_t)(t + 1) * kstep;
            const char* a2 = last ? nA : cA + (size_t)(t + 2) * kstep; const char* b2 = last ? nB : cB + (size_t)(t + 2) * kstep;
            const char* a3 = a2 + kstep; const char* b3 = b2 + kstep;
            PG8_LDB(B0, 0, 0); PG8_LDB(B1, 0, 1); PG8_SCHED; PG8_LDA(At, 0, 0); PG8_STAGE(PG8_SA(1, 1), a1 + hstepA, voffA);
            PG8_WAIT_V(8); PG8_WAIT_L(0); PG8_BAR; PG8_MMA(0, 0, At, B0); PG8_MMA(0, 1, At, B1); PG8_BAR; PG8_SCHED;
            PG8_LDA(At, 0, 1); PG8_STAGE(PG8_SB(0, 0), b2, voffB); PG8_STAGE(PG8_SB(0, 1), b2 + hstepB, voffB); PG8_STAGE(PG8_SA(0, 0), a2, voffA);
            PG8_WAIT_V(8); PG8_WAIT_L(0); PG8_BAR; PG8_MMA(1, 0, At, B0); PG8_MMA(1, 1, At, B1); PG8_BAR; PG8_SCHED;
            PG8_LDB(B0, 1, 0); PG8_LDB(B1, 1, 1); PG8_SCHED; PG8_LDA(At, 1, 0); PG8_STAGE(PG8_SA(0, 1), a2 + hstepA, voffA);
            PG8_WAIT_V(8); PG8_WAIT_L(0); PG8_BAR; PG8_MMA(0, 0, At, B0); PG8_MMA(0, 1, At, B1); PG8_BAR; PG8_SCHED;
            PG8_LDA(At, 1, 1); PG8_STAGE(PG8_SB(1, 0), b3, voffB); PG8_STAGE(PG8_SB(1, 1), b3 + hstepB, voffB); PG8_STAGE(PG8_SA(1, 0), a3, voffA);
            PG8_WAIT_V(8); PG8_WAIT_L(0); PG8_BAR; PG8_MMA(1, 0, At, B0); PG8_MMA(1, 1, At, B1); PG8_BAR; PG8_SCHED;
        }
        if constexpr (ALIGN_EPI) { if (wr == 0) PG8_BAR; }
        E(acc, cur, wr, wc, fr, fq);
        if (!has_next) break;
#pragma unroll
        for (int a = 0; a < 2; ++a)
#pragma unroll
            for (int b = 0; b < 2; ++b)
#pragma unroll
                for (int m = 0; m < 4; ++m)
#pragma unroll
                    for (int n = 0; n < 2; ++n) acc[a][b][m][n] = (f32x4){0.f, 0.f, 0.f, 0.f};
        cur = nxt; cA = nA; cB = nB; ++ui;
        if constexpr (ALIGN_EPI) { if (wr == 1) PG8_BAR; }
    }
    PG8_WAIT_V(0);
    if constexpr (!ALIGN_EPI) { if (wr == 0) PG8_BAR; }
    PG8_BAR;
#undef PG8_SA
#undef PG8_SB
#undef PG8_STAGE
#undef PG8_LDA
#undef PG8_LDB
#undef PG8_MMA
#undef PG8_WAIT_V
#undef PG8_WAIT_L
#undef PG8_BAR
#undef PG8_SCHED
}
}
namespace att {
typedef unsigned short bf16_t;
typedef short bf16x8 __attribute__((ext_vector_type(8)));
typedef short s16x4 __attribute__((ext_vector_type(4)));
typedef float f32x16 __attribute__((ext_vector_type(16)));
typedef float f32x4 __attribute__((ext_vector_type(4)));
typedef unsigned u32x4 __attribute__((ext_vector_type(4)));
#define ATT_LAS __attribute__((address_space(3)))
constexpr int KVBLK = 64, QBLK = 32, QB = 256;
constexpr int L_K = 0, L_V = 16384, L_PE = 32768, L_WS = 40960, L_FLAG = 40960 + 2048, LDS_BYTES = 40960 + 2048 + 64;
enum { MODE_MLA = 0, MODE_CROSS = 1, MODE_SB = 2 };

#define ATT_KSWZ(row, colB) ((row) * 256 + ((colB) ^ (((row) & 7) << 4)))
#define ATT_PESWZ(row, ch) ((row) * 128 + ((((ch) ^ (((row) >> 1) & 7))) << 4))
#define ATT_SBAR() __builtin_amdgcn_sched_barrier(0)
__device__ __forceinline__ int v_st(int k, int c) { const int kk = (k & ~0xC) | ((k & 4) << 1) | ((k & 8) >> 1); return ((kk >> 3) * 4 + (c >> 5)) * 512 + ((kk & 7) * 32 + (c & 31)) * 2; }
__device__ __forceinline__ int v_rd_base(int lane) { return ((lane & 3) << 3) | (((lane >> 2) & 3) << 6) | (((lane >> 4) & 1) << 5) | (((lane >> 5) & 1) << 8); }
__device__ __forceinline__ int crow(int r, int hi) { return (r & 3) + 8 * (r >> 2) + 4 * hi; }
__device__ __forceinline__ unsigned cvtpk(float lo, float hi) { unsigned r; asm volatile("v_cvt_pk_bf16_f32 %0, %1, %2" : "=v"(r) : "v"(lo), "v"(hi)); return r; }
__device__ __forceinline__ float swap_add(float v) { auto rr = __builtin_amdgcn_permlane32_swap(__float_as_uint(v), __float_as_uint(v), false, false); return __uint_as_float(rr[0]) + __uint_as_float(rr[1]); }
__device__ __forceinline__ float swap_max(float v) { auto rr = __builtin_amdgcn_permlane32_swap(__float_as_uint(v), __float_as_uint(v), false, false); return fmaxf(__uint_as_float(rr[0]), __uint_as_float(rr[1])); }
__device__ __forceinline__ float swap_other(float v, int hi) { auto rr = __builtin_amdgcn_permlane32_swap(__float_as_uint(v), __float_as_uint(v), false, false);
    const float a = __uint_as_float(rr[0]), b = __uint_as_float(rr[1]); return hi ? a : b; }

__device__ __forceinline__ void pack_p(const f32x16& p0, const f32x16& p1, bf16x8& pa0, bf16x8& pa1, bf16x8& pa2, bf16x8& pa3) {
#define ATT_PK4(P, B_, OUT) do { unsigned a0 = cvtpk(P[B_+0], P[B_+1]), a1 = cvtpk(P[B_+2], P[B_+3]);                          \
        unsigned b0 = cvtpk(P[B_+4], P[B_+5]), b1 = cvtpk(P[B_+6], P[B_+7]);                                             \
        auto r0 = __builtin_amdgcn_permlane32_swap(a0, b0, false, false); auto r1 = __builtin_amdgcn_permlane32_swap(a1, b1, false, false); \
        u32x4 w = {r0[0], r1[0], r0[1], r1[1]}; OUT = *reinterpret_cast<bf16x8*>(&w); } while (0)
    ATT_PK4(p0, 0, pa0); ATT_PK4(p0, 8, pa1); ATT_PK4(p1, 0, pa2); ATT_PK4(p1, 8, pa3);
#undef ATT_PK4
}
__device__ __forceinline__ void pv_tile(f32x16* o, int vb0, bf16x8 pa0, bf16x8 pa1, bf16x8 pa2, bf16x8 pa3) {
#define ATT_TRRD(dst, off) asm volatile("ds_read_b64_tr_b16 %0, %1 offset:%2" : "=&v"(dst) : "v"(vb0), "i"(off) : "memory")
#define ATT_PV_D0(d0) do { s16x4 l0, l1, l2, l3, h0, h1, h2, h3; constexpr int b_ = (d0) * 512;   \
        ATT_TRRD(l0, b_); ATT_TRRD(h0, b_ + 2048); ATT_TRRD(l1, b_ + 4096); ATT_TRRD(h1, b_ + 6144); ATT_TRRD(l2, b_ + 8192); ATT_TRRD(h2, b_ + 10240); ATT_TRRD(l3, b_ + 12288); ATT_TRRD(h3, b_ + 14336); \
        asm volatile("s_waitcnt lgkmcnt(0)" ::: "memory"); ATT_SBAR();   \
        o[d0] = __builtin_amdgcn_mfma_f32_32x32x16_bf16(pa0, (bf16x8){l0[0], l0[1], l0[2], l0[3], h0[0], h0[1], h0[2], h0[3]}, o[d0], 0, 0, 0);   \
        o[d0] = __builtin_amdgcn_mfma_f32_32x32x16_bf16(pa1, (bf16x8){l1[0], l1[1], l1[2], l1[3], h1[0], h1[1], h1[2], h1[3]}, o[d0], 0, 0, 0);   \
        o[d0] = __builtin_amdgcn_mfma_f32_32x32x16_bf16(pa2, (bf16x8){l2[0], l2[1], l2[2], l2[3], h2[0], h2[1], h2[2], h2[3]}, o[d0], 0, 0, 0);   \
        o[d0] = __builtin_amdgcn_mfma_f32_32x32x16_bf16(pa3, (bf16x8){l3[0], l3[1], l3[2], l3[3], h3[0], h3[1], h3[2], h3[3]}, o[d0], 0, 0, 0); } while (0)
    ATT_PV_D0(0); ATT_PV_D0(1); ATT_PV_D0(2); ATT_PV_D0(3);
#undef ATT_PV_D0
#undef ATT_TRRD
}

template <int MODE>
__device__ __forceinline__ void attn_unit(ATT_LAS unsigned char* lds, const bf16_t* Qb, const bf16_t* Kn, const bf16_t* Kpe, const bf16_t* Vp, bf16_t* Ob, int ostride, int q0, int nkeys) {
    constexpr int DKQ = (MODE == MODE_MLA) ? 192 : 128, NQF = DKQ / 16;
    int tid = threadIdx.x; asm volatile("" : "+v"(tid));
    const int wid = __builtin_amdgcn_readfirstlane(tid >> 6), lane = tid & 63, r32 = lane & 31, hi = lane >> 5;
    ATT_LAS float* ws = (ATT_LAS float*)(lds + L_WS) + wid * 64; ATT_LAS float* li_l = ws; ATT_LAS float* al_l = ws + 32;
    volatile ATT_LAS int* flags = (volatile ATT_LAS int*)(lds + L_FLAG);
    const int vb0 = (int)(unsigned)(uintptr_t)(lds + L_V) + v_rd_base(lane);
    bf16x8 qr[NQF];
#pragma unroll
    for (int d0 = 0; d0 < NQF; ++d0) qr[d0] = *(const bf16x8*)(Qb + (size_t)(wid * QBLK + r32) * DKQ + d0 * 16 + hi * 8);
    const int qlo = q0 + wid * QBLK;
    const int qpos = qlo + r32;
    float m_reg = -1e30f, l_reg = 0.f, Rrun = 0.f;
    f32x16 o[4]; o[0] = f32x16{}; o[1] = f32x16{}; o[2] = f32x16{}; o[3] = f32x16{};
    const int sr = tid >> 4, sc = (tid & 15) * 8;
    const int kws = ATT_KSWZ(sr, sc * 2), vst0 = v_st(sr, sc), vst1 = v_st(32 + sr, sc);
    const int per = tid >> 3, pech = tid & 7, pews = ATT_PESWZ(per, pech);
    int NT;
    if (MODE == MODE_CROSS) NT = nkeys / KVBLK; else NT = (q0 + QB) / KVBLK;
    if (MODE == MODE_SB) { if (tid < 8) flags[tid] = 0; }
    for (int it = 0; it < NT; ++it) {
        const int t = (MODE == MODE_SB) ? (NT - 1 - it) : it;
        const int kb = t * KVBLK;
        __syncthreads();
        if (MODE == MODE_SB && it > 0) { int alld = 1;
#pragma unroll
            for (int w = 0; w < 8; ++w) alld &= flags[w];
            if (alld) break; }
        {
            const u32x4 k0v = *(const u32x4*)(Kn + (size_t)(kb + sr) * 128 + sc), k1v = *(const u32x4*)(Kn + (size_t)(kb + 32 + sr) * 128 + sc);
            const u32x4 v0v = *(const u32x4*)(Vp + (size_t)(kb + sr) * 128 + sc), v1v = *(const u32x4*)(Vp + (size_t)(kb + 32 + sr) * 128 + sc);
            u32x4 pev; if (MODE == MODE_MLA) pev = *(const u32x4*)(Kpe + (size_t)(kb + per) * 64 + pech * 8);
            *(ATT_LAS u32x4*)(lds + L_K + kws) = k0v; *(ATT_LAS u32x4*)(lds + L_K + kws + 32 * 256) = k1v;
            *(ATT_LAS u32x4*)(lds + L_V + vst0) = v0v; *(ATT_LAS u32x4*)(lds + L_V + vst1) = v1v;
            if (MODE == MODE_MLA) *(ATT_LAS u32x4*)(lds + L_PE + pews) = pev;
        }
        __syncthreads();
        bool act = true;
        if (MODE == MODE_MLA) act = (kb <= qlo + QBLK - 1);
        if (MODE == MODE_SB) act = (kb < qlo + QBLK - 1);
        if (act && MODE != MODE_SB) {
            f32x16 p0 = f32x16{}, p1 = f32x16{};
#pragma unroll
            for (int d0 = 0; d0 < 8; ++d0) {
                const int off = ATT_KSWZ(r32, ((d0 & 3) * 16 + hi * 8) * 2) + (d0 >> 2) * 128;
                const bf16x8 b0 = *(const ATT_LAS bf16x8*)(lds + L_K + off);
                const bf16x8 b1 = *(const ATT_LAS bf16x8*)(lds + L_K + off + 32 * 256);
                p0 = __builtin_amdgcn_mfma_f32_32x32x16_bf16(b0, qr[d0], p0, 0, 0, 0);
                p1 = __builtin_amdgcn_mfma_f32_32x32x16_bf16(b1, qr[d0], p1, 0, 0, 0);
            }
            if (MODE == MODE_MLA) {
#pragma unroll
                for (int d0 = 8; d0 < NQF; ++d0) {
                    const int off = ATT_PESWZ(r32, (d0 - 8) * 2 + hi);
                    const bf16x8 b0 = *(const ATT_LAS bf16x8*)(lds + L_PE + off);
                    const bf16x8 b1 = *(const ATT_LAS bf16x8*)(lds + L_PE + off + 32 * 128);
                    p0 = __builtin_amdgcn_mfma_f32_32x32x16_bf16(b0, qr[d0], p0, 0, 0, 0);
                    p1 = __builtin_amdgcn_mfma_f32_32x32x16_bf16(b1, qr[d0], p1, 0, 0, 0);
                }
            }
            bf16x8 pa0, pa1, pa2, pa3;
            if (MODE == MODE_MLA && kb + KVBLK - 1 > qlo) {
                const float NEG = -__builtin_inff();
#pragma unroll
                for (int r = 0; r < 16; ++r) { const int key = kb + crow(r, hi); if (key > qpos) p0[r] = NEG; if (key + 32 > qpos) p1[r] = NEG; }
            }
            float pmax = p0[0];
#pragma unroll
            for (int r = 1; r < 16; ++r) pmax = fmaxf(pmax, p0[r]);
#pragma unroll
            for (int r = 0; r < 16; ++r) pmax = fmaxf(pmax, p1[r]);
            pmax = swap_max(pmax);
            const float mn = fmaxf(m_reg, pmax), alpha = __builtin_amdgcn_exp2f(m_reg - mn); m_reg = mn;
            float ps = 0.f;
#pragma unroll
            for (int r = 0; r < 16; ++r) { p0[r] = __builtin_amdgcn_exp2f(p0[r] - mn); ps += p0[r]; }
#pragma unroll
            for (int r = 0; r < 16; ++r) { p1[r] = __builtin_amdgcn_exp2f(p1[r] - mn); ps += p1[r]; }
            ps = swap_add(ps);
            l_reg = l_reg * alpha + ps;
            if (__any(alpha < 1.f)) {
                if (hi == 0) al_l[r32] = alpha;
                asm volatile("s_waitcnt lgkmcnt(0)" ::: "memory");
#pragma unroll
                for (int r = 0; r < 16; ++r) { const float a = al_l[crow(r, hi)];
#pragma unroll
                    for (int d_ = 0; d_ < 4; ++d_) o[d_][r] *= a; }
            }
            pack_p(p0, p1, pa0, pa1, pa2, pa3);
            ATT_SBAR();
            pv_tile(o, vb0, pa0, pa1, pa2, pa3);
        }
        if (act && MODE == MODE_SB) {
            const bool needmask = (kb + KVBLK - 1 >= qlo);
            bf16x8 pa[4];
#pragma unroll
            for (int half = 1; half >= 0; --half) {
                f32x16 p = f32x16{};
#pragma unroll
                for (int d0 = 0; d0 < 8; ++d0) {
                    const int off = ATT_KSWZ(r32, ((d0 & 3) * 16 + hi * 8) * 2) + (d0 >> 2) * 128 + half * 32 * 256;
                    const bf16x8 b0 = *(const ATT_LAS bf16x8*)(lds + L_K + off);
                    p = __builtin_amdgcn_mfma_f32_32x32x16_bf16(b0, qr[d0], p, 0, 0, 0);
                }
                f32x16 L;
#pragma unroll
                for (int r = 0; r < 16; ++r) { const float z = p[r], az = fabsf(z); const float sp = fmaxf(z, 0.f) + __builtin_amdgcn_logf(1.f + __builtin_amdgcn_exp2f(-az)); L[r] = -sp; p[r] = z - sp; }
                if (needmask) {
#pragma unroll
                    for (int r = 0; r < 16; ++r) { const int key = kb + half * 32 + crow(r, hi); if (key >= qpos) L[r] = 0.f; }
                }
                float g[4], h[4];
#pragma unroll
                for (int i = 0; i < 4; ++i) g[i] = (L[4 * i] + L[4 * i + 1]) + (L[4 * i + 2] + L[4 * i + 3]);
#pragma unroll
                for (int i = 0; i < 4; ++i) h[i] = swap_other(g[i], hi);
                float os[4]; float run = Rrun;
#pragma unroll
                for (int i = 3; i >= 0; --i) { os[i] = run; run += g[i] + h[i]; }
#pragma unroll
                for (int i = 0; i < 4; ++i) {
                    float e = os[i] + (hi == 0 ? h[i] : 0.f);
#pragma unroll
                    for (int j = 3; j >= 0; --j) { const float lsg = p[4 * i + j]; p[4 * i + j] = __builtin_amdgcn_exp2f(lsg + e); e += L[4 * i + j]; }
                }
                if (needmask) {
#pragma unroll
                    for (int r = 0; r < 16; ++r) { const int key = kb + half * 32 + crow(r, hi); if (key >= qpos) p[r] = 0.f; }
                }
                Rrun = run;
#define ATT_PK4(P, B_, OUT) do { unsigned a0 = cvtpk(P[B_+0], P[B_+1]), a1 = cvtpk(P[B_+2], P[B_+3]);                          \
        unsigned b0 = cvtpk(P[B_+4], P[B_+5]), b1 = cvtpk(P[B_+6], P[B_+7]);                                             \
        auto r0 = __builtin_amdgcn_permlane32_swap(a0, b0, false, false); auto r1 = __builtin_amdgcn_permlane32_swap(a1, b1, false, false); \
        u32x4 w = {r0[0], r1[0], r0[1], r1[1]}; OUT = *reinterpret_cast<bf16x8*>(&w); } while (0)
                ATT_PK4(p, 0, pa[2 * half]); ATT_PK4(p, 8, pa[2 * half + 1]);
#undef ATT_PK4
            }
            ATT_SBAR();
            pv_tile(o, vb0, pa[0], pa[1], pa[2], pa[3]);
        }
        if (MODE == MODE_SB) { const int dn = (act && __all(Rrun < -152.0f)) ? 1 : 0; if (lane == 0) flags[wid] = dn; }
    }
    float rli[16];
    if (MODE != MODE_SB) {
        if (hi == 0) li_l[r32] = l_reg;
        asm volatile("s_waitcnt lgkmcnt(0)" ::: "memory");
#pragma unroll
        for (int r = 0; r < 16; ++r) rli[r] = 1.0f / li_l[crow(r, hi)];
    } else {
#pragma unroll
        for (int r = 0; r < 16; ++r) rli[r] = 1.0f;
    }
    bf16_t* Ow = Ob + (size_t)(wid * QBLK) * ostride;
#pragma unroll
    for (int r = 0; r < 16; ++r) { const int orow = crow(r, hi);
#pragma unroll
        for (int d0 = 0; d0 < 4; ++d0) { const float v = o[d0][r] * rli[r]; const float vn = __shfl_xor(v, 1);
            if ((r32 & 1) == 0) *(unsigned*)(Ow + (size_t)orow * ostride + d0 * 32 + r32) = cvtpk(v, vn); } }
    __syncthreads();
}
}
constexpr int NWAVES = 8;
constexpr int BATCH = 8, SEQ = 2048, DM = 1024, T = BATCH * SEQ;
constexpr int MEMLEN = 256, TM = BATCH * MEMLEN;
constexpr int QLORA = 384, KVLORA = 256, ROPE = 64, NLAT = 704, NLATP = 768;
constexpr int HEADS = 8, NOPE = 128, DQK = 192, DV = 128;
constexpr int XH = 4, DFF = 4096;
constexpr float EPS = 1e-6f;
constexpr float LOG2E = 1.4426950408889634f;
constexpr float QSCALE_MLA = 0.07216878364870322f * LOG2E;
constexpr float QSCALE_128 = 0.08838834764831845f * LOG2E;

constexpr size_t MiB = 1u << 20;
constexpr size_t WS_CTL = 0, CTL_ZERO_BYTES = 64 * 1024;
constexpr size_t WS_RS = 1 * MiB / 2;
constexpr size_t WS_WDKV = 1 * MiB;
constexpr size_t WS_WUQ = WS_WDKV + (size_t)NLATP * DM * 2;
constexpr size_t WS_WUKV = WS_WUQ + (size_t)1536 * 384 * 2;
constexpr size_t WS_WO0 = WS_WUKV + (size_t)2048 * 256 * 2;
constexpr size_t WS_WXQ = WS_WO0 + (size_t)DM * DM * 2;
constexpr size_t WS_WXKV = WS_WXQ + 2 * (size_t)512 * DM * 2;
constexpr size_t WS_WXO = WS_WXKV + 2 * (size_t)DM * DM * 2;
constexpr size_t WS_WIN = WS_WXO + 2 * (size_t)DM * 512 * 2;
constexpr size_t WS_WOUT = WS_WIN + 2 * (size_t)DFF * DM * 2;
constexpr size_t WS_WQKV = WS_WOUT + 2 * (size_t)DM * DFF * 2;
constexpr size_t WS_WO1 = WS_WQKV + (size_t)3072 * DM * 2;
constexpr size_t WS_WEND = WS_WO1 + (size_t)DM * DM * 2;
static_assert(WS_WEND <= 56 * MiB, "weights");
constexpr size_t WS_HB = 56 * MiB;
constexpr size_t WS_KVX = 88 * MiB;
constexpr size_t WS_CS = 96 * MiB;
constexpr size_t WS_KPE = 100 * MiB;
constexpr size_t WS_MEMB = 102 * MiB;
constexpr size_t WS_SSQ = 106 * MiB;
constexpr size_t WS_X = 107 * MiB;
constexpr size_t WS_LAT = WS_X;
constexpr size_t WS_OB = WS_X;
constexpr size_t WS_Q = WS_X + 32 * MiB;
constexpr size_t WS_KN = WS_X + 80 * MiB;
constexpr size_t WS_V = WS_X + 112 * MiB;
constexpr size_t WS_K1 = WS_X + 64 * MiB, WS_V1 = WS_X + 96 * MiB;
constexpr size_t WS_QX = WS_X, WS_OX = WS_X + 16 * MiB;
constexpr size_t WS_U = WS_X;
constexpr size_t WS_END = WS_X + 144 * MiB;
static_assert(WS_END <= 256 * MiB, "d_ws map");
constexpr int RS_X = 0, RS_Q = T, RS_KV = 2 * T, RS_H = 3 * T, RS_MEM = 4 * T;
constexpr int CW_BAR = 1024;

constexpr int RING_OFF = 0, RING_BYTES = 131072;
constexpr int LDSCTL_OFF = RING_BYTES, MISC_OFF = LDSCTL_OFF + 320;
constexpr int LDS_BYTES = 147456;

#define GAS __attribute__((address_space(1)))
#define LAS __attribute__((address_space(3)))
typedef unsigned short bf16;
typedef unsigned v4u __attribute__((ext_vector_type(4)));
typedef float f32x4 __attribute__((ext_vector_type(4)));
typedef GAS unsigned gu32;
#define RLX_AGENT __ATOMIC_RELAXED, __HIP_MEMORY_SCOPE_AGENT
#define LDS_WAIT() asm volatile("s_waitcnt lgkmcnt(0)" ::: "memory")
#define VM_WAIT() asm volatile("s_waitcnt vmcnt(0)" ::: "memory")
__device__ __forceinline__ unsigned f2bf(float f) { unsigned u = __builtin_bit_cast(unsigned, f); return (u + 0x7fffu + ((u >> 16) & 1u)) >> 16; }
__device__ __forceinline__ unsigned pk2(float lo, float hi) { return f2bf(lo) | (f2bf(hi) << 16); }
__device__ __forceinline__ float bf2f(unsigned short b) { return __builtin_bit_cast(float, (unsigned)b << 16); }
__device__ __forceinline__ void store8(bf16* p, f32x4 a, f32x4 b) { v4u w; w.x = pg8::cvt_pk_bf16(a[0], a[1]); w.y = pg8::cvt_pk_bf16(a[2], a[3]); w.z = pg8::cvt_pk_bf16(b[0], b[1]); w.w = pg8::cvt_pk_bf16(b[2], b[3]); *(v4u*)p = w; }

#define XB_TMO      128
#define XB_XCNT(j)  (256  + 64 * (j))
#define XB_XSUB(j)  (1280 + 64 * (j))
#define XB_XGEN(j)  (2304 + 64 * (j))
#define XB_TOP      3328
#define XB_TOPGEN   3392
#define XCD_BAR_WORDS 3456
#define XB_SPIN_CAP (1u << 18)
__device__ __forceinline__ unsigned xb_ld(unsigned* p)              { return __hip_atomic_load(p, __ATOMIC_RELAXED, __HIP_MEMORY_SCOPE_AGENT); }
__device__ __forceinline__ unsigned xb_add(unsigned* p, unsigned v) { return __hip_atomic_fetch_add(p, v, __ATOMIC_RELAXED, __HIP_MEMORY_SCOPE_AGENT); }
__device__ __forceinline__ unsigned xb_xcc_id() { return (unsigned)__builtin_amdgcn_s_getreg((3 << 11) | 20) & 0xFu; }
#define XB_SPIN(cond, bar) do { unsigned _sp = 0; while (cond) { __builtin_amdgcn_s_sleep(1); \
    if ((++_sp & 255u) == 0u) { if (xb_ld(&(bar)[XB_TMO])) break; if (_sp > XB_SPIN_CAP) { atomicAdd(&(bar)[XB_TMO], 1u); break; } } } } while (0)
struct XcdBarrier { unsigned* bar; unsigned x; volatile LAS unsigned* st; };
__device__ __forceinline__ XcdBarrier xcd_barrier_post(unsigned* bar, volatile LAS unsigned* st) {
    XcdBarrier b; b.bar = bar; b.x = xb_xcc_id(); b.st = st;
    if (threadIdx.x == 0) (void)xb_add(&bar[XB_XCNT(b.x)], 1u);
    return b;
}
__device__ __forceinline__ void xcd_barrier_complete(unsigned* bar, unsigned x, unsigned& nloc, unsigned& nx) {
    const unsigned G = gridDim.x * gridDim.y * gridDim.z;
    unsigned sum, cnt, mine, sp = 0u;
    for (;;) {
        sum = 0u; cnt = 0u; mine = 0u;
#pragma unroll
        for (unsigned j = 0; j < 16; ++j) { const unsigned c = xb_ld(&bar[XB_XCNT(j)]); sum += c; cnt += (c > 0u) ? 1u : 0u; mine = (j == x) ? c : mine; }
        if (sum == G) break;
        __builtin_amdgcn_s_sleep(1);
        if ((++sp & 255u) == 0u) { if (xb_ld(&bar[XB_TMO])) break; if (sp > XB_SPIN_CAP) { atomicAdd(&bar[XB_TMO], 1u); break; } }
    }
    nloc = mine > 0u ? mine : 1u; nx = cnt > 0u ? cnt : 1u;
}
__device__ __forceinline__ void xcd_barrier(const XcdBarrier& b) {
    asm volatile("s_waitcnt vmcnt(0)" ::: "memory");
    __syncthreads();
    if (threadIdx.x == 0) {
        unsigned* bar = b.bar;
        __builtin_amdgcn_s_waitcnt(0);
        unsigned nloc = b.st[0], nx = b.st[1];
        if (nloc == 0u) { xcd_barrier_complete(bar, b.x, nloc, nx); b.st[0] = nloc; b.st[1] = nx; }
        const unsigned old = xb_add(&bar[XB_XSUB(b.x)], 1u);
        const unsigned gen = old / nloc;
        if (old + 1u == (gen + 1u) * nloc) {
            __builtin_amdgcn_fence(__ATOMIC_RELEASE, "agent");
            asm volatile("s_waitcnt vmcnt(0)" ::: "memory");
            const unsigned og = xb_add(&bar[XB_TOP], 1u);
            const unsigned tg = og / nx;
            if (og + 1u == (tg + 1u) * nx) xb_add(&bar[XB_TOPGEN], 1u);
            else XB_SPIN(xb_ld(&bar[XB_TOPGEN]) == tg, bar);
            __builtin_amdgcn_fence(__ATOMIC_ACQUIRE, "agent");
            xb_add(&bar[XB_XGEN(b.x)], 1u);
            asm volatile("s_waitcnt vmcnt(0)" ::: "memory");
        } else {
            XB_SPIN(xb_ld(&bar[XB_XGEN(b.x)]) == gen, bar);
            __builtin_amdgcn_fence(__ATOMIC_ACQUIRE, "agent");
            asm volatile("s_waitcnt vmcnt(0)" ::: "memory");
        }
    }
    __syncthreads();
}

__device__ __forceinline__ float wave_sum(float v) {
#pragma unroll
    for (int o = 1; o < 64; o <<= 1) v += __shfl_xor(v, o);
    return v;
}
__device__ __forceinline__ void transpose_item(const float* W, int K, int N, bf16* WT, const float* gain, int permq, LAS float* scr, int item, int lane) {
    const int nblk = N / 32, kb = item / nblk, nb = item % nblk, k0 = 64 * kb, n0 = 32 * nb;
    int src = n0 + (lane & 31);
    if (permq) { const int h = src / DQK; int d = src - h * DQK; if (d >= NOPE) { const int j = d - NOPE; d = NOPE + (j & 1) * 32 + (j >> 1); } src = h * DQK + d; }
#pragma unroll 8
    for (int i = 0; i < 32; ++i) { const int kk = 2 * i + (lane >> 5); const float g = gain ? gain[k0 + kk] : 1.0f; scr[kk * 33 + (lane & 31)] = W[(size_t)(k0 + kk) * N + src] * g; }
    LDS_WAIT(); asm volatile("" ::: "memory");
    const int c = lane & 7;
#pragma unroll
    for (int j = 0; j < 4; ++j) { const int n = (lane >> 3) + 8 * j; const LAS float* s = scr + (8 * c) * 33 + n;
        v4u o; o.x = pk2(s[0 * 33], s[1 * 33]); o.y = pk2(s[2 * 33], s[3 * 33]); o.z = pk2(s[4 * 33], s[5 * 33]); o.w = pk2(s[6 * 33], s[7 * 33]);
        *(GAS v4u*)(WT + (size_t)(n0 + n) * K + k0 + 8 * c) = o; }
    LDS_WAIT(); asm volatile("" ::: "memory");
}
__device__ __forceinline__ void rowstat_1024(const float* xrow, bf16* orow, float* rs, int lane) {
    const GAS f32x4* xr = (const GAS f32x4*)xrow + lane;
    f32x4 v[4]; float s = 0.f;
#pragma unroll
    for (int j = 0; j < 4; ++j) { v[j] = xr[64 * j]; s += (v[j].x * v[j].x + v[j].y * v[j].y) + (v[j].z * v[j].z + v[j].w * v[j].w); }
    const float r = 1.0f / sqrtf(wave_sum(s) * (1.0f / 1024.0f) + EPS);
    if (lane == 0) *rs = r;
    GAS unsigned long long* o8 = (GAS unsigned long long*)orow + lane;
#pragma unroll
    for (int j = 0; j < 4; ++j) o8[64 * j] = (unsigned long long)pk2(v[j].x, v[j].y) | ((unsigned long long)pk2(v[j].z, v[j].w) << 32);
}

__device__ __forceinline__ float rs_from_partials(const float* ssqp, int row) {
    const f32x4* p = (const f32x4*)(ssqp + (size_t)row * 16); const f32x4 a = p[0], b = p[1], c = p[2], d = p[3];
    const float s = (((a[0] + a[1]) + (a[2] + a[3])) + ((b[0] + b[1]) + (b[2] + b[3]))) + (((c[0] + c[1]) + (c[2] + c[3])) + ((d[0] + d[1]) + (d[2] + d[3])));
    return 1.0f / sqrtf(s * (1.0f / 1024.0f) + EPS); }
struct FLat { bf16* lat; const float* rs;
    __device__ __forceinline__ float rowscale(int row) const { return rs[row]; }
    __device__ __forceinline__ void operator()(int row, int col, f32x4 v0, f32x4 v1) const { store8(lat + (size_t)row * NLATP + col, v0, v1); } };
struct FMemKV { bf16* kx; bf16* vx; const float* rs;
    __device__ __forceinline__ float rowscale(int row) const { return rs[row]; }
    __device__ __forceinline__ void operator()(int row, int col, f32x4 v0, f32x4 v1) const {
        const int b = row >> 8, m = row & 255, t = col >> 9, c = col & 511, h = c >> 7, d = c & 127;
        bf16* p = (t ? vx : kx) + ((size_t)((b * XH + h) * MEMLEN + m)) * 128 + d; store8(p, v0, v1); } };
struct FQ0 { bf16* q; const float* rs; const float2* cs;
    __device__ __forceinline__ float rowscale(int row) const { return rs[row] * QSCALE_MLA; }
    __device__ __forceinline__ void operator()(int row, int col, f32x4 v0, f32x4 v1) const {
        const int h = col / DQK, d = col - h * DQK;
        if (d >= NOPE) { const float2* c = cs + (size_t)row * 32 + ((d - NOPE) >> 1);
            const float2 c0 = c[0], c1 = c[1], c2 = c[2], c3 = c[3];
            const f32x4 a = v0, b = v1;
            v0[0] = a[0] * c0.x - a[1] * c0.y; v0[1] = a[0] * c0.y + a[1] * c0.x; v0[2] = a[2] * c1.x - a[3] * c1.y; v0[3] = a[2] * c1.y + a[3] * c1.x;
            v1[0] = b[0] * c2.x - b[1] * c2.y; v1[1] = b[0] * c2.y + b[1] * c2.x; v1[2] = b[2] * c3.x - b[3] * c3.y; v1[3] = b[2] * c3.y + b[3] * c3.x; }
        const int bb = row >> 11, si = row & 2047;
        store8(q + ((size_t)((bb * HEADS + h) * SEQ + si)) * DQK + d, v0, v1); } };
struct FKV0 { bf16* kn; bf16* v; const float* rs;
    __device__ __forceinline__ float rowscale(int row) const { return rs[row]; }
    __device__ __forceinline__ void operator()(int row, int col, f32x4 v0, f32x4 v1) const {
        const int h = col >> 8, j = col & 255, bb = row >> 11, si = row & 2047;
        bf16* p = (j < 128 ? kn : v) + ((size_t)((bb * HEADS + h) * SEQ + si)) * 128 + (j & 127); store8(p, v0, v1); } };
struct FXQ { bf16* qx; const float* ssqp;
    __device__ __forceinline__ float rowscale(int row) const { return rs_from_partials(ssqp, row) * QSCALE_128; }
    __device__ __forceinline__ void operator()(int row, int col, f32x4 v0, f32x4 v1) const {
        const int h = col >> 7, d = col & 127, bb = row >> 11, si = row & 2047;
        store8(qx + ((size_t)((bb * XH + h) * SEQ + si)) * 128 + d, v0, v1); } };
struct FUp { bf16* u; const float* ssqp;
    __device__ __forceinline__ float rowscale(int row) const { return rs_from_partials(ssqp, row); }
    __device__ __forceinline__ void operator()(int row, int col, f32x4 v0, f32x4 v1) const {
#pragma unroll
        for (int j = 0; j < 4; ++j) { const float a = fmaxf(v0[j], 0.f), b = fmaxf(v1[j], 0.f); v0[j] = a * a; v1[j] = b * b; }
        store8(u + (size_t)row * DFF + col, v0, v1); } };
struct FQKV1 { bf16* q; bf16* k; bf16* v; const float* ssqp;
    __device__ __forceinline__ float rowscale(int row) const { return rs_from_partials(ssqp, row); }
    __device__ __forceinline__ void operator()(int row, int col, f32x4 v0, f32x4 v1) const { const int t = col >> 10, c = col & 1023, h = c >> 7, d = c & 127, bb = row >> 11, si = row & 2047;
        const float s = (t == 0 ? QSCALE_128 : 1.0f);
        bf16* p = q + (size_t)t * (32u << 19) + ((size_t)((bb * HEADS + h) * SEQ + si)) * 128 + d; store8(p, v0 * s, v1 * s); } };

struct Args { const float* in[21]; float* out; unsigned char* ws; int ph_lo, ph_hi; };
static_assert(sizeof(Args) == 21 * 8 + 8 + 8 + 8, "Args has no padding");

enum { PH_PRO = 0, PH_DKV, PH_LATSTAT, PH_UQKV, PH_ATT0, PH_WO0, PH_XQ0, PH_XA0, PH_XO0, PH_UP0, PH_DN0,
       PH_QKV1, PH_ATT1, PH_WO1, PH_XQ1, PH_XA1, PH_XO1, PH_UP1, PH_DN1, PH_FINAL, NPH };

__global__ void __launch_bounds__(NWAVES * 64, 2) mk_fwd(Args args) {
    extern __shared__ __attribute__((aligned(16))) unsigned char lds_raw[];
    LAS unsigned char* lds = (LAS unsigned char*)lds_raw;
    volatile LAS unsigned* MISC = (volatile LAS unsigned*)(lds + MISC_OFF);
    const int tid = threadIdx.x, lane = tid & 63, wave = __builtin_amdgcn_readfirstlane(tid >> 6);
    const int G = gridDim.x; int vcu; { const int bx = blockIdx.x; vcu = (G % 8 == 0) ? (bx % 8) * (G / 8) + bx / 8 : bx; }
    unsigned char* ws = args.ws;
    gu32* ctl = (gu32*)(ws + WS_CTL);
    for (int u = tid; u < (LDS_BYTES - LDSCTL_OFF) / 4; u += NWAVES * 64) ((LAS unsigned*)(lds + LDSCTL_OFF))[u] = 0u;
    __syncthreads();
    const int lo = args.ph_lo, hi = args.ph_hi;
    const bool one_phase = (hi - lo == 1);
    XcdBarrier bar; bar.bar = (unsigned*)(ctl + CW_BAR); bar.x = 0; bar.st = nullptr;
    if (!one_phase) bar = xcd_barrier_post((unsigned*)(ctl + CW_BAR), MISC + 8);
#define IN(k) (lo <= (k) && (k) < hi)
#define SEAM(k) do { if (IN(k) && IN((k) + 1)) xcd_barrier(bar); } while (0)

    const float* x = args.in[0]; const float* mem = args.in[1]; const int* positions = (const int*)args.in[2];
    const float* norm_mix = args.in[3]; const float* norm_cross = args.in[4]; const float* norm_mem = args.in[5]; const float* norm_mlp = args.in[6]; const float* norm_final = args.in[7];
#define WSL() ({ unsigned char* _p = ws; asm volatile("" : "+s"(_p)); _p; })
#define rsb ((float*)(WSL() + WS_RS))
#define HB ((bf16*)(WSL() + WS_HB))
#define MEMB ((bf16*)(WSL() + WS_MEMB))
#define LAT ((bf16*)(WSL() + WS_LAT))
#define CS ((float2*)(WSL() + WS_CS))
#define KPE ((bf16*)(WSL() + WS_KPE))
#define OB ((bf16*)(WSL() + WS_OB))
#define QB_ ((bf16*)(WSL() + WS_Q))
#define KN ((bf16*)(WSL() + WS_KN))
#define VV ((bf16*)(WSL() + WS_V))
#define K1 ((bf16*)(WSL() + WS_K1))
#define V1 ((bf16*)(WSL() + WS_V1))
#define QX ((bf16*)(WSL() + WS_QX))
#define OX ((bf16*)(WSL() + WS_OX))
#define U ((bf16*)(WSL() + WS_U))
#define SSQP ((float*)(WSL() + WS_SSQ))
    float* hres = args.out;
    const int gw = vcu * NWAVES + wave, NGW = G * NWAVES;

    if (IN(PH_PRO)) {
        LAS float* scr = (LAS float*)(lds + RING_OFF + wave * 16384);
        struct Job { const float* W; int K, N; size_t dst; const float* gain; int permq; };
        constexpr int NJ = 16;
        for (int j = 0; j < NJ; ++j) {
            Job jb;
            switch (j) {
                case 0: jb = {args.in[8], DM, NLAT, WS_WDKV, norm_mix, 0}; break;
                case 1: jb = {args.in[11], QLORA, 1536, WS_WUQ, args.in[9], 1}; break;
                case 2: jb = {args.in[12], KVLORA, 2048, WS_WUKV, args.in[10], 0}; break;
                case 3: jb = {args.in[13], DM, DM, WS_WO0, nullptr, 0}; break;
                case 4: jb = {args.in[16], DM, 512, WS_WXQ, norm_cross, 0}; break;
                case 5: jb = {args.in[16] + (size_t)DM * 512, DM, 512, WS_WXQ + (size_t)512 * DM * 2, norm_cross + DM, 0}; break;
                case 6: jb = {args.in[17], DM, DM, WS_WXKV, norm_mem, 0}; break;
                case 7: jb = {args.in[17] + (size_t)DM * DM, DM, DM, WS_WXKV + (size_t)DM * DM * 2, norm_mem + DM, 0}; break;
                case 8: jb = {args.in[18], 512, DM, WS_WXO, nullptr, 0}; break;
                case 9: jb = {args.in[18] + (size_t)512 * DM, 512, DM, WS_WXO + (size_t)DM * 512 * 2, nullptr, 0}; break;
                case 10: jb = {args.in[19], DM, DFF, WS_WIN, norm_mlp, 0}; break;
                case 11: jb = {args.in[19] + (size_t)DM * DFF, DM, DFF, WS_WIN + (size_t)DFF * DM * 2, norm_mlp + DM, 0}; break;
                case 12: jb = {args.in[20], DFF, DM, WS_WOUT, nullptr, 0}; break;
                case 13: jb = {args.in[20] + (size_t)DFF * DM, DFF, DM, WS_WOUT + (size_t)DM * DFF * 2, nullptr, 0}; break;
                case 14: jb = {args.in[14], DM, 3072, WS_WQKV, norm_mix + DM, 0}; break;
                default: jb = {args.in[15], DM, DM, WS_WO1, nullptr, 0}; break;
            }
            const int nitems = (jb.K / 64) * (jb.N / 32);
            for (int it = gw; it < nitems; it += NGW) transpose_item(jb.W, jb.K, jb.N, (bf16*)(WSL() + jb.dst), jb.gain, jb.permq, scr, it, lane);
        }
        { GAS v4u* z = (GAS v4u*)(WSL() + WS_WDKV + (size_t)NLAT * DM * 2); const int n16 = (NLATP - NLAT) * DM * 2 / 16;
            for (int i = blockIdx.x * (NWAVES * 64) + tid; i < n16; i += G * NWAVES * 64) z[i] = (v4u){0u, 0u, 0u, 0u}; }
        for (int i = blockIdx.x * (NWAVES * 64) + tid; i < T * 32; i += G * NWAVES * 64) {
            const int tok = i >> 5, f = i & 31;
            const float inv = powf(10000.0f, -(float)(2 * f) / 64.0f);
            const float ang = (float)positions[tok] * inv;
            CS[i] = make_float2(cosf(ang), sinf(ang));
        }
        for (int m = gw; m < T; m += NGW) rowstat_1024(x + (size_t)m * DM, HB + (size_t)m * DM, rsb + RS_X + m, lane);
        for (int m = gw; m < TM; m += NGW) rowstat_1024(mem + (size_t)m * DM, MEMB + (size_t)m * DM, rsb + RS_MEM + m, lane);
    }
    SEAM(PH_PRO);

    if (IN(PH_DKV)) {
        { pg8::Gemm g{HB, (const bf16*)(WSL() + WS_WDKV), T, NLATP, DM, DM}; pg8::StaticOrder S; S.init(T, NLATP, G, (int)blockIdx.x);
          pg8::EpiB<FLat> E{{LAT, rsb + RS_X}}; pg8::gemm_phase<pg8::EpiB<FLat>, pg8::StaticOrder, true>(lds + RING_OFF, g, S, E); }
        for (int l = 0; l < 2; ++l) {
          pg8::Gemm g{MEMB, (const bf16*)(WSL() + WS_WXKV + (size_t)l * DM * DM * 2), TM, DM, DM, DM}; pg8::StaticOrder S; S.init(TM, DM, G, (int)((blockIdx.x + 64 - 32 * l) % G));
          bf16* kx = (bf16*)(WSL() + WS_KVX + (size_t)l * 4 * MiB);
          pg8::EpiB<FMemKV> E{{kx, kx + (size_t)TM * 512, rsb + RS_MEM}}; pg8::gemm_phase<pg8::EpiB<FMemKV>, pg8::StaticOrder, true>(lds + RING_OFF, g, S, E); }
    }
    SEAM(PH_DKV);

    if (IN(PH_LATSTAT)) {
        for (int m = gw; m < T; m += NGW) {
            const bf16* lr = LAT + (size_t)m * NLATP; float sq = 0.f, skv = 0.f;
#pragma unroll
            for (int j = 0; j < 3; ++j) { const int c = j * 64 + lane; const unsigned long long w = *(const GAS unsigned long long*)(lr + 4 * c);
                const float a0 = bf2f((unsigned short)w), a1 = bf2f((unsigned short)(w >> 16)), a2 = bf2f((unsigned short)(w >> 32)), a3 = bf2f((unsigned short)(w >> 48));
                const float s = (a0 * a0 + a1 * a1) + (a2 * a2 + a3 * a3);
                if (c < 96) sq += s; else if (c < 160) skv += s; }
            sq = wave_sum(sq); skv = wave_sum(skv);
            if (lane == 0) { rsb[RS_Q + m] = 1.0f / sqrtf(sq * (1.0f / QLORA) + EPS); rsb[RS_KV + m] = 1.0f / sqrtf(skv * (1.0f / KVLORA) + EPS); }
            if (lane < 32) { const float x1 = bf2f(lr[640 + lane]), x2 = bf2f(lr[672 + lane]); const float2 c = CS[(size_t)m * 32 + lane];
                *(GAS unsigned*)(KPE + (size_t)m * 64 + 2 * lane) = pk2(x1 * c.x - x2 * c.y, x1 * c.y + x2 * c.x); }
        }
    }
    SEAM(PH_LATSTAT);

    if (IN(PH_UQKV)) {
        { pg8::Gemm g{LAT, (const bf16*)(WSL() + WS_WUQ), T, 1536, QLORA, NLATP}; pg8::StaticOrder S; S.init(T, 1536, G, (int)blockIdx.x);
          pg8::EpiB<FQ0> E{{QB_, rsb + RS_Q, CS}}; pg8::gemm_phase<pg8::EpiB<FQ0>, pg8::StaticOrder, true>(lds + RING_OFF, g, S, E); }
        { pg8::Gemm g{LAT + QLORA, (const bf16*)(WSL() + WS_WUKV), T, 2048, KVLORA, NLATP}; pg8::StaticOrder S; S.init(T, 2048, G, (int)((blockIdx.x + 128) % G));
          pg8::EpiB<FKV0> E{{KN, VV, rsb + RS_KV}}; pg8::gemm_phase<pg8::EpiB<FKV0>, pg8::StaticOrder, true>(lds + RING_OFF, g, S, E); }
    }
    SEAM(PH_UQKV);

    if (IN(PH_ATT0)) {
        for (int pu = vcu; pu < 256; pu += G) { const int bh = pu >> 2, s = pu & 3, b = bh >> 3, h = bh & 7;
            for (int pass = 0; pass < 2; ++pass) { const int qb = pass ? s : 7 - s;
                att::attn_unit<att::MODE_MLA>(lds + RING_OFF, QB_ + ((size_t)bh * SEQ + qb * 256) * DQK, KN + (size_t)bh * SEQ * 128, KPE + (size_t)b * SEQ * 64, VV + (size_t)bh * SEQ * 128,
                    OB + ((size_t)b * SEQ + qb * 256) * DM + h * 128, DM, qb * 256, 0); } }
    }
    SEAM(PH_ATT0);

    for (int layer = 0; layer < 2; ++layer) {
        const int PB = layer ? PH_WO1 : PH_WO0;
        if (layer == 1) {
            if (IN(PH_QKV1)) { pg8::Gemm g{HB, (const bf16*)(WSL() + WS_WQKV), T, 3072, DM, DM}; pg8::StaticOrder S; S.init(T, 3072, G, (int)blockIdx.x);
                pg8::EpiB<FQKV1> E{{QB_, K1, V1, SSQP}}; pg8::gemm_phase<pg8::EpiB<FQKV1>, pg8::StaticOrder, true>(lds + RING_OFF, g, S, E); }
            SEAM(PH_QKV1);
            if (IN(PH_ATT1)) {
                for (int u = vcu; u < 512; u += G) { const int bh = u >> 3, qb = u & 7, b = bh >> 3, h = bh & 7;
                    att::attn_unit<att::MODE_SB>(lds + RING_OFF, QB_ + ((size_t)bh * SEQ + qb * 256) * 128, K1 + (size_t)bh * SEQ * 128, nullptr, V1 + (size_t)bh * SEQ * 128,
                        OB + ((size_t)b * SEQ + qb * 256) * DM + h * 128, DM, qb * 256, 0); }
            }
            SEAM(PH_ATT1);
        }
        if (IN(PB)) { pg8::Gemm g{OB, (const bf16*)(WSL() + (layer ? WS_WO1 : WS_WO0)), T, DM, DM, DM}; pg8::StaticOrder S; S.init(T, DM, G, (int)blockIdx.x);
            pg8::EpiResN E{layer ? hres : x, hres, HB, SSQP}; pg8::gemm_phase<pg8::EpiResN, pg8::StaticOrder, true>(lds + RING_OFF, g, S, E); }
        SEAM(PB);
        if (IN(PB + 1)) { pg8::Gemm g{HB, (const bf16*)(WSL() + WS_WXQ + (size_t)layer * 512 * DM * 2), T, 512, DM, DM}; pg8::StaticOrder S; S.init(T, 512, G, (int)blockIdx.x);
            pg8::EpiB<FXQ> E{{QX, SSQP}}; pg8::gemm_phase<pg8::EpiB<FXQ>, pg8::StaticOrder, true>(lds + RING_OFF, g, S, E); }
        SEAM(PB + 1);
        if (IN(PB + 2)) { const bf16* kx = (const bf16*)(WSL() + WS_KVX + (size_t)layer * 4 * MiB); const bf16* vx = kx + (size_t)TM * 512;
            for (int u = vcu; u < 256; u += G) { const int bh = u >> 3, qb = u & 7, b = bh >> 2, h = bh & 3;
                att::attn_unit<att::MODE_CROSS>(lds + RING_OFF, QX + ((size_t)bh * SEQ + qb * 256) * 128, kx + (size_t)bh * MEMLEN * 128, nullptr, vx + (size_t)bh * MEMLEN * 128,
                    OX + ((size_t)b * SEQ + qb * 256) * 512 + h * 128, 512, 0, MEMLEN); } }
        SEAM(PB + 2);
        if (IN(PB + 3)) { pg8::Gemm g{OX, (const bf16*)(WSL() + WS_WXO + (size_t)layer * DM * 512 * 2), T, DM, 512, 512}; pg8::StaticOrder S; S.init(T, DM, G, (int)blockIdx.x);
            pg8::EpiResN E{hres, hres, HB, SSQP}; pg8::gemm_phase<pg8::EpiResN, pg8::StaticOrder, true>(lds + RING_OFF, g, S, E); }
        SEAM(PB + 3);
        if (IN(PB + 4)) { pg8::Gemm g{HB, (const bf16*)(WSL() + WS_WIN + (size_t)layer * DFF * DM * 2), T, DFF, DM, DM}; pg8::StaticOrder S; S.init(T, DFF, G, (int)blockIdx.x);
            pg8::EpiB<FUp> E{{U, SSQP}}; pg8::gemm_phase<pg8::EpiB<FUp>, pg8::StaticOrder, true>(lds + RING_OFF, g, S, E); }
        SEAM(PB + 4);
        if (IN(PB + 5)) { pg8::Gemm g{U, (const bf16*)(WSL() + WS_WOUT + (size_t)layer * DM * DFF * 2), T, DM, DFF, DFF}; pg8::StaticOrder S; S.init(T, DM, G, (int)blockIdx.x);
            pg8::EpiResN E{hres, hres, HB, SSQP}; pg8::gemm_phase<pg8::EpiResN, pg8::StaticOrder, true>(lds + RING_OFF, g, S, E); }
        SEAM(PB + 5);
        if (layer == 1) {
            if (IN(PH_FINAL)) {
                for (int m = gw; m < T; m += NGW) {
                    GAS f32x4* xr = (GAS f32x4*)(hres + (size_t)m * DM) + lane; const GAS f32x4* gr = (const GAS f32x4*)norm_final + lane;
                    f32x4 v[4]; float s = 0.f;
#pragma unroll
                    for (int j = 0; j < 4; ++j) { v[j] = xr[64 * j]; s += (v[j].x * v[j].x + v[j].y * v[j].y) + (v[j].z * v[j].z + v[j].w * v[j].w); }
                    const float r = 1.0f / sqrtf(wave_sum(s) * (1.0f / 1024.0f) + EPS);
#pragma unroll
                    for (int j = 0; j < 4; ++j) xr[64 * j] = v[j] * r * gr[64 * j];
                }
            }
        }
    }
#undef IN
#undef SEAM
}

#ifndef MK_N_LAUNCHES
#define MK_N_LAUNCHES 1
#endif
extern "C" void kernel_launch(void* const* d_in, const int* in_sizes, int n_in, void* d_out, int out_size, void* d_ws, size_t ws_size, hipStream_t stream) {
    static int grid = 0;
    if (grid == 0) {
        if (n_in != 21 || in_sizes[0] != T * DM || out_size != T * DM || ws_size < WS_END) { fprintf(stderr, "kernel_launch: unexpected shapes (n_in %d, in0 %d, out %d, ws %zu)\n", n_in, n_in > 0 ? in_sizes[0] : -1, out_size, ws_size); grid = -1; return; }
        int dev = 0, cus = 0, per_cu = 0;
        if (hipGetDevice(&dev) != hipSuccess || hipDeviceGetAttribute(&cus, hipDeviceAttributeMultiprocessorCount, dev) != hipSuccess) { grid = -1; return; }
        if (hipFuncSetAttribute((const void*)mk_fwd, hipFuncAttributeMaxDynamicSharedMemorySize, LDS_BYTES) != hipSuccess) { fprintf(stderr, "kernel_launch: hipFuncSetAttribute failed\n"); grid = -1; return; }
        if (hipOccupancyMaxActiveBlocksPerMultiprocessor(&per_cu, (const void*)mk_fwd, NWAVES * 64, LDS_BYTES) != hipSuccess || per_cu < 1)
            fprintf(stderr, "kernel_launch: note: occupancy query reports %d workgroups per CU\n", per_cu);
        (void)hipGetLastError();
        grid = cus;
    }
    if (grid < 0) return;
    (void)hipMemsetAsync((char*)d_ws + WS_CTL, 0, CTL_ZERO_BYTES, stream);
    Args a{};
    for (int i = 0; i < 21; ++i) a.in[i] = (const float*)d_in[i];
    a.out = (float*)d_out; a.ws = (unsigned char*)d_ws;
#if MK_N_LAUNCHES == 1
    a.ph_lo = 0; a.ph_hi = NPH;
    hipLaunchKernelGGL(mk_fwd, dim3(grid), dim3(NWAVES * 64), LDS_BYTES, stream, a);
#else
    for (int p = 0; p < NPH; ++p) { a.ph_lo = p; a.ph_hi = p + 1; hipLaunchKernelGGL(mk_fwd, dim3(grid), dim3(NWAVES * 64), LDS_BYTES, stream, a); }
#endif
}
```

```cpp
#include <hip/hip_runtime.h>
#include <cstdio>
#include <cstdint>
namespace pg8 {
#define PG8_LAS __attribute__((address_space(3)))
typedef unsigned short bf16_t;
typedef short bf16x8 __attribute__((ext_vector_type(8)));
typedef float f32x4 __attribute__((ext_vector_type(4)));
typedef unsigned u32x4 __attribute__((ext_vector_type(4)));
constexpr int BM = 256, BK = 64, HALF = 128, HTB = HALF * BK * 2  , STAGE_BYTES = 8 * HTB, NXCD = 8, WGM = 8;

__host__ __device__ __forceinline__ int lds_byte(int r, int c) { const int st = (r >> 4) * 2 + (c >> 5), rr = r & 15, cc = c & 31, ob = rr * 64 + cc * 2; return st * 1024 + (ob ^ (((ob >> 9) & 1) << 5)); }
__host__ __device__ __forceinline__ void stage_rc(int b, int& R, int& C) { const int st = b / 1024, sb = b % 1024, swz = sb ^ (((sb >> 9) & 1) << 5); R = (st >> 1) * 16 + swz / 64; C = (st & 1) * 32 + (swz % 64) / 2; }
__host__ __device__ __forceinline__ int perm32(int rho) { const int n = rho >> 4, i = rho & 15; return 8 * (i >> 2) + 4 * n + (i & 3); }

struct Unit { int pm, pn; };
struct Gemm { const bf16_t* A; const bf16_t* Bt; int M, N, K, lda; };

struct StaticOrder {
    int nM, nN, nwg, G, c;
    __host__ __device__ void init(int M, int N, int G_, int c_) { nM = M / BM; nN = N / BM; nwg = nM * nN; G = G_; c = c_; }
    __host__ __device__ bool next(int i, Unit& u) const {
        const long L = (long)i * G + c; if (L >= nwg) return false;
        int wgid = (int)L; { const int q = nwg / NXCD, r = nwg % NXCD, xcd = wgid % NXCD, off = wgid / NXCD; wgid = (xcd < r ? xcd * (q + 1) : r * (q + 1) + (xcd - r) * q) + off; }
        const int nig = WGM * nN, gid = wgid / nig, fm = gid * WGM, gsz = (nM - fm) < WGM ? (nM - fm) : WGM;
        u.pm = fm + ((wgid % nig) % gsz); u.pn = (wgid % nig) / gsz; return true;
    }
};

__device__ __forceinline__ unsigned cvt_pk_bf16(float lo, float hi) { unsigned r; asm volatile("v_cvt_pk_bf16_f32 %0, %1, %2" : "=v"(r) : "v"(lo), "v"(hi)); return r; }

template <class F> struct EpiB {
    static constexpr bool PERM = true;
    F f;
    __device__ __forceinline__ void operator()(const f32x4 (&acc)[2][2][4][2], const Unit& u, int wr, int wc, int fr, int fq) const {
        const int row0 = u.pm * BM + wr * 64 + fr, col0 = u.pn * BM + wc * 32 + 8 * fq;
#pragma unroll
        for (int ai = 0; ai < 2; ++ai)
#pragma unroll
            for (int m = 0; m < 4; ++m) { const int row = row0 + ai * HALF + m * 16; const float rsc = f.rowscale(row);
#pragma unroll
                for (int bj = 0; bj < 2; ++bj) f(row, col0 + bj * HALF, acc[ai][bj][m][0] * rsc, acc[ai][bj][m][1] * rsc); }
    }
};
struct EpiRes {
    static constexpr bool PERM = false;
    const float* base; float* out; int ldc;
    __device__ __forceinline__ void operator()(const f32x4 (&acc)[2][2][4][2], const Unit& u, int wr, int wc, int fr, int fq) const {
        const int row0 = u.pm * BM + wr * 64 + fr, col0 = u.pn * BM + wc * 32 + 4 * fq;
#pragma unroll
        for (int ai = 0; ai < 2; ++ai)
#pragma unroll
            for (int m = 0; m < 4; ++m) { const size_t off = (size_t)(row0 + ai * HALF + m * 16) * ldc + col0;
#pragma unroll
                for (int bj = 0; bj < 2; ++bj)
#pragma unroll
                    for (int n = 0; n < 2; ++n) { const size_t o = off + bj * HALF + n * 16; *(f32x4*)(out + o) = *(const f32x4*)(base + o) + acc[ai][bj][m][n]; } }
    }
};

struct EpiResN {
    static constexpr bool PERM = true;
    const float* base; float* out; bf16_t* hb; float* ssqp;
    __device__ __forceinline__ void operator()(const f32x4 (&acc)[2][2][4][2], const Unit& u, int wr, int wc, int fr, int fq) const {
        const int row0 = u.pm * BM + wr * 64 + fr, col0 = u.pn * BM + wc * 32 + 8 * fq;
#pragma unroll
        for (int ai = 0; ai < 2; ++ai)
#pragma unroll
            for (int m = 0; m < 4; ++m) { const int row = row0 + ai * HALF + m * 16; float ss = 0.f;
#pragma unroll
                for (int bj = 0; bj < 2; ++bj) { const size_t o = (size_t)row * 1024 + col0 + bj * HALF;
                    const f32x4 a = *(const f32x4*)(base + o) + acc[ai][bj][m][0], b = *(const f32x4*)(base + o + 4) + acc[ai][bj][m][1];
                    *(f32x4*)(out + o) = a; *(f32x4*)(out + o + 4) = b;
                    u32x4 w; w.x = cvt_pk_bf16(a[0], a[1]); w.y = cvt_pk_bf16(a[2], a[3]); w.z = cvt_pk_bf16(b[0], b[1]); w.w = cvt_pk_bf16(b[2], b[3]); *(u32x4*)(hb + o) = w;
                    ss += ((a[0] * a[0] + a[1] * a[1]) + (a[2] * a[2] + a[3] * a[3])) + ((b[0] * b[0] + b[1] * b[1]) + (b[2] * b[2] + b[3] * b[3])); }
                ss += __shfl_xor(ss, 16); ss += __shfl_xor(ss, 32);
                if (fq == 0) ssqp[(size_t)row * 16 + u.pn * 4 + wc] = ss; }
    }
};

template <class Epi, class Sched, bool ALIGN_EPI>
__device__ __forceinline__ void gemm_phase(PG8_LAS unsigned char* lds, const Gemm g, const Sched& S, const Epi& E) {
    int tid = threadIdx.x; asm volatile("" : "+v"(tid));
    const int wid = __builtin_amdgcn_readfirstlane(tid >> 6), lane = tid & 63, wr = wid >> 2, wc = wid & 3, fr = lane & 15, fq = lane >> 4;
    const int K = g.K, nt = K / BK;
    unsigned voffA[2], voffB[2];
#pragma unroll
    for (int i = 0; i < 2; ++i) { int R, C; stage_rc(tid * 16 + i * 8192, R, C); const int Rb = Epi::PERM ? ((R & ~31) + perm32(R & 31)) : R;
        voffA[i] = (unsigned)(R * g.lda + C) * 2u; voffB[i] = (unsigned)(Rb * K + C) * 2u; }
    const size_t kstep = (size_t)(BK * 2);
    const size_t hstepA = (size_t)HALF * g.lda * 2, hstepB = (size_t)HALF * K * 2;
    const size_t tstepA = 2 * hstepA, tstepB = 2 * hstepB;
    const unsigned ldsw = (unsigned)wid * 1024u;
    const int aoff = lds_byte(wr * 64 + fr, fq * 8), boff = lds_byte(wc * 32 + fr, fq * 8);
#define PG8_SA(b, h) (((b) * 2 + (h)) * HTB)
#define PG8_SB(b, h) ((4 + (b) * 2 + (h)) * HTB)
#define PG8_STAGE(bufoff, gbase, voff) do { _Pragma("unroll") for (int _i = 0; _i < 2; ++_i) \
        __builtin_amdgcn_global_load_lds((const unsigned*)((const char*)(gbase) + (voff)[_i]), (PG8_LAS unsigned*)(lds + (bufoff) + ldsw + _i * 8192), 16, 0, 0); } while (0)
#define PG8_LDA(dst, b, h) do { _Pragma("unroll") for (int m = 0; m < 4; ++m) _Pragma("unroll") for (int k = 0; k < 2; ++k) dst[m][k] = *(const PG8_LAS bf16x8*)(lds + PG8_SA(b, h) + aoff + m * 2048 + k * 1024); } while (0)
#define PG8_LDB(dst, b, h) do { _Pragma("unroll") for (int n = 0; n < 2; ++n) _Pragma("unroll") for (int k = 0; k < 2; ++k) dst[n][k] = *(const PG8_LAS bf16x8*)(lds + PG8_SB(b, h) + boff + n * 2048 + k * 1024); } while (0)
#define PG8_MMA(ai, bj, At, Bt) do { __builtin_amdgcn_s_setprio(1); _Pragma("unroll") for (int m = 0; m < 4; ++m) _Pragma("unroll") for (int n = 0; n < 2; ++n) _Pragma("unroll") for (int k = 0; k < 2; ++k) \
        acc[ai][bj][m][n] = __builtin_amdgcn_mfma_f32_16x16x32_bf16(Bt[n][k], At[m][k], acc[ai][bj][m][n], 0, 0, 0); __builtin_amdgcn_s_setprio(0); } while (0)
#define PG8_WAIT_V(n) asm volatile("s_waitcnt vmcnt(" #n ")" ::: "memory")
#define PG8_WAIT_L(n) asm volatile("s_waitcnt lgkmcnt(" #n ")" ::: "memory")
#define PG8_BAR __builtin_amdgcn_s_barrier()
#define PG8_SCHED __builtin_amdgcn_sched_barrier(0)
    Unit cur, nxt; int ui = 0;
    if (!S.next(0, cur)) return;
    f32x4 acc[2][2][4][2];
#pragma unroll
    for (int a = 0; a < 2; ++a)
#pragma unroll
        for (int b = 0; b < 2; ++b)
#pragma unroll
            for (int m = 0; m < 4; ++m)
#pragma unroll
                for (int n = 0; n < 2; ++n) acc[a][b][m][n] = (f32x4){0.f, 0.f, 0.f, 0.f};
    bf16x8 At[4][2], B0[2][2], B1[2][2];
    const char* cA = (const char*)g.A + (size_t)cur.pm * tstepA; const char* cB = (const char*)g.Bt + (size_t)cur.pn * tstepB;
    PG8_STAGE(PG8_SB(0, 0), cB, voffB); PG8_STAGE(PG8_SB(0, 1), cB + hstepB, voffB); PG8_STAGE(PG8_SA(0, 0), cA, voffA); PG8_STAGE(PG8_SA(0, 1), cA + hstepA, voffA);
    if (wr == 1) PG8_BAR;
    PG8_WAIT_V(2); PG8_BAR;
    PG8_STAGE(PG8_SB(1, 0), cB + kstep, voffB); PG8_STAGE(PG8_SA(1, 0), cA + kstep, voffA); PG8_STAGE(PG8_SB(1, 1), cB + hstepB + kstep, voffB);
    PG8_WAIT_V(6); PG8_BAR;
    for (;;) {
        const bool has_next = S.next(ui + 1, nxt);
        const char* nA = has_next ? (const char*)g.A + (size_t)nxt.pm * tstepA : cA; const char* nB = has_next ? (const char*)g.Bt + (size_t)nxt.pn * tstepB : cB;
#pragma nounroll
        for (int t = 0; t < nt; t += 2) {
            const bool last = (t == nt - 2);
            const char* a1 = cA + (size_t)(t + 1) * kstep;
            const char* a2 = last ? nA : cA + (size_t)(t + 2) * kstep; const char* b2 = last ? nB : cB + (size_t)(t + 2) * kstep;
            const char* a3 = a2 + kstep; const char* b3 = b2 + kstep;
            PG8_LDB(B0, 0, 0); PG8_LDB(B1, 0, 1); PG8_SCHED; PG8_LDA(At, 0, 0); PG8_STAGE(PG8_SA(1, 1), a1 + hstepA, voffA);
            PG8_WAIT_V(8); PG8_WAIT_L(0); PG8_BAR; PG8_MMA(0, 0, At, B0); PG8_MMA(0, 1, At, B1); PG8_BAR; PG8_SCHED;
            PG8_LDA(At, 0, 1); PG8_STAGE(PG8_SB(0, 0), b2, voffB); PG8_STAGE(PG8_SB(0, 1), b2 + hstepB, voffB); PG8_STAGE(PG8_SA(0, 0), a2, voffA);
            PG8_WAIT_V(8); PG8_WAIT_L(0); PG8_BAR; PG8_MMA(1, 0, At, B0); PG8_MMA(1, 1, At, B1); PG8_BAR; PG8_SCHED;
            PG8_LDB(B0, 1, 0); PG8_LDB(B1, 1, 1); PG8_SCHED; PG8_LDA(At, 1, 0); PG8_STAGE(PG8_SA(0, 1), a2 + hstepA, voffA);
            PG8_WAIT_V(8); PG8_WAIT_L(0); PG8_BAR; PG8_MMA(0, 0, At, B0); PG8_MMA(0, 1, At, B1); PG8_BAR; PG8_SCHED;
            PG8_LDA(At, 1, 1); PG8_STAGE(PG8_SB(1, 0), b3, voffB); PG8_STAGE(PG8_SB(1, 1), b3 + hstepB, voffB); PG8_STAGE(PG8_SA(1, 0), a3, voffA);
            PG8_WAIT_V(8); PG8_WAIT_L(0); PG8_BAR; PG8_MMA(1, 0, At, B0); PG8_MMA(1, 1, At, B1); PG8_BAR; PG8_SCHED;
        }
        if constexpr (ALIGN_EPI) { if (wr == 0) PG8_BAR; }
        E(acc, cur, wr, wc, fr, fq);
        if (!has_next) break;
#pragma unroll
        for (int a = 0; a < 2; ++a)
#pragma unroll
            for (int b = 0; b < 2; ++b)
#pragma unroll
                for (int m = 0; m < 4; ++m)
#pragma unroll
                    for (int n = 0; n < 2; ++n) acc[a][b][m][n] = (f32x4){0.f, 0.f, 0.f, 0.f};
        cur = nxt; cA = nA; cB = nB; ++ui;
        if constexpr (ALIGN_EPI) { if (wr == 1) PG8_BAR; }
    }
    PG8_WAIT_V(0);
    if constexpr (!ALIGN_EPI) { if (wr == 0) PG8_BAR; }
    PG8_BAR;
#undef PG8_SA
#undef PG8_SB
#undef PG8_STAGE
#undef PG8_LDA
#undef PG8_LDB
#undef PG8_MMA
#undef PG8_WAIT_V
#undef PG8_WAIT_L
#undef PG8_BAR
#undef PG8_SCHED
}
}
namespace att {
typedef unsigned short bf16_t;
typedef short bf16x8 __attribute__((ext_vector_type(8)));
typedef short s16x4 __attribute__((ext_vector_type(4)));
typedef float f32x16 __attribute__((ext_vector_type(16)));
typedef float f32x4 __attribute__((ext_vector_type(4)));
typedef unsigned u32x4 __attribute__((ext_vector_type(4)));
#define ATT_LAS __attribute__((address_space(3)))
constexpr int KVBLK = 64, QBLK = 32, QB = 256;
constexpr int L_K = 0, L_V = 16384, L_PE = 32768, L_WS = 40960, L_FLAG = 40960 + 2048, LDS_BYTES = 40960 + 2048 + 64;
enum { MODE_MLA = 0, MODE_CROSS = 1, MODE_SB = 2 };

#define ATT_KSWZ(row, colB) ((row) * 256 + ((colB) ^ (((row) & 7) << 4)))
#define ATT_PESWZ(row, ch) ((row) * 128 + ((((ch) ^ (((row) >> 1) & 7))) << 4))
#define ATT_SBAR() __builtin_amdgcn_sched_barrier(0)
__device__ __forceinline__ int v_st(int k, int c) { const int kk = (k & ~0xC) | ((k & 4) << 1) | ((k & 8) >> 1); return ((kk >> 3) * 4 + (c >> 5)) * 512 + ((kk & 7) * 32 + (c & 31)) * 2; }
__device__ __forceinline__ int v_rd_base(int lane) { return ((lane & 3) << 3) | (((lane >> 2) & 3) << 6) | (((lane >> 4) & 1) << 5) | (((lane >> 5) & 1) << 8); }
__device__ __forceinline__ int crow(int r, int hi) { return (r & 3) + 8 * (r >> 2) + 4 * hi; }
__device__ __forceinline__ unsigned cvtpk(float lo, float hi) { unsigned r; asm volatile("v_cvt_pk_bf16_f32 %0, %1, %2" : "=v"(r) : "v"(lo), "v"(hi)); return r; }
__device__ __forceinline__ float swap_add(float v) { auto rr = __builtin_amdgcn_permlane32_swap(__float_as_uint(v), __float_as_uint(v), false, false); return __uint_as_float(rr[0]) + __uint_as_float(rr[1]); }
__device__ __forceinline__ float swap_max(float v) { auto rr = __builtin_amdgcn_permlane32_swap(__float_as_uint(v), __float_as_uint(v), false, false); return fmaxf(__uint_as_float(rr[0]), __uint_as_float(rr[1])); }
__device__ __forceinline__ float swap_other(float v, int hi) { auto rr = __builtin_amdgcn_permlane32_swap(__float_as_uint(v), __float_as_uint(v), false, false);
    const float a = __uint_as_float(rr[0]), b = __uint_as_float(rr[1]); return hi ? a : b; }

__device__ __forceinline__ void pack_p(const f32x16& p0, const f32x16& p1, bf16x8& pa0, bf16x8& pa1, bf16x8& pa2, bf16x8& pa3) {
#define ATT_PK4(P, B_, OUT) do { unsigned a0 = cvtpk(P[B_+0], P[B_+1]), a1 = cvtpk(P[B_+2], P[B_+3]);                          \
        unsigned b0 = cvtpk(P[B_+4], P[B_+5]), b1 = cvtpk(P[B_+6], P[B_+7]);                                             \
        auto r0 = __builtin_amdgcn_permlane32_swap(a0, b0, false, false); auto r1 = __builtin_amdgcn_permlane32_swap(a1, b1, false, false); \
        u32x4 w = {r0[0], r1[0], r0[1], r1[1]}; OUT = *reinterpret_cast<bf16x8*>(&w); } while (0)
    ATT_PK4(p0, 0, pa0); ATT_PK4(p0, 8, pa1); ATT_PK4(p1, 0, pa2); ATT_PK4(p1, 8, pa3);
#undef ATT_PK4
}
__device__ __forceinline__ void pv_tile(f32x16* o, int vb0, bf16x8 pa0, bf16x8 pa1, bf16x8 pa2, bf16x8 pa3) {
#define ATT_TRRD(dst, off) asm volatile("ds_read_b64_tr_b16 %0, %1 offset:%2" : "=&v"(dst) : "v"(vb0), "i"(off) : "memory")
#define ATT_PV_D0(d0) do { s16x4 l0, l1, l2, l3, h0, h1, h2, h3; constexpr int b_ = (d0) * 512;   \
        ATT_TRRD(l0, b_); ATT_TRRD(h0, b_ + 2048); ATT_TRRD(l1, b_ + 4096); ATT_TRRD(h1, b_ + 6144); ATT_TRRD(l2, b_ + 8192); ATT_TRRD(h2, b_ + 10240); ATT_TRRD(l3, b_ + 12288); ATT_TRRD(h3, b_ + 14336); \
        asm volatile("s_waitcnt lgkmcnt(0)" ::: "memory"); ATT_SBAR();   \
        o[d0] = __builtin_amdgcn_mfma_f32_32x32x16_bf16(pa0, (bf16x8){l0[0], l0[1], l0[2], l0[3], h0[0], h0[1], h0[2], h0[3]}, o[d0], 0, 0, 0);   \
        o[d0] = __builtin_amdgcn_mfma_f32_32x32x16_bf16(pa1, (bf16x8){l1[0], l1[1], l1[2], l1[3], h1[0], h1[1], h1[2], h1[3]}, o[d0], 0, 0, 0);   \
        o[d0] = __builtin_amdgcn_mfma_f32_32x32x16_bf16(pa2, (bf16x8){l2[0], l2[1], l2[2], l2[3], h2[0], h2[1], h2[2], h2[3]}, o[d0], 0, 0, 0);   \
        o[d0] = __builtin_amdgcn_mfma_f32_32x32x16_bf16(pa3, (bf16x8){l3[0], l3[1], l3[2], l3[3], h3[0], h3[1], h3[2], h3[3]}, o[d0], 0, 0, 0); } while (0)
    ATT_PV_D0(0); ATT_PV_D0(1); ATT_PV_D0(2); ATT_PV_D0(3);
#undef ATT_PV_D0
#undef ATT_TRRD
}

template <int MODE>
__device__ __forceinline__ void attn_unit(ATT_LAS unsigned char* lds, const bf16_t* Qb, const bf16_t* Kn, const bf16_t* Kpe, const bf16_t* Vp, bf16_t* Ob, int ostride, int q0, int nkeys) {
    constexpr int DKQ = (MODE == MODE_MLA) ? 192 : 128, NQF = DKQ / 16;
    int tid = threadIdx.x; asm volatile("" : "+v"(tid));
    const int wid = __builtin_amdgcn_readfirstlane(tid >> 6), lane = tid & 63, r32 = lane & 31, hi = lane >> 5;
    ATT_LAS float* ws = (ATT_LAS float*)(lds + L_WS) + wid * 64; ATT_LAS float* li_l = ws; ATT_LAS float* al_l = ws + 32;
    volatile ATT_LAS int* flags = (volatile ATT_LAS int*)(lds + L_FLAG);
    const int vb0 = (int)(unsigned)(uintptr_t)(lds + L_V) + v_rd_base(lane);
    bf16x8 qr[NQF];
#pragma unroll
    for (int d0 = 0; d0 < NQF; ++d0) qr[d0] = *(const bf16x8*)(Qb + (size_t)(wid * QBLK + r32) * DKQ + d0 * 16 + hi * 8);
    const int qlo = q0 + wid * QBLK;
    const int qpos = qlo + r32;
    float m_reg = -1e30f, l_reg = 0.f, Rrun = 0.f;
    f32x16 o[4]; o[0] = f32x16{}; o[1] = f32x16{}; o[2] = f32x16{}; o[3] = f32x16{};
    const int sr = tid >> 4, sc = (tid & 15) * 8;
    const int kws = ATT_KSWZ(sr, sc * 2), vst0 = v_st(sr, sc), vst1 = v_st(32 + sr, sc);
    const int per = tid >> 3, pech = tid & 7, pews = ATT_PESWZ(per, pech);
    int NT;
    if (MODE == MODE_CROSS) NT = nkeys / KVBLK; else NT = (q0 + QB) / KVBLK;
    if (MODE == MODE_SB) { if (tid < 8) flags[tid] = 0; }
    for (int it = 0; it < NT; ++it) {
        const int t = (MODE == MODE_SB) ? (NT - 1 - it) : it;
        const int kb = t * KVBLK;
        __syncthreads();
        if (MODE == MODE_SB && it > 0) { int alld = 1;
#pragma unroll
            for (int w = 0; w < 8; ++w) alld &= flags[w];
            if (alld) break; }
        {
            const u32x4 k0v = *(const u32x4*)(Kn + (size_t)(kb + sr) * 128 + sc), k1v = *(const u32x4*)(Kn + (size_t)(kb + 32 + sr) * 128 + sc);
            const u32x4 v0v = *(const u32x4*)(Vp + (size_t)(kb + sr) * 128 + sc), v1v = *(const u32x4*)(Vp + (size_t)(kb + 32 + sr) * 128 + sc);
            u32x4 pev; if (MODE == MODE_MLA) pev = *(const u32x4*)(Kpe + (size_t)(kb + per) * 64 + pech * 8);
            *(ATT_LAS u32x4*)(lds + L_K + kws) = k0v; *(ATT_LAS u32x4*)(lds + L_K + kws + 32 * 256) = k1v;
            *(ATT_LAS u32x4*)(lds + L_V + vst0) = v0v; *(ATT_LAS u32x4*)(lds + L_V + vst1) = v1v;
            if (MODE == MODE_MLA) *(ATT_LAS u32x4*)(lds + L_PE + pews) = pev;
        }
        __syncthreads();
        bool act = true;
        if (MODE == MODE_MLA) act = (kb <= qlo + QBLK - 1);
        if (MODE == MODE_SB) act = (kb < qlo + QBLK - 1);
        if (act && MODE != MODE_SB) {
            f32x16 p0 = f32x16{}, p1 = f32x16{};
#pragma unroll
            for (int d0 = 0; d0 < 8; ++d0) {
                const int off = ATT_KSWZ(r32, ((d0 & 3) * 16 + hi * 8) * 2) + (d0 >> 2) * 128;
                const bf16x8 b0 = *(const ATT_LAS bf16x8*)(lds + L_K + off);
                const bf16x8 b1 = *(const ATT_LAS bf16x8*)(lds + L_K + off + 32 * 256);
                p0 = __builtin_amdgcn_mfma_f32_32x32x16_bf16(b0, qr[d0], p0, 0, 0, 0);
                p1 = __builtin_amdgcn_mfma_f32_32x32x16_bf16(b1, qr[d0], p1, 0, 0, 0);
            }
            if (MODE == MODE_MLA) {
#pragma unroll
                for (int d0 = 8; d0 < NQF; ++d0) {
                    const int off = ATT_PESWZ(r32, (d0 - 8) * 2 + hi);
                    const bf16x8 b0 = *(const ATT_LAS bf16x8*)(lds + L_PE + off);
                    const bf16x8 b1 = *(const ATT_LAS bf16x8*)(lds + L_PE + off + 32 * 128);
                    p0 = __builtin_amdgcn_mfma_f32_32x32x16_bf16(b0, qr[d0], p0, 0, 0, 0);
                    p1 = __builtin_amdgcn_mfma_f32_32x32x16_bf16(b1, qr[d0], p1, 0, 0, 0);
                }
            }
            bf16x8 pa0, pa1, pa2, pa3;
            if (MODE == MODE_MLA && kb + KVBLK - 1 > qlo) {
                const float NEG = -__builtin_inff();
#pragma unroll
                for (int r = 0; r < 16; ++r) { const int key = kb + crow(r, hi); if (key > qpos) p0[r] = NEG; if (key + 32 > qpos) p1[r] = NEG; }
            }
            float pmax = p0[0];
#pragma unroll
            for (int r = 1; r < 16; ++r) pmax = fmaxf(pmax, p0[r]);
#pragma unroll
            for (int r = 0; r < 16; ++r) pmax = fmaxf(pmax, p1[r]);
            pmax = swap_max(pmax);
            const float mn = fmaxf(m_reg, pmax), alpha = __builtin_amdgcn_exp2f(m_reg - mn); m_reg = mn;
            float ps = 0.f;
#pragma unroll
            for (int r = 0; r < 16; ++r) { p0[r] = __builtin_amdgcn_exp2f(p0[r] - mn); ps += p0[r]; }
#pragma unroll
            for (int r = 0; r < 16; ++r) { p1[r] = __builtin_amdgcn_exp2f(p1[r] - mn); ps += p1[r]; }
            ps = swap_add(ps);
            l_reg = l_reg * alpha + ps;
            if (__any(alpha < 1.f)) {
                if (hi == 0) al_l[r32] = alpha;
                asm volatile("s_waitcnt lgkmcnt(0)" ::: "memory");
#pragma unroll
                for (int r = 0; r < 16; ++r) { const float a = al_l[crow(r, hi)];
#pragma unroll
                    for (int d_ = 0; d_ < 4; ++d_) o[d_][r] *= a; }
            }
            pack_p(p0, p1, pa0, pa1, pa2, pa3);
            ATT_SBAR();
            pv_tile(o, vb0, pa0, pa1, pa2, pa3);
        }
        if (act && MODE == MODE_SB) {
            const bool needmask = (kb + KVBLK - 1 >= qlo);
            bf16x8 pa[4];
#pragma unroll
            for (int half = 1; half >= 0; --half) {
                f32x16 p = f32x16{};
#pragma unroll
                for (int d0 = 0; d0 < 8; ++d0) {
                    const int off = ATT_KSWZ(r32, ((d0 & 3) * 16 + hi * 8) * 2) + (d0 >> 2) * 128 + half * 32 * 256;
                    const bf16x8 b0 = *(const ATT_LAS bf16x8*)(lds + L_K + off);
                    p = __builtin_amdgcn_mfma_f32_32x32x16_bf16(b0, qr[d0], p, 0, 0, 0);
                }
                f32x16 L;
#pragma unroll
                for (int r = 0; r < 16; ++r) { const float z = p[r], az = fabsf(z); const float sp = fmaxf(z, 0.f) + __builtin_amdgcn_logf(1.f + __builtin_amdgcn_exp2f(-az)); L[r] = -sp; p[r] = z - sp; }
                if (needmask) {
#pragma unroll
                    for (int r = 0; r < 16; ++r) { const int key = kb + half * 32 + crow(r, hi); if (key >= qpos) L[r] = 0.f; }
                }
                float g[4], h[4];
#pragma unroll
                for (int i = 0; i < 4; ++i) g[i] = (L[4 * i] + L[4 * i + 1]) + (L[4 * i + 2] + L[4 * i + 3]);
#pragma unroll
                for (int i = 0; i < 4; ++i) h[i] = swap_other(g[i], hi);
                float os[4]; float run = Rrun;
#pragma unroll
                for (int i = 3; i >= 0; --i) { os[i] = run; run += g[i] + h[i]; }
#pragma unroll
                for (int i = 0; i < 4; ++i) {
                    float e = os[i] + (hi == 0 ? h[i] : 0.f);
#pragma unroll
                    for (int j = 3; j >= 0; --j) { const float lsg = p[4 * i + j]; p[4 * i + j] = __builtin_amdgcn_exp2f(lsg + e); e += L[4 * i + j]; }
                }
                if (needmask) {
#pragma unroll
                    for (int r = 0; r < 16; ++r) { const int key = kb + half * 32 + crow(r, hi); if (key >= qpos) p[r] = 0.f; }
                }
                Rrun = run;
#define ATT_PK4(P, B_, OUT) do { unsigned a0 = cvtpk(P[B_+0], P[B_+1]), a1 = cvtpk(P[B_+2], P[B_+3]);                          \
        unsigned b0 = cvtpk(P[B_+4], P[B_+5]), b1 = cvtpk(P[B_+6], P[B_+7]);                                             \
        auto r0 = __builtin_amdgcn_permlane32_swap(a0, b0, false, false); auto r1 = __builtin_amdgcn_permlane32_swap(a1, b1, false, false); \
        u32x4 w = {r0[0], r1[0], r0[1], r1[1]}; OUT = *reinterpret_cast<bf16x8*>(&w); } while (0)
                ATT_PK4(p, 0, pa[2 * half]); ATT_PK4(p, 8, pa[2 * half + 1]);
#undef ATT_PK4
            }
            ATT_SBAR();
            pv_tile(o, vb0, pa[0], pa[1], pa[2], pa[3]);
        }
        if (MODE == MODE_SB) { const int dn = (act && __all(Rrun < -152.0f)) ? 1 : 0; if (lane == 0) flags[wid] = dn; }
    }
    float rli[16];
    if (MODE != MODE_SB) {
        if (hi == 0) li_l[r32] = l_reg;
        asm volatile("s_waitcnt lgkmcnt(0)" ::: "memory");
#pragma unroll
        for (int r = 0; r < 16; ++r) rli[r] = 1.0f / li_l[crow(r, hi)];
    } else {
#pragma unroll
        for (int r = 0; r < 16; ++r) rli[r] = 1.0f;
    }
    bf16_t* Ow = Ob + (size_t)(wid * QBLK) * ostride;
#pragma unroll
    for (int r = 0; r < 16; ++r) { const int orow = crow(r, hi);
#pragma unroll
        for (int d0 = 0; d0 < 4; ++d0) { const float v = o[d0][r] * rli[r]; const float vn = __shfl_xor(v, 1);
            if ((r32 & 1) == 0) *(unsigned*)(Ow + (size_t)orow * ostride + d0 * 32 + r32) = cvtpk(v, vn); } }
    __syncthreads();
}
}
constexpr int NWAVES = 8;
constexpr int BATCH = 8, SEQ = 2048, DM = 1024, T = BATCH * SEQ;
constexpr int MEMLEN = 256, TM = BATCH * MEMLEN;
constexpr int QLORA = 384, KVLORA = 256, ROPE = 64, NLAT = 704, NLATP = 768;
constexpr int HEADS = 8, NOPE = 128, DQK = 192, DV = 128;
constexpr int XH = 4, DFF = 4096;
constexpr float EPS = 1e-6f;
constexpr float LOG2E = 1.4426950408889634f;
constexpr float QSCALE_MLA = 0.07216878364870322f * LOG2E;
constexpr float QSCALE_128 = 0.08838834764831845f * LOG2E;

constexpr size_t MiB = 1u << 20;
constexpr size_t WS_CTL = 0, CTL_ZERO_BYTES = 64 * 1024;
constexpr size_t WS_RS = 1 * MiB / 2;
constexpr size_t WS_WDKV = 1 * MiB;
constexpr size_t WS_WUQ = WS_WDKV + (size_t)NLATP * DM * 2;
constexpr size_t WS_WUKV = WS_WUQ + (size_t)1536 * 384 * 2;
constexpr size_t WS_WO0 = WS_WUKV + (size_t)2048 * 256 * 2;
constexpr size_t WS_WXQ = WS_WO0 + (size_t)DM * DM * 2;
constexpr size_t WS_WXKV = WS_WXQ + 2 * (size_t)512 * DM * 2;
constexpr size_t WS_WXO = WS_WXKV + 2 * (size_t)DM * DM * 2;
constexpr size_t WS_WIN = WS_WXO + 2 * (size_t)DM * 512 * 2;
constexpr size_t WS_WOUT = WS_WIN + 2 * (size_t)DFF * DM * 2;
constexpr size_t WS_WQKV = WS_WOUT + 2 * (size_t)DM * DFF * 2;
constexpr size_t WS_WO1 = WS_WQKV + (size_t)3072 * DM * 2;
constexpr size_t WS_WEND = WS_WO1 + (size_t)DM * DM * 2;
static_assert(WS_WEND <= 56 * MiB, "weights");
constexpr size_t WS_HB = 56 * MiB;
constexpr size_t WS_KVX = 88 * MiB;
constexpr size_t WS_CS = 96 * MiB;
constexpr size_t WS_KPE = 100 * MiB;
constexpr size_t WS_MEMB = 102 * MiB;
constexpr size_t WS_SSQ = 106 * MiB;
constexpr size_t WS_X = 107 * MiB;
constexpr size_t WS_LAT = WS_X;
constexpr size_t WS_OB = WS_X;
constexpr size_t WS_Q = WS_X + 32 * MiB;
constexpr size_t WS_KN = WS_X + 80 * MiB;
constexpr size_t WS_V = WS_X + 112 * MiB;
constexpr size_t WS_K1 = WS_X + 64 * MiB, WS_V1 = WS_X + 96 * MiB;
constexpr size_t WS_QX = WS_X, WS_OX = WS_X + 16 * MiB;
constexpr size_t WS_U = WS_X;
constexpr size_t WS_END = WS_X + 144 * MiB;
static_assert(WS_END <= 256 * MiB, "d_ws map");
constexpr int RS_X = 0, RS_Q = T, RS_KV = 2 * T, RS_H = 3 * T, RS_MEM = 4 * T;
constexpr int CW_BAR = 1024;

constexpr int RING_OFF = 0, RING_BYTES = 131072;
constexpr int LDSCTL_OFF = RING_BYTES, MISC_OFF = LDSCTL_OFF + 320;
constexpr int LDS_BYTES = 147456;

#define GAS __attribute__((address_space(1)))
#define LAS __attribute__((address_space(3)))
typedef unsigned short bf16;
typedef unsigned v4u __attribute__((ext_vector_type(4)));
typedef float f32x4 __attribute__((ext_vector_type(4)));
typedef GAS unsigned gu32;
#define RLX_AGENT __ATOMIC_RELAXED, __HIP_MEMORY_SCOPE_AGENT
#define LDS_WAIT() asm volatile("s_waitcnt lgkmcnt(0)" ::: "memory")
#define VM_WAIT() asm volatile("s_waitcnt vmcnt(0)" ::: "memory")
__device__ __forceinline__ unsigned f2bf(float f) { unsigned u = __builtin_bit_cast(unsigned, f); return (u + 0x7fffu + ((u >> 16) & 1u)) >> 16; }
__device__ __forceinline__ unsigned pk2(float lo, float hi) { return f2bf(lo) | (f2bf(hi) << 16); }
__device__ __forceinline__ float bf2f(unsigned short b) { return __builtin_bit_cast(float, (unsigned)b << 16); }
__device__ __forceinline__ void store8(bf16* p, f32x4 a, f32x4 b) { v4u w; w.x = pg8::cvt_pk_bf16(a[0], a[1]); w.y = pg8::cvt_pk_bf16(a[2], a[3]); w.z = pg8::cvt_pk_bf16(b[0], b[1]); w.w = pg8::cvt_pk_bf16(b[2], b[3]); *(v4u*)p = w; }

#define XB_TMO      128
#define XB_XCNT(j)  (256  + 64 * (j))
#define XB_XSUB(j)  (1280 + 64 * (j))
#define XB_XGEN(j)  (2304 + 64 * (j))
#define XB_TOP      3328
#define XB_TOPGEN   3392
#define XCD_BAR_WORDS 3456
#define XB_SPIN_CAP (1u << 18)
__device__ __forceinline__ unsigned xb_ld(unsigned* p)              { return __hip_atomic_load(p, __ATOMIC_RELAXED, __HIP_MEMORY_SCOPE_AGENT); }
__device__ __forceinline__ unsigned xb_add(unsigned* p, unsigned v) { return __hip_atomic_fetch_add(p, v, __ATOMIC_RELAXED, __HIP_MEMORY_SCOPE_AGENT); }
__device__ __forceinline__ unsigned xb_xcc_id() { return (unsigned)__builtin_amdgcn_s_getreg((3 << 11) | 20) & 0xFu; }
#define XB_SPIN(cond, bar) do { unsigned _sp = 0; while (cond) { __builtin_amdgcn_s_sleep(1); \
    if ((++_sp & 255u) == 0u) { if (xb_ld(&(bar)[XB_TMO])) break; if (_sp > XB_SPIN_CAP) { atomicAdd(&(bar)[XB_TMO], 1u); break; } } } } while (0)
struct XcdBarrier { unsigned* bar; unsigned x; volatile LAS unsigned* st; };
__device__ __forceinline__ XcdBarrier xcd_barrier_post(unsigned* bar, volatile LAS unsigned* st) {
    XcdBarrier b; b.bar = bar; b.x = xb_xcc_id(); b.st = st;
    if (threadIdx.x == 0) (void)xb_add(&bar[XB_XCNT(b.x)], 1u);
    return b;
}
__device__ __forceinline__ void xcd_barrier_complete(unsigned* bar, unsigned x, unsigned& nloc, unsigned& nx) {
    const unsigned G = gridDim.x * gridDim.y * gridDim.z;
    unsigned sum, cnt, mine, sp = 0u;
    for (;;) {
        sum = 0u; cnt = 0u; mine = 0u;
#pragma unroll
        for (unsigned j = 0; j < 16; ++j) { const unsigned c = xb_ld(&bar[XB_XCNT(j)]); sum += c; cnt += (c > 0u) ? 1u : 0u; mine = (j == x) ? c : mine; }
        if (sum == G) break;
        __builtin_amdgcn_s_sleep(1);
        if ((++sp & 255u) == 0u) { if (xb_ld(&bar[XB_TMO])) break; if (sp > XB_SPIN_CAP) { atomicAdd(&bar[XB_TMO], 1u); break; } }
    }
    nloc = mine > 0u ? mine : 1u; nx = cnt > 0u ? cnt : 1u;
}
__device__ __forceinline__ void xcd_barrier(const XcdBarrier& b) {
    asm volatile("s_waitcnt vmcnt(0)" ::: "memory");
    __syncthreads();
    if (threadIdx.x == 0) {
        unsigned* bar = b.bar;
        __builtin_amdgcn_s_waitcnt(0);
        unsigned nloc = b.st[0], nx = b.st[1];
        if (nloc == 0u) { xcd_barrier_complete(bar, b.x, nloc, nx); b.st[0] = nloc; b.st[1] = nx; }
        const unsigned old = xb_add(&bar[XB_XSUB(b.x)], 1u);
        const unsigned gen = old / nloc;
        if (old + 1u == (gen + 1u) * nloc) {
            __builtin_amdgcn_fence(__ATOMIC_RELEASE, "agent");
            asm volatile("s_waitcnt vmcnt(0)" ::: "memory");
            const unsigned og = xb_add(&bar[XB_TOP], 1u);
            const unsigned tg = og / nx;
            if (og + 1u == (tg + 1u) * nx) xb_add(&bar[XB_TOPGEN], 1u);
            else XB_SPIN(xb_ld(&bar[XB_TOPGEN]) == tg, bar);
            __builtin_amdgcn_fence(__ATOMIC_ACQUIRE, "agent");
            xb_add(&bar[XB_XGEN(b.x)], 1u);
            asm volatile("s_waitcnt vmcnt(0)" ::: "memory");
        } else {
            XB_SPIN(xb_ld(&bar[XB_XGEN(b.x)]) == gen, bar);
            __builtin_amdgcn_fence(__ATOMIC_ACQUIRE, "agent");
            asm volatile("s_waitcnt vmcnt(0)" ::: "memory");
        }
    }
    __syncthreads();
}

__device__ __forceinline__ float wave_sum(float v) {
#pragma unroll
    for (int o = 1; o < 64; o <<= 1) v += __shfl_xor(v, o);
    return v;
}
__device__ __forceinline__ void transpose_item(const float* W, int K, int N, bf16* WT, const float* gain, int permq, LAS float* scr, int item, int lane) {
    const int nblk = N / 32, kb = item / nblk, nb = item - kb * nblk, k0 = 64 * kb, n0 = 32 * nb;
    const int lr = lane >> 3, lc = (lane & 7) * 4;
    f32x4 v[8];
#pragma unroll
    for (int i = 0; i < 8; ++i) v[i] = *(const GAS f32x4*)(W + (size_t)(k0 + i * 8 + lr) * N + n0 + lc);
    if (gain) {
#pragma unroll
        for (int i = 0; i < 8; ++i) v[i] = v[i] * gain[k0 + i * 8 + lr];
    }
#pragma unroll
    for (int i = 0; i < 8; ++i) { LAS float* d = scr + (i * 8 + lr) * 33 + lc; d[0] = v[i][0]; d[1] = v[i][1]; d[2] = v[i][2]; d[3] = v[i][3]; }
    LDS_WAIT(); asm volatile("" ::: "memory");
    const int c = lane & 7;
#pragma unroll
    for (int j = 0; j < 4; ++j) { const int n = (lane >> 3) + 8 * j; const LAS float* sp = scr + (8 * c) * 33 + n;
        v4u o; o.x = pk2(sp[0 * 33], sp[1 * 33]); o.y = pk2(sp[2 * 33], sp[3 * 33]); o.z = pk2(sp[4 * 33], sp[5 * 33]); o.w = pk2(sp[6 * 33], sp[7 * 33]);
        int drow = n0 + n;
        if (permq) { const int h = drow / DQK, d = drow - h * DQK; if (d >= NOPE) { const int cc = d - NOPE; drow = h * DQK + NOPE + 2 * (cc & 31) + (cc >> 5); } }
        *(GAS v4u*)(WT + (size_t)drow * K + k0 + 8 * c) = o; }
    LDS_WAIT(); asm volatile("" ::: "memory");
}
__device__ __forceinline__ void rowstat_1024(const float* xrow, bf16* orow, float* rs, int lane) {
    const GAS f32x4* xr = (const GAS f32x4*)xrow + lane;
    f32x4 v[4]; float s = 0.f;
#pragma unroll
    for (int j = 0; j < 4; ++j) { v[j] = xr[64 * j]; s += (v[j].x * v[j].x + v[j].y * v[j].y) + (v[j].z * v[j].z + v[j].w * v[j].w); }
    const float r = 1.0f / sqrtf(wave_sum(s) * (1.0f / 1024.0f) + EPS);
    if (lane == 0) *rs = r;
    GAS unsigned long long* o8 = (GAS unsigned long long*)orow + lane;
#pragma unroll
    for (int j = 0; j < 4; ++j) o8[64 * j] = (unsigned long long)pk2(v[j].x, v[j].y) | ((unsigned long long)pk2(v[j].z, v[j].w) << 32);
}

__device__ __forceinline__ float rs_from_partials(const float* ssqp, int row) {
    const f32x4* p = (const f32x4*)(ssqp + (size_t)row * 16); const f32x4 a = p[0], b = p[1], c = p[2], d = p[3];
    const float s = (((a[0] + a[1]) + (a[2] + a[3])) + ((b[0] + b[1]) + (b[2] + b[3]))) + (((c[0] + c[1]) + (c[2] + c[3])) + ((d[0] + d[1]) + (d[2] + d[3])));
    return 1.0f / sqrtf(s * (1.0f / 1024.0f) + EPS); }
struct FLat { bf16* lat; const float* rs;
    __device__ __forceinline__ float rowscale(int row) const { return rs[row]; }
    __device__ __forceinline__ void operator()(int row, int col, f32x4 v0, f32x4 v1) const { store8(lat + (size_t)row * NLATP + col, v0, v1); } };
struct FMemKV { bf16* kx; bf16* vx; const float* rs;
    __device__ __forceinline__ float rowscale(int row) const { return rs[row]; }
    __device__ __forceinline__ void operator()(int row, int col, f32x4 v0, f32x4 v1) const {
        const int b = row >> 8, m = row & 255, t = col >> 9, c = col & 511, h = c >> 7, d = c & 127;
        bf16* p = (t ? vx : kx) + ((size_t)((b * XH + h) * MEMLEN + m)) * 128 + d; store8(p, v0, v1); } };
struct FQ0 { bf16* q; const float* rs; const float2* cs;
    __device__ __forceinline__ float rowscale(int row) const { return rs[row] * QSCALE_MLA; }
    __device__ __forceinline__ void operator()(int row, int col, f32x4 v0, f32x4 v1) const {
        const int h = col / DQK, d = col - h * DQK;
        if (d >= NOPE) { const float2* c = cs + (size_t)row * 32 + ((d - NOPE) >> 1);
            const float2 c0 = c[0], c1 = c[1], c2 = c[2], c3 = c[3];
            const f32x4 a = v0, b = v1;
            v0[0] = a[0] * c0.x - a[1] * c0.y; v0[1] = a[0] * c0.y + a[1] * c0.x; v0[2] = a[2] * c1.x - a[3] * c1.y; v0[3] = a[2] * c1.y + a[3] * c1.x;
            v1[0] = b[0] * c2.x - b[1] * c2.y; v1[1] = b[0] * c2.y + b[1] * c2.x; v1[2] = b[2] * c3.x - b[3] * c3.y; v1[3] = b[2] * c3.y + b[3] * c3.x; }
        const int bb = row >> 11, si = row & 2047;
        store8(q + ((size_t)((bb * HEADS + h) * SEQ + si)) * DQK + d, v0, v1); } };
struct FKV0 { bf16* kn; bf16* v; const float* rs;
    __device__ __forceinline__ float rowscale(int row) const { return rs[row]; }
    __device__ __forceinline__ void operator()(int row, int col, f32x4 v0, f32x4 v1) const {
        const int h = col >> 8, j = col & 255, bb = row >> 11, si = row & 2047;
        bf16* p = (j < 128 ? kn : v) + ((size_t)((bb * HEADS + h) * SEQ + si)) * 128 + (j & 127); store8(p, v0, v1); } };
struct FXQ { bf16* qx; const float* ssqp;
    __device__ __forceinline__ float rowscale(int row) const { return rs_from_partials(ssqp, row) * QSCALE_128; }
    __device__ __forceinline__ void operator()(int row, int col, f32x4 v0, f32x4 v1) const {
        const int h = col >> 7, d = col & 127, bb = row >> 11, si = row & 2047;
        store8(qx + ((size_t)((bb * XH + h) * SEQ + si)) * 128 + d, v0, v1); } };
struct FUp { bf16* u; const float* ssqp;
    __device__ __forceinline__ float rowscale(int row) const { return rs_from_partials(ssqp, row); }
    __device__ __forceinline__ void operator()(int row, int col, f32x4 v0, f32x4 v1) const {
#pragma unroll
        for (int j = 0; j < 4; ++j) { const float a = fmaxf(v0[j], 0.f), b = fmaxf(v1[j], 0.f); v0[j] = a * a; v1[j] = b * b; }
        store8(u + (size_t)row * DFF + col, v0, v1); } };
struct FQKV1 { bf16* q; bf16* k; bf16* v; const float* ssqp;
    __device__ __forceinline__ float rowscale(int row) const { return rs_from_partials(ssqp, row); }
    __device__ __forceinline__ void operator()(int row, int col, f32x4 v0, f32x4 v1) const { const int t = col >> 10, c = col & 1023, h = c >> 7, d = c & 127, bb = row >> 11, si = row & 2047;
        const float s = (t == 0 ? QSCALE_128 : 1.0f);
        bf16* p = q + (size_t)t * (32u << 19) + ((size_t)((bb * HEADS + h) * SEQ + si)) * 128 + d; store8(p, v0 * s, v1 * s); } };

struct Args { const float* in[21]; float* out; unsigned char* ws; int ph_lo, ph_hi; };
static_assert(sizeof(Args) == 21 * 8 + 8 + 8 + 8, "Args has no padding");

enum { PH_PRO = 0, PH_DKV, PH_LATSTAT, PH_UQKV, PH_ATT0, PH_WO0, PH_XQ0, PH_XA0, PH_XO0, PH_UP0, PH_DN0,
       PH_QKV1, PH_ATT1, PH_WO1, PH_XQ1, PH_XA1, PH_XO1, PH_UP1, PH_DN1, PH_FINAL, NPH };

__global__ void __launch_bounds__(NWAVES * 64, 2) mk_fwd(Args args) {
    extern __shared__ __attribute__((aligned(16))) unsigned char lds_raw[];
    LAS unsigned char* lds = (LAS unsigned char*)lds_raw;
    volatile LAS unsigned* MISC = (volatile LAS unsigned*)(lds + MISC_OFF);
    const int tid = threadIdx.x, lane = tid & 63, wave = __builtin_amdgcn_readfirstlane(tid >> 6);
    const int G = gridDim.x; int vcu; { const int bx = blockIdx.x; vcu = (G % 8 == 0) ? (bx % 8) * (G / 8) + bx / 8 : bx; }
    unsigned char* ws = args.ws;
    gu32* ctl = (gu32*)(ws + WS_CTL);
    for (int u = tid; u < (LDS_BYTES - LDSCTL_OFF) / 4; u += NWAVES * 64) ((LAS unsigned*)(lds + LDSCTL_OFF))[u] = 0u;
    __syncthreads();
    const int lo = args.ph_lo, hi = args.ph_hi;
    const bool one_phase = (hi - lo == 1);
    XcdBarrier bar; bar.bar = (unsigned*)(ctl + CW_BAR); bar.x = 0; bar.st = nullptr;
    if (!one_phase) bar = xcd_barrier_post((unsigned*)(ctl + CW_BAR), MISC + 8);
#define IN(k) (lo <= (k) && (k) < hi)
#ifndef PROBE_MASK
#define PROBE_MASK 0u
#endif
#ifndef PROBE_DBLBAR
#define PROBE_DBLBAR 0
#endif
    unsigned long long t_prev = PROBE_MASK ? __builtin_amdgcn_s_memrealtime() : 0ull, t_acc = 0ull;
#define SEAM(k) do { if (IN(k) && IN((k) + 1)) { xcd_barrier(bar); if (PROBE_DBLBAR) xcd_barrier(bar); } \
    if (PROBE_MASK) { const unsigned long long t_now = __builtin_amdgcn_s_memrealtime(); if ((PROBE_MASK >> (k)) & 1u) t_acc += t_now - t_prev; t_prev = t_now; } } while (0)

    const float* x = args.in[0]; const float* mem = args.in[1]; const int* positions = (const int*)args.in[2];
    const float* norm_mix = args.in[3]; const float* norm_cross = args.in[4]; const float* norm_mem = args.in[5]; const float* norm_mlp = args.in[6]; const float* norm_final = args.in[7];
#define WSL() ({ unsigned char* _p = ws; asm volatile("" : "+s"(_p)); _p; })
#define rsb ((float*)(WSL() + WS_RS))
#define HB ((bf16*)(WSL() + WS_HB))
#define MEMB ((bf16*)(WSL() + WS_MEMB))
#define LAT ((bf16*)(WSL() + WS_LAT))
#define CS ((float2*)(WSL() + WS_CS))
#define KPE ((bf16*)(WSL() + WS_KPE))
#define OB ((bf16*)(WSL() + WS_OB))
#define QB_ ((bf16*)(WSL() + WS_Q))
#define KN ((bf16*)(WSL() + WS_KN))
#define VV ((bf16*)(WSL() + WS_V))
#define K1 ((bf16*)(WSL() + WS_K1))
#define V1 ((bf16*)(WSL() + WS_V1))
#define QX ((bf16*)(WSL() + WS_QX))
#define OX ((bf16*)(WSL() + WS_OX))
#define U ((bf16*)(WSL() + WS_U))
#define SSQP ((float*)(WSL() + WS_SSQ))
    float* hres = args.out;
    const int gw = vcu * NWAVES + wave, NGW = G * NWAVES;

    if (IN(PH_PRO)) {
        LAS float* scr = (LAS float*)(lds + RING_OFF + wave * 16384);
        struct Job { const float* W; int K, N; size_t dst; const float* gain; int permq; };
        constexpr int C0 = 352, C1 = C0 + 288, C2 = C1 + 256, C3 = C2 + 512, C4 = C3 + 256, C5 = C4 + 256, C6 = C5 + 512, C7 = C6 + 512, C8 = C7 + 256, C9 = C8 + 256,
                      C10 = C9 + 2048, C11 = C10 + 2048, C12 = C11 + 2048, C13 = C12 + 2048, C14 = C13 + 1536, C15 = C14 + 512;
        for (int fit = gw; fit < C15; fit += NGW) {
            Job jb; int it;
            if (fit < C0) { it = fit; jb = {args.in[8], DM, NLAT, WS_WDKV, norm_mix, 0}; }
            else if (fit < C1) { it = fit - C0; jb = {args.in[11], QLORA, 1536, WS_WUQ, args.in[9], 1}; }
            else if (fit < C2) { it = fit - C1; jb = {args.in[12], KVLORA, 2048, WS_WUKV, args.in[10], 0}; }
            else if (fit < C3) { it = fit - C2; jb = {args.in[13], DM, DM, WS_WO0, nullptr, 0}; }
            else if (fit < C4) { it = fit - C3; jb = {args.in[16], DM, 512, WS_WXQ, norm_cross, 0}; }
            else if (fit < C5) { it = fit - C4; jb = {args.in[16] + (size_t)DM * 512, DM, 512, WS_WXQ + (size_t)512 * DM * 2, norm_cross + DM, 0}; }
            else if (fit < C6) { it = fit - C5; jb = {args.in[17], DM, DM, WS_WXKV, norm_mem, 0}; }
            else if (fit < C7) { it = fit - C6; jb = {args.in[17] + (size_t)DM * DM, DM, DM, WS_WXKV + (size_t)DM * DM * 2, norm_mem + DM, 0}; }
            else if (fit < C8) { it = fit - C7; jb = {args.in[18], 512, DM, WS_WXO, nullptr, 0}; }
            else if (fit < C9) { it = fit - C8; jb = {args.in[18] + (size_t)512 * DM, 512, DM, WS_WXO + (size_t)DM * 512 * 2, nullptr, 0}; }
            else if (fit < C10) { it = fit - C9; jb = {args.in[19], DM, DFF, WS_WIN, norm_mlp, 0}; }
            else if (fit < C11) { it = fit - C10; jb = {args.in[19] + (size_t)DM * DFF, DM, DFF, WS_WIN + (size_t)DFF * DM * 2, norm_mlp + DM, 0}; }
            else if (fit < C12) { it = fit - C11; jb = {args.in[20], DFF, DM, WS_WOUT, nullptr, 0}; }
            else if (fit < C13) { it = fit - C12; jb = {args.in[20] + (size_t)DFF * DM, DFF, DM, WS_WOUT + (size_t)DM * DFF * 2, nullptr, 0}; }
            else if (fit < C14) { it = fit - C13; jb = {args.in[14], DM, 3072, WS_WQKV, norm_mix + DM, 0}; }
            else { it = fit - C14; jb = {args.in[15], DM, DM, WS_WO1, nullptr, 0}; }
            transpose_item(jb.W, jb.K, jb.N, (bf16*)(WSL() + jb.dst), jb.gain, jb.permq, scr, it, lane);
        }
        { GAS v4u* z = (GAS v4u*)(WSL() + WS_WDKV + (size_t)NLAT * DM * 2); const int n16 = (NLATP - NLAT) * DM * 2 / 16;
            for (int i = blockIdx.x * (NWAVES * 64) + tid; i < n16; i += G * NWAVES * 64) z[i] = (v4u){0u, 0u, 0u, 0u}; }
        for (int i = blockIdx.x * (NWAVES * 64) + tid; i < T * 32; i += G * NWAVES * 64) {
            const int tok = i >> 5, f = i & 31;
            const float inv = powf(10000.0f, -(float)(2 * f) / 64.0f);
            const float ang = (float)positions[tok] * inv;
            CS[i] = make_float2(cosf(ang), sinf(ang));
        }
        for (int m = gw; m < T; m += NGW) rowstat_1024(x + (size_t)m * DM, HB + (size_t)m * DM, rsb + RS_X + m, lane);
        for (int m = gw; m < TM; m += NGW) rowstat_1024(mem + (size_t)m * DM, MEMB + (size_t)m * DM, rsb + RS_MEM + m, lane);
    }
    SEAM(PH_PRO);

    if (IN(PH_DKV)) {
        { pg8::Gemm g{HB, (const bf16*)(WSL() + WS_WDKV), T, NLATP, DM, DM}; pg8::StaticOrder S; S.init(T, NLATP, G, (int)blockIdx.x);
          pg8::EpiB<FLat> E{{LAT, rsb + RS_X}}; pg8::gemm_phase<pg8::EpiB<FLat>, pg8::StaticOrder, true>(lds + RING_OFF, g, S, E); }
        for (int l = 0; l < 2; ++l) {
          pg8::Gemm g{MEMB, (const bf16*)(WSL() + WS_WXKV + (size_t)l * DM * DM * 2), TM, DM, DM, DM}; pg8::StaticOrder S; S.init(TM, DM, G, (int)((blockIdx.x + 64 - 32 * l) % G));
          bf16* kx = (bf16*)(WSL() + WS_KVX + (size_t)l * 4 * MiB);
          pg8::EpiB<FMemKV> E{{kx, kx + (size_t)TM * 512, rsb + RS_MEM}}; pg8::gemm_phase<pg8::EpiB<FMemKV>, pg8::StaticOrder, true>(lds + RING_OFF, g, S, E); }
    }
    SEAM(PH_DKV);

    if (IN(PH_LATSTAT)) {
        for (int m = gw; m < T; m += NGW) {
            const bf16* lr = LAT + (size_t)m * NLATP; float sq = 0.f, skv = 0.f;
#pragma unroll
            for (int j = 0; j < 3; ++j) { const int c = j * 64 + lane; const unsigned long long w = *(const GAS unsigned long long*)(lr + 4 * c);
                const float a0 = bf2f((unsigned short)w), a1 = bf2f((unsigned short)(w >> 16)), a2 = bf2f((unsigned short)(w >> 32)), a3 = bf2f((unsigned short)(w >> 48));
                const float s = (a0 * a0 + a1 * a1) + (a2 * a2 + a3 * a3);
                if (c < 96) sq += s; else if (c < 160) skv += s; }
            sq = wave_sum(sq); skv = wave_sum(skv);
            if (lane == 0) { rsb[RS_Q + m] = 1.0f / sqrtf(sq * (1.0f / QLORA) + EPS); rsb[RS_KV + m] = 1.0f / sqrtf(skv * (1.0f / KVLORA) + EPS); }
            if (lane < 32) { const float x1 = bf2f(lr[640 + lane]), x2 = bf2f(lr[672 + lane]); const float2 c = CS[(size_t)m * 32 + lane];
                *(GAS unsigned*)(KPE + (size_t)m * 64 + 2 * lane) = pk2(x1 * c.x - x2 * c.y, x1 * c.y + x2 * c.x); }
        }
    }
    SEAM(PH_LATSTAT);

    if (IN(PH_UQKV)) {
        { pg8::Gemm g{LAT, (const bf16*)(WSL() + WS_WUQ), T, 1536, QLORA, NLATP}; pg8::StaticOrder S; S.init(T, 1536, G, (int)blockIdx.x);
          pg8::EpiB<FQ0> E{{QB_, rsb + RS_Q, CS}}; pg8::gemm_phase<pg8::EpiB<FQ0>, pg8::StaticOrder, true>(lds + RING_OFF, g, S, E); }
        { pg8::Gemm g{LAT + QLORA, (const bf16*)(WSL() + WS_WUKV), T, 2048, KVLORA, NLATP}; pg8::StaticOrder S; S.init(T, 2048, G, (int)((blockIdx.x + 128) % G));
          pg8::EpiB<FKV0> E{{KN, VV, rsb + RS_KV}}; pg8::gemm_phase<pg8::EpiB<FKV0>, pg8::StaticOrder, true>(lds + RING_OFF, g, S, E); }
    }
    SEAM(PH_UQKV);

    if (IN(PH_ATT0)) {
        for (int pu = vcu; pu < 256; pu += G) { const int bh = pu >> 2, s = pu & 3, b = bh >> 3, h = bh & 7;
            for (int pass = 0; pass < 2; ++pass) { const int qb = pass ? s : 7 - s;
                att::attn_unit<att::MODE_MLA>(lds + RING_OFF, QB_ + ((size_t)bh * SEQ + qb * 256) * DQK, KN + (size_t)bh * SEQ * 128, KPE + (size_t)b * SEQ * 64, VV + (size_t)bh * SEQ * 128,
                    OB + ((size_t)b * SEQ + qb * 256) * DM + h * 128, DM, qb * 256, 0); } }
    }
    SEAM(PH_ATT0);

    for (int layer = 0; layer < 2; ++layer) {
        const int PB = layer ? PH_WO1 : PH_WO0;
        if (layer == 1) {
            if (IN(PH_QKV1)) { pg8::Gemm g{HB, (const bf16*)(WSL() + WS_WQKV), T, 3072, DM, DM}; pg8::StaticOrder S; S.init(T, 3072, G, (int)blockIdx.x);
                pg8::EpiB<FQKV1> E{{QB_, K1, V1, SSQP}}; pg8::gemm_phase<pg8::EpiB<FQKV1>, pg8::StaticOrder, true>(lds + RING_OFF, g, S, E); }
            SEAM(PH_QKV1);
            if (IN(PH_ATT1)) {
                for (int u = vcu; u < 512; u += G) { const int bh = u >> 3, qb = u & 7, b = bh >> 3, h = bh & 7;
                    att::attn_unit<att::MODE_SB>(lds + RING_OFF, QB_ + ((size_t)bh * SEQ + qb * 256) * 128, K1 + (size_t)bh * SEQ * 128, nullptr, V1 + (size_t)bh * SEQ * 128,
                        OB + ((size_t)b * SEQ + qb * 256) * DM + h * 128, DM, qb * 256, 0); }
            }
            SEAM(PH_ATT1);
        }
        if (IN(PB)) { pg8::Gemm g{OB, (const bf16*)(WSL() + (layer ? WS_WO1 : WS_WO0)), T, DM, DM, DM}; pg8::StaticOrder S; S.init(T, DM, G, (int)blockIdx.x);
            pg8::EpiResN E{layer ? hres : x, hres, HB, SSQP}; pg8::gemm_phase<pg8::EpiResN, pg8::StaticOrder, true>(lds + RING_OFF, g, S, E); }
        SEAM(PB);
        if (IN(PB + 1)) { pg8::Gemm g{HB, (const bf16*)(WSL() + WS_WXQ + (size_t)layer * 512 * DM * 2), T, 512, DM, DM}; pg8::StaticOrder S; S.init(T, 512, G, (int)blockIdx.x);
            pg8::EpiB<FXQ> E{{QX, SSQP}}; pg8::gemm_phase<pg8::EpiB<FXQ>, pg8::StaticOrder, true>(lds + RING_OFF, g, S, E); }
        SEAM(PB + 1);
        if (IN(PB + 2)) { const bf16* kx = (const bf16*)(WSL() + WS_KVX + (size_t)layer * 4 * MiB); const bf16* vx = kx + (size_t)TM * 512;
            for (int u = vcu; u < 256; u += G) { const int bh = u >> 3, qb = u & 7, b = bh >> 2, h = bh & 3;
                att::attn_unit<att::MODE_CROSS>(lds + RING_OFF, QX + ((size_t)bh * SEQ + qb * 256) * 128, kx + (size_t)bh * MEMLEN * 128, nullptr, vx + (size_t)bh * MEMLEN * 128,
                    OX + ((size_t)b * SEQ + qb * 256) * 512 + h * 128, 512, 0, MEMLEN); } }
        SEAM(PB + 2);
        if (IN(PB + 3)) { pg8::Gemm g{OX, (const bf16*)(WSL() + WS_WXO + (size_t)layer * DM * 512 * 2), T, DM, 512, 512}; pg8::StaticOrder S; S.init(T, DM, G, (int)blockIdx.x);
            pg8::EpiResN E{hres, hres, HB, SSQP}; pg8::gemm_phase<pg8::EpiResN, pg8::StaticOrder, true>(lds + RING_OFF, g, S, E); }
        SEAM(PB + 3);
        if (IN(PB + 4)) { pg8::Gemm g{HB, (const bf16*)(WSL() + WS_WIN + (size_t)layer * DFF * DM * 2), T, DFF, DM, DM}; pg8::StaticOrder S; S.init(T, DFF, G, (int)blockIdx.x);
            pg8::EpiB<FUp> E{{U, SSQP}}; pg8::gemm_phase<pg8::EpiB<FUp>, pg8::StaticOrder, true>(lds + RING_OFF, g, S, E); }
        SEAM(PB + 4);
        if (IN(PB + 5)) { pg8::Gemm g{U, (const bf16*)(WSL() + WS_WOUT + (size_t)layer * DM * DFF * 2), T, DM, DFF, DFF}; pg8::StaticOrder S; S.init(T, DM, G, (int)blockIdx.x);
            pg8::EpiResN E{hres, hres, HB, SSQP}; pg8::gemm_phase<pg8::EpiResN, pg8::StaticOrder, true>(lds + RING_OFF, g, S, E); }
        SEAM(PB + 5);
        if (layer == 1) {
            if (IN(PH_FINAL)) {
                for (int m = gw; m < T; m += NGW) {
                    GAS f32x4* xr = (GAS f32x4*)(hres + (size_t)m * DM) + lane; const GAS f32x4* gr = (const GAS f32x4*)norm_final + lane;
                    f32x4 v[4]; float s = 0.f;
#pragma unroll
                    for (int j = 0; j < 4; ++j) { v[j] = xr[64 * j]; s += (v[j].x * v[j].x + v[j].y * v[j].y) + (v[j].z * v[j].z + v[j].w * v[j].w); }
                    const float r = 1.0f / sqrtf(wave_sum(s) * (1.0f / 1024.0f) + EPS);
#pragma unroll
                    for (int j = 0; j < 4; ++j) xr[64 * j] = v[j] * r * gr[64 * j];
                }
            }
        }
    }
    if (PROBE_MASK) { const unsigned long long t_now = __builtin_amdgcn_s_memrealtime(); if ((PROBE_MASK >> (NPH - 1)) & 1u) t_acc += t_now - t_prev;
        if (blockIdx.x == 0 && tid == 0) { while (__builtin_amdgcn_s_memrealtime() - t_now < 4ull * t_acc) __builtin_amdgcn_s_sleep(32); } }
#undef IN
#undef SEAM
}

#ifndef MK_N_LAUNCHES
#define MK_N_LAUNCHES 1
#endif
extern "C" void kernel_launch(void* const* d_in, const int* in_sizes, int n_in, void* d_out, int out_size, void* d_ws, size_t ws_size, hipStream_t stream) {
    static int grid = 0;
    if (grid == 0) {
        if (n_in != 21 || in_sizes[0] != T * DM || out_size != T * DM || ws_size < WS_END) { fprintf(stderr, "kernel_launch: unexpected shapes (n_in %d, in0 %d, out %d, ws %zu)\n", n_in, n_in > 0 ? in_sizes[0] : -1, out_size, ws_size); grid = -1; return; }
        int dev = 0, cus = 0, per_cu = 0;
        if (hipGetDevice(&dev) != hipSuccess || hipDeviceGetAttribute(&cus, hipDeviceAttributeMultiprocessorCount, dev) != hipSuccess) { grid = -1; return; }
        if (hipFuncSetAttribute((const void*)mk_fwd, hipFuncAttributeMaxDynamicSharedMemorySize, LDS_BYTES) != hipSuccess) { fprintf(stderr, "kernel_launch: hipFuncSetAttribute failed\n"); grid = -1; return; }
        if (hipOccupancyMaxActiveBlocksPerMultiprocessor(&per_cu, (const void*)mk_fwd, NWAVES * 64, LDS_BYTES) != hipSuccess || per_cu < 1)
            fprintf(stderr, "kernel_launch: note: occupancy query reports %d workgroups per CU\n", per_cu);
        (void)hipGetLastError();
        grid = cus;
    }
    if (grid < 0) return;
    (void)hipMemsetAsync((char*)d_ws + WS_CTL, 0, CTL_ZERO_BYTES, stream);
    Args a{};
    for (int i = 0; i < 21; ++i) a.in[i] = (const float*)d_in[i];
    a.out = (float*)d_out; a.ws = (unsigned char*)d_ws;
#if MK_N_LAUNCHES == 1
    a.ph_lo = 0; a.ph_hi = NPH;
    hipLaunchKernelGGL(mk_fwd, dim3(grid), dim3(NWAVES * 64), LDS_BYTES, stream, a);
#else
    for (int p = 0; p < NPH; ++p) { a.ph_lo = p; a.ph_hi = p + 1; hipLaunchKernelGGL(mk_fwd, dim3(grid), dim3(NWAVES * 64), LDS_BYTES, stream, a); }
#endif
}
```

```cpp
#include <hip/hip_runtime.h>
#include <cstdio>
#include <cstdint>
namespace pg8 {
#define PG8_LAS __attribute__((address_space(3)))
typedef unsigned short bf16_t;
typedef short bf16x8 __attribute__((ext_vector_type(8)));
typedef float f32x4 __attribute__((ext_vector_type(4)));
typedef unsigned u32x4 __attribute__((ext_vector_type(4)));
constexpr int BM = 256, BK = 64, HALF = 128, HTB = HALF * BK * 2  , STAGE_BYTES = 8 * HTB, NXCD = 8, WGM = 8;

__host__ __device__ __forceinline__ int lds_byte(int r, int c) { const int st = (r >> 4) * 2 + (c >> 5), rr = r & 15, cc = c & 31, ob = rr * 64 + cc * 2; return st * 1024 + (ob ^ (((ob >> 9) & 1) << 5)); }
__host__ __device__ __forceinline__ void stage_rc(int b, int& R, int& C) { const int st = b / 1024, sb = b % 1024, swz = sb ^ (((sb >> 9) & 1) << 5); R = (st >> 1) * 16 + swz / 64; C = (st & 1) * 32 + (swz % 64) / 2; }
__host__ __device__ __forceinline__ int perm32(int rho) { const int n = rho >> 4, i = rho & 15; return 8 * (i >> 2) + 4 * n + (i & 3); }

struct Unit { int pm, pn; };
struct Gemm { const bf16_t* A; const bf16_t* Bt; int M, N, K, lda; };

struct StaticOrder {
    int nM, nN, nwg, G, c;
    __host__ __device__ void init(int M, int N, int G_, int c_) { nM = M / BM; nN = N / BM; nwg = nM * nN; G = G_; c = c_; }
    __host__ __device__ bool next(int i, Unit& u) const {
        const long L = (long)i * G + c; if (L >= nwg) return false;
        int wgid = (int)L; { const int q = nwg / NXCD, r = nwg % NXCD, xcd = wgid % NXCD, off = wgid / NXCD; wgid = (xcd < r ? xcd * (q + 1) : r * (q + 1) + (xcd - r) * q) + off; }
        const int nig = WGM * nN, gid = wgid / nig, fm = gid * WGM, gsz = (nM - fm) < WGM ? (nM - fm) : WGM;
        u.pm = fm + ((wgid % nig) % gsz); u.pn = (wgid % nig) / gsz; return true;
    }
};

__device__ __forceinline__ unsigned cvt_pk_bf16(float lo, float hi) { unsigned r; asm volatile("v_cvt_pk_bf16_f32 %0, %1, %2" : "=v"(r) : "v"(lo), "v"(hi)); return r; }

template <class F> struct EpiB {
    static constexpr bool PERM = true;
    F f;
    __device__ __forceinline__ void operator()(const f32x4 (&acc)[2][2][4][2], const Unit& u, int wr, int wc, int fr, int fq) const {
        const int row0 = u.pm * BM + wr * 64 + fr, col0 = u.pn * BM + wc * 32 + 8 * fq;
#pragma unroll
        for (int ai = 0; ai < 2; ++ai)
#pragma unroll
            for (int m = 0; m < 4; ++m) { const int row = row0 + ai * HALF + m * 16; const float rsc = f.rowscale(row);
#pragma unroll
                for (int bj = 0; bj < 2; ++bj) f(row, col0 + bj * HALF, acc[ai][bj][m][0] * rsc, acc[ai][bj][m][1] * rsc); }
    }
};
struct EpiRes {
    static constexpr bool PERM = false;
    const float* base; float* out; int ldc;
    __device__ __forceinline__ void operator()(const f32x4 (&acc)[2][2][4][2], const Unit& u, int wr, int wc, int fr, int fq) const {
        const int row0 = u.pm * BM + wr * 64 + fr, col0 = u.pn * BM + wc * 32 + 4 * fq;
#pragma unroll
        for (int ai = 0; ai < 2; ++ai)
#pragma unroll
            for (int m = 0; m < 4; ++m) { const size_t off = (size_t)(row0 + ai * HALF + m * 16) * ldc + col0;
#pragma unroll
                for (int bj = 0; bj < 2; ++bj)
#pragma unroll
                    for (int n = 0; n < 2; ++n) { const size_t o = off + bj * HALF + n * 16; *(f32x4*)(out + o) = *(const f32x4*)(base + o) + acc[ai][bj][m][n]; } }
    }
};

template <bool BASE_F32> struct EpiResN {
    static constexpr bool PERM = true;
    const float* basef; bf16_t* hb; float* ssqp;
    __device__ __forceinline__ void operator()(const f32x4 (&acc)[2][2][4][2], const Unit& u, int wr, int wc, int fr, int fq) const {
        const int row0 = u.pm * BM + wr * 64 + fr, col0 = u.pn * BM + wc * 32 + 8 * fq;
#pragma unroll
        for (int ai = 0; ai < 2; ++ai)
#pragma unroll
            for (int m = 0; m < 4; ++m) { const int row = row0 + ai * HALF + m * 16; float ss = 0.f;
#pragma unroll
                for (int bj = 0; bj < 2; ++bj) { const size_t o = (size_t)row * 1024 + col0 + bj * HALF;
                    f32x4 a, b;
                    if (BASE_F32) { a = *(const f32x4*)(basef + o); b = *(const f32x4*)(basef + o + 4); }
                    else { const u32x4 w = *(const u32x4*)(hb + o);
                        a = (f32x4){__builtin_bit_cast(float, w.x << 16), __builtin_bit_cast(float, w.x & 0xffff0000u), __builtin_bit_cast(float, w.y << 16), __builtin_bit_cast(float, w.y & 0xffff0000u)};
                        b = (f32x4){__builtin_bit_cast(float, w.z << 16), __builtin_bit_cast(float, w.z & 0xffff0000u), __builtin_bit_cast(float, w.w << 16), __builtin_bit_cast(float, w.w & 0xffff0000u)}; }
                    a = a + acc[ai][bj][m][0]; b = b + acc[ai][bj][m][1];
                    u32x4 w2; w2.x = cvt_pk_bf16(a[0], a[1]); w2.y = cvt_pk_bf16(a[2], a[3]); w2.z = cvt_pk_bf16(b[0], b[1]); w2.w = cvt_pk_bf16(b[2], b[3]); *(u32x4*)(hb + o) = w2;
                    ss += ((a[0] * a[0] + a[1] * a[1]) + (a[2] * a[2] + a[3] * a[3])) + ((b[0] * b[0] + b[1] * b[1]) + (b[2] * b[2] + b[3] * b[3])); }
                ss += __shfl_xor(ss, 16); ss += __shfl_xor(ss, 32);
                if (fq == 0) ssqp[(size_t)row * 16 + u.pn * 4 + wc] = ss; }
    }
};

template <class Epi, class Sched, bool ALIGN_EPI>
__device__ __forceinline__ void gemm_phase(PG8_LAS unsigned char* lds, const Gemm g, const Sched& S, const Epi& E) {
    int tid = threadIdx.x; asm volatile("" : "+v"(tid));
    const int wid = __builtin_amdgcn_readfirstlane(tid >> 6), lane = tid & 63, wr = wid >> 2, wc = wid & 3, fr = lane & 15, fq = lane >> 4;
    const int K = g.K, nt = K / BK;
    unsigned voffA[2], voffB[2];
#pragma unroll
    for (int i = 0; i < 2; ++i) { int R, C; stage_rc(tid * 16 + i * 8192, R, C); const int Rb = Epi::PERM ? ((R & ~31) + perm32(R & 31)) : R;
        voffA[i] = (unsigned)(R * g.lda + C) * 2u; voffB[i] = (unsigned)(Rb * K + C) * 2u; }
    const size_t kstep = (size_t)(BK * 2);
    const size_t hstepA = (size_t)HALF * g.lda * 2, hstepB = (size_t)HALF * K * 2;
    const size_t tstepA = 2 * hstepA, tstepB = 2 * hstepB;
    const unsigned ldsw = (unsigned)wid * 1024u;
    const int aoff = lds_byte(wr * 64 + fr, fq * 8), boff = lds_byte(wc * 32 + fr, fq * 8);
#define PG8_SA(b, h) (((b) * 2 + (h)) * HTB)
#define PG8_SB(b, h) ((4 + (b) * 2 + (h)) * HTB)
#define PG8_STAGE(bufoff, gbase, voff) do { _Pragma("unroll") for (int _i = 0; _i < 2; ++_i) \
        __builtin_amdgcn_global_load_lds((const unsigned*)((const char*)(gbase) + (voff)[_i]), (PG8_LAS unsigned*)(lds + (bufoff) + ldsw + _i * 8192), 16, 0, 0); } while (0)
#define PG8_LDA(dst, b, h) do { _Pragma("unroll") for (int m = 0; m < 4; ++m) _Pragma("unroll") for (int k = 0; k < 2; ++k) dst[m][k] = *(const PG8_LAS bf16x8*)(lds + PG8_SA(b, h) + aoff + m * 2048 + k * 1024); } while (0)
#define PG8_LDB(dst, b, h) do { _Pragma("unroll") for (int n = 0; n < 2; ++n) _Pragma("unroll") for (int k = 0; k < 2; ++k) dst[n][k] = *(const PG8_LAS bf16x8*)(lds + PG8_SB(b, h) + boff + n * 2048 + k * 1024); } while (0)
#define PG8_MMA(ai, bj, At, Bt) do { __builtin_amdgcn_s_setprio(1); _Pragma("unroll") for (int m = 0; m < 4; ++m) _Pragma("unroll") for (int n = 0; n < 2; ++n) _Pragma("unroll") for (int k = 0; k < 2; ++k) \
        acc[ai][bj][m][n] = __builtin_amdgcn_mfma_f32_16x16x32_bf16(Bt[n][k], At[m][k], acc[ai][bj][m][n], 0, 0, 0); __builtin_amdgcn_s_setprio(0); } while (0)
#define PG8_WAIT_V(n) asm volatile("s_waitcnt vmcnt(" #n ")" ::: "memory")
#define PG8_WAIT_L(n) asm volatile("s_waitcnt lgkmcnt(" #n ")" ::: "memory")
#define PG8_BAR __builtin_amdgcn_s_barrier()
#define PG8_SCHED __builtin_amdgcn_sched_barrier(0)
    Unit cur, nxt; int ui = 0;
    if (!S.next(0, cur)) return;
    f32x4 acc[2][2][4][2];
#pragma unroll
    for (int a = 0; a < 2; ++a)
#pragma unroll
        for (int b = 0; b < 2; ++b)
#pragma unroll
            for (int m = 0; m < 4; ++m)
#pragma unroll
                for (int n = 0; n < 2; ++n) acc[a][b][m][n] = (f32x4){0.f, 0.f, 0.f, 0.f};
    bf16x8 At[4][2], B0[2][2], B1[2][2];
    const char* cA = (const char*)g.A + (size_t)cur.pm * tstepA; const char* cB = (const char*)g.Bt + (size_t)cur.pn * tstepB;
    PG8_STAGE(PG8_SB(0, 0), cB, voffB); PG8_STAGE(PG8_SB(0, 1), cB + hstepB, voffB); PG8_STAGE(PG8_SA(0, 0), cA, voffA); PG8_STAGE(PG8_SA(0, 1), cA + hstepA, voffA);
    if (wr == 1) PG8_BAR;
    PG8_WAIT_V(2); PG8_BAR;
    PG8_STAGE(PG8_SB(1, 0), cB + kstep, voffB); PG8_STAGE(PG8_SA(1, 0), cA + kstep, voffA); PG8_STAGE(PG8_SB(1, 1), cB + hstepB + kstep, voffB);
    PG8_WAIT_V(6); PG8_BAR;
    for (;;) {
        const bool has_next = S.next(ui + 1, nxt);
        const char* nA = has_next ? (const char*)g.A + (size_t)nxt.pm * tstepA : cA; const char* nB = has_next ? (const char*)g.Bt + (size_t)nxt.pn * tstepB : cB;
#pragma nounroll
        for (int t = 0; t < nt; t += 2) {
            const bool last = (t == nt - 2);
            const char* a1 = cA + (size_t)(t + 1) * kstep;
            const char* a2 = last ? nA : cA + (size_t)(t + 2) * kstep; const char* b2 = last ? nB : cB + (size_t)(t + 2) * kstep;
            const char* a3 = a2 + kstep; const char* b3 = b2 + kstep;
            PG8_LDB(B0, 0, 0); PG8_LDB(B1, 0, 1); PG8_SCHED; PG8_LDA(At, 0, 0); PG8_STAGE(PG8_SA(1, 1), a1 + hstepA, voffA);
            PG8_WAIT_V(8); PG8_WAIT_L(0); PG8_BAR; PG8_MMA(0, 0, At, B0); PG8_MMA(0, 1, At, B1); PG8_BAR; PG8_SCHED;
            PG8_LDA(At, 0, 1); PG8_STAGE(PG8_SB(0, 0), b2, voffB); PG8_STAGE(PG8_SB(0, 1), b2 + hstepB, voffB); PG8_STAGE(PG8_SA(0, 0), a2, voffA);
            PG8_WAIT_V(8); PG8_WAIT_L(0); PG8_BAR; PG8_MMA(1, 0, At, B0); PG8_MMA(1, 1, At, B1); PG8_BAR; PG8_SCHED;
            PG8_LDB(B0, 1, 0); PG8_LDB(B1, 1, 1); PG8_SCHED; PG8_LDA(At, 1, 0); PG8_STAGE(PG8_SA(0, 1), a2 + hstepA, voffA);
            PG8_WAIT_V(8); PG8_WAIT_L(0); PG8_BAR; PG8_MMA(0, 0, At, B0); PG8_MMA(0, 1, At, B1); PG8_BAR; PG8_SCHED;
            PG8_LDA(At, 1, 1); PG8_STAGE(PG8_SB(1, 0), b3, voffB); PG8_STAGE(PG8_SB(1, 1), b3 + hstepB, voffB); PG8_STAGE(PG8_SA(1, 0), a3, voffA);
            PG8_WAIT_V(8); PG8_WAIT_L(0); PG8_BAR; PG8_MMA(1, 0, At, B0); PG8_MMA(1, 1, At, B1); PG8_BAR; PG8_SCHED;
        }
        if constexpr (ALIGN_EPI) { if (wr == 0) PG8_BAR; }
        E(acc, cur, wr, wc, fr, fq);
        if (!has_next) break;
#pragma unroll
        for (int a = 0; a < 2; ++a)
#pragma unroll
            for (int b = 0; b < 2; ++b)
#pragma unroll
                for (int m = 0; m < 4; ++m)
#pragma unroll
                    for (int n = 0; n < 2; ++n) acc[a][b][m][n] = (f32x4){0.f, 0.f, 0.f, 0.f};
        cur = nxt; cA = nA; cB = nB; ++ui;
        if constexpr (ALIGN_EPI) { if (wr == 1) PG8_BAR; }
    }
    PG8_WAIT_V(0);
    if constexpr (!ALIGN_EPI) { if (wr == 0) PG8_BAR; }
    PG8_BAR;
#undef PG8_SA
#undef PG8_SB
#undef PG8_STAGE
#undef PG8_LDA
#undef PG8_LDB
#undef PG8_MMA
#undef PG8_WAIT_V
#undef PG8_WAIT_L
#undef PG8_BAR
#undef PG8_SCHED
}
}
namespace att {
typedef unsigned short bf16_t;
typedef short bf16x8 __attribute__((ext_vector_type(8)));
typedef short s16x4 __attribute__((ext_vector_type(4)));
typedef float f32x16 __attribute__((ext_vector_type(16)));
typedef float f32x4 __attribute__((ext_vector_type(4)));
typedef unsigned u32x4 __attribute__((ext_vector_type(4)));
#define ATT_LAS __attribute__((address_space(3)))
constexpr int KVBLK = 64, QBLK = 32, QB = 256;
constexpr int L_K = 0, L_V = 16384, L_PE = 32768, BUFB = 40960, L_WS = 2 * BUFB, L_FLAG = L_WS + 2048, LDS_BYTES = L_FLAG + 64;
enum { MODE_MLA = 0, MODE_CROSS = 1, MODE_SB = 2 };

#define ATT_KSWZ(row, colB) ((row) * 256 + ((colB) ^ (((row) & 7) << 4)))
#define ATT_PESWZ(row, ch) ((row) * 128 + ((((ch) ^ (((row) >> 1) & 7))) << 4))
#define ATT_SBAR() __builtin_amdgcn_sched_barrier(0)
__device__ __forceinline__ int v_st(int k, int c) { const int kk = (k & ~0xC) | ((k & 4) << 1) | ((k & 8) >> 1); return ((kk >> 3) * 4 + (c >> 5)) * 512 + ((kk & 7) * 32 + (c & 31)) * 2; }
__device__ __forceinline__ int v_rd_base(int lane) { return ((lane & 3) << 3) | (((lane >> 2) & 3) << 6) | (((lane >> 4) & 1) << 5) | (((lane >> 5) & 1) << 8); }
__device__ __forceinline__ int crow(int r, int hi) { return (r & 3) + 8 * (r >> 2) + 4 * hi; }
__device__ __forceinline__ unsigned cvtpk(float lo, float hi) { unsigned r; asm volatile("v_cvt_pk_bf16_f32 %0, %1, %2" : "=v"(r) : "v"(lo), "v"(hi)); return r; }
__device__ __forceinline__ float swap_add(float v) { auto rr = __builtin_amdgcn_permlane32_swap(__float_as_uint(v), __float_as_uint(v), false, false); return __uint_as_float(rr[0]) + __uint_as_float(rr[1]); }
__device__ __forceinline__ float swap_max(float v) { auto rr = __builtin_amdgcn_permlane32_swap(__float_as_uint(v), __float_as_uint(v), false, false); return fmaxf(__uint_as_float(rr[0]), __uint_as_float(rr[1])); }
__device__ __forceinline__ float swap_other(float v, int hi) { auto rr = __builtin_amdgcn_permlane32_swap(__float_as_uint(v), __float_as_uint(v), false, false);
    const float a = __uint_as_float(rr[0]), b = __uint_as_float(rr[1]); return hi ? a : b; }

__device__ __forceinline__ void pack_p(const f32x16& p0, const f32x16& p1, bf16x8& pa0, bf16x8& pa1, bf16x8& pa2, bf16x8& pa3) {
#define ATT_PK4(P, B_, OUT) do { unsigned a0 = cvtpk(P[B_+0], P[B_+1]), a1 = cvtpk(P[B_+2], P[B_+3]);                          \
        unsigned b0 = cvtpk(P[B_+4], P[B_+5]), b1 = cvtpk(P[B_+6], P[B_+7]);                                             \
        auto r0 = __builtin_amdgcn_permlane32_swap(a0, b0, false, false); auto r1 = __builtin_amdgcn_permlane32_swap(a1, b1, false, false); \
        u32x4 w = {r0[0], r1[0], r0[1], r1[1]}; OUT = *reinterpret_cast<bf16x8*>(&w); } while (0)
    ATT_PK4(p0, 0, pa0); ATT_PK4(p0, 8, pa1); ATT_PK4(p1, 0, pa2); ATT_PK4(p1, 8, pa3);
#undef ATT_PK4
}
__device__ __forceinline__ void pv_tile(f32x16* o, int vb0, bf16x8 pa0, bf16x8 pa1, bf16x8 pa2, bf16x8 pa3) {
#define ATT_TRRD(dst, off) asm volatile("ds_read_b64_tr_b16 %0, %1 offset:%2" : "=&v"(dst) : "v"(vb0), "i"(off) : "memory")
#define ATT_PV_D0(d0) do { s16x4 l0, l1, l2, l3, h0, h1, h2, h3; constexpr int b_ = (d0) * 512;   \
        ATT_TRRD(l0, b_); ATT_TRRD(h0, b_ + 2048); ATT_TRRD(l1, b_ + 4096); ATT_TRRD(h1, b_ + 6144); ATT_TRRD(l2, b_ + 8192); ATT_TRRD(h2, b_ + 10240); ATT_TRRD(l3, b_ + 12288); ATT_TRRD(h3, b_ + 14336); \
        asm volatile("s_waitcnt lgkmcnt(0)" ::: "memory"); ATT_SBAR();   \
        o[d0] = __builtin_amdgcn_mfma_f32_32x32x16_bf16(pa0, (bf16x8){l0[0], l0[1], l0[2], l0[3], h0[0], h0[1], h0[2], h0[3]}, o[d0], 0, 0, 0);   \
        o[d0] = __builtin_amdgcn_mfma_f32_32x32x16_bf16(pa1, (bf16x8){l1[0], l1[1], l1[2], l1[3], h1[0], h1[1], h1[2], h1[3]}, o[d0], 0, 0, 0);   \
        o[d0] = __builtin_amdgcn_mfma_f32_32x32x16_bf16(pa2, (bf16x8){l2[0], l2[1], l2[2], l2[3], h2[0], h2[1], h2[2], h2[3]}, o[d0], 0, 0, 0);   \
        o[d0] = __builtin_amdgcn_mfma_f32_32x32x16_bf16(pa3, (bf16x8){l3[0], l3[1], l3[2], l3[3], h3[0], h3[1], h3[2], h3[3]}, o[d0], 0, 0, 0); } while (0)
    ATT_PV_D0(0); ATT_PV_D0(1); ATT_PV_D0(2); ATT_PV_D0(3);
#undef ATT_PV_D0
#undef ATT_TRRD
}

template <int MODE>
__device__ __forceinline__ void attn_unit(ATT_LAS unsigned char* lds, const bf16_t* Qb, const bf16_t* Kn, const bf16_t* Kpe, const bf16_t* Vp, bf16_t* Ob, int ostride, int q0, int nkeys) {
    constexpr int DKQ = (MODE == MODE_MLA) ? 192 : 128, NQF = DKQ / 16;
    int tid = threadIdx.x; asm volatile("" : "+v"(tid));
    const int wid = __builtin_amdgcn_readfirstlane(tid >> 6), lane = tid & 63, r32 = lane & 31, hi = lane >> 5;
    ATT_LAS float* ws = (ATT_LAS float*)(lds + L_WS) + wid * 64; ATT_LAS float* li_l = ws; ATT_LAS float* al_l = ws + 32;
    volatile ATT_LAS int* flags = (volatile ATT_LAS int*)(lds + L_FLAG);
    const int vb0 = (int)(unsigned)(uintptr_t)(lds + L_V) + v_rd_base(lane);
    bf16x8 qr[NQF];
#pragma unroll
    for (int d0 = 0; d0 < NQF; ++d0) qr[d0] = *(const bf16x8*)(Qb + (size_t)(wid * QBLK + r32) * DKQ + d0 * 16 + hi * 8);
    const int qlo = q0 + wid * QBLK;
    const int qpos = qlo + r32;
    float m_reg = -1e30f, l_reg = 0.f, Rrun = 0.f;
    f32x16 o[4]; o[0] = f32x16{}; o[1] = f32x16{}; o[2] = f32x16{}; o[3] = f32x16{};
    const int sr = tid >> 4, sc = (tid & 15) * 8;
    const int kws = ATT_KSWZ(sr, sc * 2), vst0 = v_st(sr, sc), vst1 = v_st(32 + sr, sc);
    const int per = tid >> 3, pech = tid & 7, pews = ATT_PESWZ(per, pech);
    int NT;
    if (MODE == MODE_CROSS) NT = nkeys / KVBLK; else NT = (q0 + QB) / KVBLK;
    u32x4 k0v, k1v, v0v, v1v, pev;
#define ATT_LOAD(kb_) do { k0v = *(const u32x4*)(Kn + (size_t)((kb_) + sr) * 128 + sc); k1v = *(const u32x4*)(Kn + (size_t)((kb_) + 32 + sr) * 128 + sc); \
        v0v = *(const u32x4*)(Vp + (size_t)((kb_) + sr) * 128 + sc); v1v = *(const u32x4*)(Vp + (size_t)((kb_) + 32 + sr) * 128 + sc); \
        if (MODE == MODE_MLA) pev = *(const u32x4*)(Kpe + (size_t)((kb_) + per) * 64 + pech * 8); } while (0)
#define ATT_WRITE(bo_) do { *(ATT_LAS u32x4*)(lds + (bo_) + L_K + kws) = k0v; *(ATT_LAS u32x4*)(lds + (bo_) + L_K + kws + 32 * 256) = k1v; \
        *(ATT_LAS u32x4*)(lds + (bo_) + L_V + vst0) = v0v; *(ATT_LAS u32x4*)(lds + (bo_) + L_V + vst1) = v1v; \
        if (MODE == MODE_MLA) *(ATT_LAS u32x4*)(lds + (bo_) + L_PE + pews) = pev; } while (0)
#define ATT_TILE(it_) ((MODE == MODE_SB) ? (NT - 1 - (it_)) : (it_))
    ATT_LOAD(ATT_TILE(0) * KVBLK);
    ATT_WRITE(0);
    __syncthreads();
    for (int it = 0; it < NT; ++it) {
        const int kb = ATT_TILE(it) * KVBLK;
        const int bo = (it & 1) * BUFB;
        ATT_LAS unsigned char* ldsb = lds + bo;
        const bool more = (it + 1 < NT);
        if (more) ATT_LOAD(ATT_TILE(it + 1) * KVBLK);
        bool act = true;
        if (MODE == MODE_MLA) act = (kb <= qlo + QBLK - 1);
        if (MODE == MODE_SB) act = (kb < qlo + QBLK - 1);
        if (act && MODE != MODE_SB) {
            f32x16 p0 = f32x16{}, p1 = f32x16{};
#pragma unroll
            for (int d0 = 0; d0 < 8; ++d0) {
                const int off = ATT_KSWZ(r32, ((d0 & 3) * 16 + hi * 8) * 2) + (d0 >> 2) * 128;
                const bf16x8 b0 = *(const ATT_LAS bf16x8*)(ldsb + L_K + off);
                const bf16x8 b1 = *(const ATT_LAS bf16x8*)(ldsb + L_K + off + 32 * 256);
                p0 = __builtin_amdgcn_mfma_f32_32x32x16_bf16(b0, qr[d0], p0, 0, 0, 0);
                p1 = __builtin_amdgcn_mfma_f32_32x32x16_bf16(b1, qr[d0], p1, 0, 0, 0);
            }
            if (MODE == MODE_MLA) {
#pragma unroll
                for (int d0 = 8; d0 < NQF; ++d0) {
                    const int off = ATT_PESWZ(r32, (d0 - 8) * 2 + hi);
                    const bf16x8 b0 = *(const ATT_LAS bf16x8*)(ldsb + L_PE + off);
                    const bf16x8 b1 = *(const ATT_LAS bf16x8*)(ldsb + L_PE + off + 32 * 128);
                    p0 = __builtin_amdgcn_mfma_f32_32x32x16_bf16(b0, qr[d0], p0, 0, 0, 0);
                    p1 = __builtin_amdgcn_mfma_f32_32x32x16_bf16(b1, qr[d0], p1, 0, 0, 0);
                }
            }
            bf16x8 pa0, pa1, pa2, pa3;
            if (MODE == MODE_MLA && kb + KVBLK - 1 > qlo) {
                const float NEG = -__builtin_inff();
#pragma unroll
                for (int r = 0; r < 16; ++r) { const int key = kb + crow(r, hi); if (key > qpos) p0[r] = NEG; if (key + 32 > qpos) p1[r] = NEG; }
            }
            float pmax = p0[0];
#pragma unroll
            for (int r = 1; r < 16; ++r) pmax = fmaxf(pmax, p0[r]);
#pragma unroll
            for (int r = 0; r < 16; ++r) pmax = fmaxf(pmax, p1[r]);
            pmax = swap_max(pmax);
            const float mn = fmaxf(m_reg, pmax), alpha = __builtin_amdgcn_exp2f(m_reg - mn); m_reg = mn;
            float ps = 0.f;
#pragma unroll
            for (int r = 0; r < 16; ++r) { p0[r] = __builtin_amdgcn_exp2f(p0[r] - mn); ps += p0[r]; }
#pragma unroll
            for (int r = 0; r < 16; ++r) { p1[r] = __builtin_amdgcn_exp2f(p1[r] - mn); ps += p1[r]; }
            ps = swap_add(ps);
            l_reg = l_reg * alpha + ps;
            if (__any(alpha < 1.f)) {
                if (hi == 0) al_l[r32] = alpha;
                asm volatile("s_waitcnt lgkmcnt(0)" ::: "memory");
#pragma unroll
                for (int r = 0; r < 16; ++r) { const float a = al_l[crow(r, hi)];
#pragma unroll
                    for (int d_ = 0; d_ < 4; ++d_) o[d_][r] *= a; }
            }
            pack_p(p0, p1, pa0, pa1, pa2, pa3);
            ATT_SBAR();
            pv_tile(o, vb0 + bo, pa0, pa1, pa2, pa3);
        }
        if (act && MODE == MODE_SB) {
            const bool needmask = (kb + KVBLK - 1 >= qlo);
            bf16x8 pa[4];
#pragma unroll
            for (int half = 1; half >= 0; --half) {
                f32x16 p = f32x16{};
#pragma unroll
                for (int d0 = 0; d0 < 8; ++d0) {
                    const int off = ATT_KSWZ(r32, ((d0 & 3) * 16 + hi * 8) * 2) + (d0 >> 2) * 128 + half * 32 * 256;
                    const bf16x8 b0 = *(const ATT_LAS bf16x8*)(ldsb + L_K + off);
                    p = __builtin_amdgcn_mfma_f32_32x32x16_bf16(b0, qr[d0], p, 0, 0, 0);
                }
                f32x16 L;
#pragma unroll
                for (int r = 0; r < 16; ++r) { const float z = p[r], az = fabsf(z); const float sp = fmaxf(z, 0.f) + __builtin_amdgcn_logf(1.f + __builtin_amdgcn_exp2f(-az)); L[r] = -sp; p[r] = z - sp; }
                if (needmask) {
#pragma unroll
                    for (int r = 0; r < 16; ++r) { const int key = kb + half * 32 + crow(r, hi); if (key >= qpos) L[r] = 0.f; }
                }
                float g[4], h[4];
#pragma unroll
                for (int i = 0; i < 4; ++i) g[i] = (L[4 * i] + L[4 * i + 1]) + (L[4 * i + 2] + L[4 * i + 3]);
#pragma unroll
                for (int i = 0; i < 4; ++i) h[i] = swap_other(g[i], hi);
                float os[4]; float run = Rrun;
#pragma unroll
                for (int i = 3; i >= 0; --i) { os[i] = run; run += g[i] + h[i]; }
#pragma unroll
                for (int i = 0; i < 4; ++i) {
                    float e = os[i] + (hi == 0 ? h[i] : 0.f);
#pragma unroll
                    for (int j = 3; j >= 0; --j) { const float lsg = p[4 * i + j]; p[4 * i + j] = __builtin_amdgcn_exp2f(lsg + e); e += L[4 * i + j]; }
                }
                if (needmask) {
#pragma unroll
                    for (int r = 0; r < 16; ++r) { const int key = kb + half * 32 + crow(r, hi); if (key >= qpos) p[r] = 0.f; }
                }
                Rrun = run;
#define ATT_PK4(P, B_, OUT) do { unsigned a0 = cvtpk(P[B_+0], P[B_+1]), a1 = cvtpk(P[B_+2], P[B_+3]);                          \
        unsigned b0 = cvtpk(P[B_+4], P[B_+5]), b1 = cvtpk(P[B_+6], P[B_+7]);                                             \
        auto r0 = __builtin_amdgcn_permlane32_swap(a0, b0, false, false); auto r1 = __builtin_amdgcn_permlane32_swap(a1, b1, false, false); \
        u32x4 w = {r0[0], r1[0], r0[1], r1[1]}; OUT = *reinterpret_cast<bf16x8*>(&w); } while (0)
                ATT_PK4(p, 0, pa[2 * half]); ATT_PK4(p, 8, pa[2 * half + 1]);
#undef ATT_PK4
            }
            ATT_SBAR();
            pv_tile(o, vb0 + bo, pa[0], pa[1], pa[2], pa[3]);
        }
        if (MODE == MODE_SB) { const int dn = (act && __all(Rrun < -152.0f)) ? 1 : 0; if (lane == 0) flags[(it & 1) * 8 + wid] = dn; }
        if (more) ATT_WRITE(bo ^ BUFB);
        __syncthreads();
        if (MODE == MODE_SB && more) { int alld = 1;
#pragma unroll
            for (int w = 0; w < 8; ++w) alld &= flags[(it & 1) * 8 + w];
            if (alld) break; }
    }
#undef ATT_LOAD
#undef ATT_WRITE
#undef ATT_TILE
    float rli[16];
    if (MODE != MODE_SB) {
        if (hi == 0) li_l[r32] = l_reg;
        asm volatile("s_waitcnt lgkmcnt(0)" ::: "memory");
#pragma unroll
        for (int r = 0; r < 16; ++r) rli[r] = 1.0f / li_l[crow(r, hi)];
    } else {
#pragma unroll
        for (int r = 0; r < 16; ++r) rli[r] = 1.0f;
    }
    bf16_t* Ow = Ob + (size_t)(wid * QBLK) * ostride;
#pragma unroll
    for (int r = 0; r < 16; ++r) { const int orow = crow(r, hi);
#pragma unroll
        for (int d0 = 0; d0 < 4; ++d0) { const float v = o[d0][r] * rli[r]; const float vn = __shfl_xor(v, 1);
            if ((r32 & 1) == 0) *(unsigned*)(Ow + (size_t)orow * ostride + d0 * 32 + r32) = cvtpk(v, vn); } }
    __syncthreads();
}
}
constexpr int NWAVES = 8;
constexpr int BATCH = 8, SEQ = 2048, DM = 1024, T = BATCH * SEQ;
constexpr int MEMLEN = 256, TM = BATCH * MEMLEN;
constexpr int QLORA = 384, KVLORA = 256, ROPE = 64, NLAT = 704, NLATP = 768;
constexpr int HEADS = 8, NOPE = 128, DQK = 192, DV = 128;
constexpr int XH = 4, DFF = 4096;
constexpr float EPS = 1e-6f;
constexpr float LOG2E = 1.4426950408889634f;
constexpr float QSCALE_MLA = 0.07216878364870322f * LOG2E;
constexpr float QSCALE_128 = 0.08838834764831845f * LOG2E;

constexpr size_t MiB = 1u << 20;
constexpr size_t WS_CTL = 0, CTL_ZERO_BYTES = 64 * 1024;
constexpr size_t WS_RS = 1 * MiB / 2;
constexpr size_t WS_WDKV = 1 * MiB;
constexpr size_t WS_WUQ = WS_WDKV + (size_t)NLATP * DM * 2;
constexpr size_t WS_WUKV = WS_WUQ + (size_t)1536 * 384 * 2;
constexpr size_t WS_WO0 = WS_WUKV + (size_t)2048 * 256 * 2;
constexpr size_t WS_WXQ = WS_WO0 + (size_t)DM * DM * 2;
constexpr size_t WS_WXKV = WS_WXQ + 2 * (size_t)512 * DM * 2;
constexpr size_t WS_WXO = WS_WXKV + 2 * (size_t)DM * DM * 2;
constexpr size_t WS_WIN = WS_WXO + 2 * (size_t)DM * 512 * 2;
constexpr size_t WS_WOUT = WS_WIN + 2 * (size_t)DFF * DM * 2;
constexpr size_t WS_WQKV = WS_WOUT + 2 * (size_t)DM * DFF * 2;
constexpr size_t WS_WO1 = WS_WQKV + (size_t)3072 * DM * 2;
constexpr size_t WS_WEND = WS_WO1 + (size_t)DM * DM * 2;
static_assert(WS_WEND <= 56 * MiB, "weights");
constexpr size_t WS_HB = 56 * MiB;
constexpr size_t WS_KVX = 88 * MiB;
constexpr size_t WS_CS = 96 * MiB;
constexpr size_t WS_KPE = 100 * MiB;
constexpr size_t WS_MEMB = 102 * MiB;
constexpr size_t WS_SSQ = 106 * MiB;
constexpr size_t WS_X = 107 * MiB;
constexpr size_t WS_LAT = WS_X;
constexpr size_t WS_OB = WS_X;
constexpr size_t WS_Q = WS_X + 32 * MiB;
constexpr size_t WS_KN = WS_X + 80 * MiB;
constexpr size_t WS_V = WS_X + 112 * MiB;
constexpr size_t WS_K1 = WS_X + 64 * MiB, WS_V1 = WS_X + 96 * MiB;
constexpr size_t WS_QX = WS_X, WS_OX = WS_X + 16 * MiB;
constexpr size_t WS_U = WS_X;
constexpr size_t WS_END = WS_X + 144 * MiB;
static_assert(WS_END <= 256 * MiB, "d_ws map");
constexpr int RS_X = 0, RS_Q = T, RS_KV = 2 * T, RS_H = 3 * T, RS_MEM = 4 * T;
constexpr int CW_BAR = 1024;

constexpr int RING_OFF = 0, RING_BYTES = 131072;
constexpr int LDSCTL_OFF = RING_BYTES, MISC_OFF = LDSCTL_OFF + 320;
constexpr int LDS_BYTES = 147456;

#define GAS __attribute__((address_space(1)))
#define LAS __attribute__((address_space(3)))
typedef unsigned short bf16;
typedef unsigned v4u __attribute__((ext_vector_type(4)));
typedef float f32x4 __attribute__((ext_vector_type(4)));
typedef GAS unsigned gu32;
#define RLX_AGENT __ATOMIC_RELAXED, __HIP_MEMORY_SCOPE_AGENT
#define LDS_WAIT() asm volatile("s_waitcnt lgkmcnt(0)" ::: "memory")
#define VM_WAIT() asm volatile("s_waitcnt vmcnt(0)" ::: "memory")
__device__ __forceinline__ unsigned f2bf(float f) { unsigned u = __builtin_bit_cast(unsigned, f); return (u + 0x7fffu + ((u >> 16) & 1u)) >> 16; }
__device__ __forceinline__ unsigned pk2(float lo, float hi) { return f2bf(lo) | (f2bf(hi) << 16); }
__device__ __forceinline__ float bf2f(unsigned short b) { return __builtin_bit_cast(float, (unsigned)b << 16); }
__device__ __forceinline__ void store8(bf16* p, f32x4 a, f32x4 b) { v4u w; w.x = pg8::cvt_pk_bf16(a[0], a[1]); w.y = pg8::cvt_pk_bf16(a[2], a[3]); w.z = pg8::cvt_pk_bf16(b[0], b[1]); w.w = pg8::cvt_pk_bf16(b[2], b[3]); *(v4u*)p = w; }

#define XB_TMO      128
#define XB_XCNT(j)  (256  + 64 * (j))
#define XB_XSUB(j)  (1280 + 64 * (j))
#define XB_XGEN(j)  (2304 + 64 * (j))
#define XB_TOP      3328
#define XB_TOPGEN   3392
#define XCD_BAR_WORDS 3456
#define XB_SPIN_CAP (1u << 18)
__device__ __forceinline__ unsigned xb_ld(unsigned* p)              { return __hip_atomic_load(p, __ATOMIC_RELAXED, __HIP_MEMORY_SCOPE_AGENT); }
__device__ __forceinline__ unsigned xb_add(unsigned* p, unsigned v) { return __hip_atomic_fetch_add(p, v, __ATOMIC_RELAXED, __HIP_MEMORY_SCOPE_AGENT); }
__device__ __forceinline__ unsigned xb_xcc_id() { return (unsigned)__builtin_amdgcn_s_getreg((3 << 11) | 20) & 0xFu; }
#define XB_SPIN(cond, bar) do { unsigned _sp = 0; while (cond) { __builtin_amdgcn_s_sleep(1); \
    if ((++_sp & 255u) == 0u) { if (xb_ld(&(bar)[XB_TMO])) break; if (_sp > XB_SPIN_CAP) { atomicAdd(&(bar)[XB_TMO], 1u); break; } } } } while (0)
struct XcdBarrier { unsigned* bar; unsigned x; volatile LAS unsigned* st; };
__device__ __forceinline__ XcdBarrier xcd_barrier_post(unsigned* bar, volatile LAS unsigned* st) {
    XcdBarrier b; b.bar = bar; b.x = xb_xcc_id(); b.st = st;
    if (threadIdx.x == 0) (void)xb_add(&bar[XB_XCNT(b.x)], 1u);
    return b;
}
__device__ __forceinline__ void xcd_barrier_complete(unsigned* bar, unsigned x, unsigned& nloc, unsigned& nx) {
    const unsigned G = gridDim.x * gridDim.y * gridDim.z;
    unsigned sum, cnt, mine, sp = 0u;
    for (;;) {
        sum = 0u; cnt = 0u; mine = 0u;
#pragma unroll
        for (unsigned j = 0; j < 16; ++j) { const unsigned c = xb_ld(&bar[XB_XCNT(j)]); sum += c; cnt += (c > 0u) ? 1u : 0u; mine = (j == x) ? c : mine; }
        if (sum == G) break;
        __builtin_amdgcn_s_sleep(1);
        if ((++sp & 255u) == 0u) { if (xb_ld(&bar[XB_TMO])) break; if (sp > XB_SPIN_CAP) { atomicAdd(&bar[XB_TMO], 1u); break; } }
    }
    nloc = mine > 0u ? mine : 1u; nx = cnt > 0u ? cnt : 1u;
}
__device__ __forceinline__ void xcd_barrier(const XcdBarrier& b) {
    asm volatile("s_waitcnt vmcnt(0)" ::: "memory");
    __syncthreads();
    if (threadIdx.x == 0) {
        unsigned* bar = b.bar;
        __builtin_amdgcn_s_waitcnt(0);
        unsigned nloc = b.st[0], nx = b.st[1];
        if (nloc == 0u) { xcd_barrier_complete(bar, b.x, nloc, nx); b.st[0] = nloc; b.st[1] = nx; }
        const unsigned old = xb_add(&bar[XB_XSUB(b.x)], 1u);
        const unsigned gen = old / nloc;
        if (old + 1u == (gen + 1u) * nloc) {
            __builtin_amdgcn_fence(__ATOMIC_RELEASE, "agent");
            asm volatile("s_waitcnt vmcnt(0)" ::: "memory");
            const unsigned og = xb_add(&bar[XB_TOP], 1u);
            const unsigned tg = og / nx;
            if (og + 1u == (tg + 1u) * nx) xb_add(&bar[XB_TOPGEN], 1u);
            else XB_SPIN(xb_ld(&bar[XB_TOPGEN]) == tg, bar);
            __builtin_amdgcn_fence(__ATOMIC_ACQUIRE, "agent");
            xb_add(&bar[XB_XGEN(b.x)], 1u);
            asm volatile("s_waitcnt vmcnt(0)" ::: "memory");
        } else {
            XB_SPIN(xb_ld(&bar[XB_XGEN(b.x)]) == gen, bar);
            __builtin_amdgcn_fence(__ATOMIC_ACQUIRE, "agent");
            asm volatile("s_waitcnt vmcnt(0)" ::: "memory");
        }
    }
    __syncthreads();
}

__device__ __forceinline__ float wave_sum(float v) {
#pragma unroll
    for (int o = 1; o < 64; o <<= 1) v += __shfl_xor(v, o);
    return v;
}
__device__ __forceinline__ void transpose_item(const float* W, int K, int N, bf16* WT, const float* gain, int permq, LAS float* scr, int item, int lane) {
    const int nblk = N / 32, kb = item / nblk, nb = item - kb * nblk, k0 = 64 * kb, n0 = 32 * nb;
    const int lr = lane >> 3, lc = (lane & 7) * 4;
    f32x4 v[8];
#pragma unroll
    for (int i = 0; i < 8; ++i) v[i] = *(const GAS f32x4*)(W + (size_t)(k0 + i * 8 + lr) * N + n0 + lc);
    if (gain) {
#pragma unroll
        for (int i = 0; i < 8; ++i) v[i] = v[i] * gain[k0 + i * 8 + lr];
    }
#pragma unroll
    for (int i = 0; i < 8; ++i) { LAS float* d = scr + (i * 8 + lr) * 33 + lc; d[0] = v[i][0]; d[1] = v[i][1]; d[2] = v[i][2]; d[3] = v[i][3]; }
    LDS_WAIT(); asm volatile("" ::: "memory");
    const int c = lane & 7;
#pragma unroll
    for (int j = 0; j < 4; ++j) { const int n = (lane >> 3) + 8 * j; const LAS float* sp = scr + (8 * c) * 33 + n;
        v4u o; o.x = pk2(sp[0 * 33], sp[1 * 33]); o.y = pk2(sp[2 * 33], sp[3 * 33]); o.z = pk2(sp[4 * 33], sp[5 * 33]); o.w = pk2(sp[6 * 33], sp[7 * 33]);
        int drow = n0 + n;
        if (permq) { const int h = drow / DQK, d = drow - h * DQK; if (d >= NOPE) { const int cc = d - NOPE; drow = h * DQK + NOPE + 2 * (cc & 31) + (cc >> 5); } }
        *(GAS v4u*)(WT + (size_t)drow * K + k0 + 8 * c) = o; }
    LDS_WAIT(); asm volatile("" ::: "memory");
}
__device__ __forceinline__ void rowstat_1024(const float* xrow, bf16* orow, float* rs, int lane) {
    const GAS f32x4* xr = (const GAS f32x4*)xrow + lane;
    f32x4 v[4]; float s = 0.f;
#pragma unroll
    for (int j = 0; j < 4; ++j) { v[j] = xr[64 * j]; s += (v[j].x * v[j].x + v[j].y * v[j].y) + (v[j].z * v[j].z + v[j].w * v[j].w); }
    const float r = 1.0f / sqrtf(wave_sum(s) * (1.0f / 1024.0f) + EPS);
    if (lane == 0) *rs = r;
    GAS unsigned long long* o8 = (GAS unsigned long long*)orow + lane;
#pragma unroll
    for (int j = 0; j < 4; ++j) o8[64 * j] = (unsigned long long)pk2(v[j].x, v[j].y) | ((unsigned long long)pk2(v[j].z, v[j].w) << 32);
}

__device__ __forceinline__ float rs_from_partials(const float* ssqp, int row) {
    const f32x4* p = (const f32x4*)(ssqp + (size_t)row * 16); const f32x4 a = p[0], b = p[1], c = p[2], d = p[3];
    const float s = (((a[0] + a[1]) + (a[2] + a[3])) + ((b[0] + b[1]) + (b[2] + b[3]))) + (((c[0] + c[1]) + (c[2] + c[3])) + ((d[0] + d[1]) + (d[2] + d[3])));
    return 1.0f / sqrtf(s * (1.0f / 1024.0f) + EPS); }
struct FLat { bf16* lat; const float* rs;
    __device__ __forceinline__ float rowscale(int row) const { return rs[row]; }
    __device__ __forceinline__ void operator()(int row, int col, f32x4 v0, f32x4 v1) const { store8(lat + (size_t)row * NLATP + col, v0, v1); } };
struct FMemKV { bf16* kx; bf16* vx; const float* rs;
    __device__ __forceinline__ float rowscale(int row) const { return rs[row]; }
    __device__ __forceinline__ void operator()(int row, int col, f32x4 v0, f32x4 v1) const {
        const int b = row >> 8, m = row & 255, t = col >> 9, c = col & 511, h = c >> 7, d = c & 127;
        bf16* p = (t ? vx : kx) + ((size_t)((b * XH + h) * MEMLEN + m)) * 128 + d; store8(p, v0, v1); } };
struct FQ0 { bf16* q; const float* rs; const float2* cs;
    __device__ __forceinline__ float rowscale(int row) const { return rs[row] * QSCALE_MLA; }
    __device__ __forceinline__ void operator()(int row, int col, f32x4 v0, f32x4 v1) const {
        const int h = col / DQK, d = col - h * DQK;
        if (d >= NOPE) { const float2* c = cs + (size_t)row * 32 + ((d - NOPE) >> 1);
            const float2 c0 = c[0], c1 = c[1], c2 = c[2], c3 = c[3];
            const f32x4 a = v0, b = v1;
            v0[0] = a[0] * c0.x - a[1] * c0.y; v0[1] = a[0] * c0.y + a[1] * c0.x; v0[2] = a[2] * c1.x - a[3] * c1.y; v0[3] = a[2] * c1.y + a[3] * c1.x;
            v1[0] = b[0] * c2.x - b[1] * c2.y; v1[1] = b[0] * c2.y + b[1] * c2.x; v1[2] = b[2] * c3.x - b[3] * c3.y; v1[3] = b[2] * c3.y + b[3] * c3.x; }
        const int bb = row >> 11, si = row & 2047;
        store8(q + ((size_t)((bb * HEADS + h) * SEQ + si)) * DQK + d, v0, v1); } };
struct FKV0 { bf16* kn; bf16* v; const float* rs;
    __device__ __forceinline__ float rowscale(int row) const { return rs[row]; }
    __device__ __forceinline__ void operator()(int row, int col, f32x4 v0, f32x4 v1) const {
        const int h = col >> 8, j = col & 255, bb = row >> 11, si = row & 2047;
        bf16* p = (j < 128 ? kn : v) + ((size_t)((bb * HEADS + h) * SEQ + si)) * 128 + (j & 127); store8(p, v0, v1); } };
struct FXQ { bf16* qx; const float* ssqp;
    __device__ __forceinline__ float rowscale(int row) const { return rs_from_partials(ssqp, row) * QSCALE_128; }
    __device__ __forceinline__ void operator()(int row, int col, f32x4 v0, f32x4 v1) const {
        const int h = col >> 7, d = col & 127, bb = row >> 11, si = row & 2047;
        store8(qx + ((size_t)((bb * XH + h) * SEQ + si)) * 128 + d, v0, v1); } };
struct FUp { bf16* u; const float* ssqp;
    __device__ __forceinline__ float rowscale(int row) const { return rs_from_partials(ssqp, row); }
    __device__ __forceinline__ void operator()(int row, int col, f32x4 v0, f32x4 v1) const {
#pragma unroll
        for (int j = 0; j < 4; ++j) { const float a = fmaxf(v0[j], 0.f), b = fmaxf(v1[j], 0.f); v0[j] = a * a; v1[j] = b * b; }
        store8(u + (size_t)row * DFF + col, v0, v1); } };
struct FQKV1 { bf16* q; bf16* k; bf16* v; const float* ssqp;
    __device__ __forceinline__ float rowscale(int row) const { return rs_from_partials(ssqp, row); }
    __device__ __forceinline__ void operator()(int row, int col, f32x4 v0, f32x4 v1) const { const int t = col >> 10, c = col & 1023, h = c >> 7, d = c & 127, bb = row >> 11, si = row & 2047;
        const float s = (t == 0 ? QSCALE_128 : 1.0f);
        bf16* p = q + (size_t)t * (32u << 19) + ((size_t)((bb * HEADS + h) * SEQ + si)) * 128 + d; store8(p, v0 * s, v1 * s); } };

struct Args { const float* in[21]; float* out; unsigned char* ws; int ph_lo, ph_hi; };
static_assert(sizeof(Args) == 21 * 8 + 8 + 8 + 8, "Args has no padding");

enum { PH_PRO = 0, PH_DKV, PH_LATSTAT, PH_UQKV, PH_ATT0, PH_WO0, PH_XQ0, PH_XA0, PH_XO0, PH_UP0, PH_DN0,
       PH_QKV1, PH_ATT1, PH_WO1, PH_XQ1, PH_XA1, PH_XO1, PH_UP1, PH_DN1, PH_FINAL, NPH };

__global__ void __launch_bounds__(NWAVES * 64, 2) mk_fwd(Args args) {
    extern __shared__ __attribute__((aligned(16))) unsigned char lds_raw[];
    LAS unsigned char* lds = (LAS unsigned char*)lds_raw;
    volatile LAS unsigned* MISC = (volatile LAS unsigned*)(lds + MISC_OFF);
    const int tid = threadIdx.x, lane = tid & 63, wave = __builtin_amdgcn_readfirstlane(tid >> 6);
    const int G = gridDim.x; int vcu; { const int bx = blockIdx.x; vcu = (G % 8 == 0) ? (bx % 8) * (G / 8) + bx / 8 : bx; }
    unsigned char* ws = args.ws;
    gu32* ctl = (gu32*)(ws + WS_CTL);
    for (int u = tid; u < (LDS_BYTES - LDSCTL_OFF) / 4; u += NWAVES * 64) ((LAS unsigned*)(lds + LDSCTL_OFF))[u] = 0u;
    __syncthreads();
    const int lo = args.ph_lo, hi = args.ph_hi;
    const bool one_phase = (hi - lo == 1);
    XcdBarrier bar; bar.bar = (unsigned*)(ctl + CW_BAR); bar.x = 0; bar.st = nullptr;
    if (!one_phase) bar = xcd_barrier_post((unsigned*)(ctl + CW_BAR), MISC + 8);
#define IN(k) (lo <= (k) && (k) < hi)
#ifndef PROBE_MASK
#define PROBE_MASK 0u
#endif
#ifndef PROBE_DBLBAR
#define PROBE_DBLBAR 0
#endif
    unsigned long long t_prev = PROBE_MASK ? __builtin_amdgcn_s_memrealtime() : 0ull, t_acc = 0ull;
#define SEAM(k) do { if (IN(k) && IN((k) + 1)) { xcd_barrier(bar); if (PROBE_DBLBAR) xcd_barrier(bar); } \
    if (PROBE_MASK) { const unsigned long long t_now = __builtin_amdgcn_s_memrealtime(); if ((PROBE_MASK >> (k)) & 1u) t_acc += t_now - t_prev; t_prev = t_now; } } while (0)

    const float* x = args.in[0]; const float* mem = args.in[1]; const int* positions = (const int*)args.in[2];
    const float* norm_mix = args.in[3]; const float* norm_cross = args.in[4]; const float* norm_mem = args.in[5]; const float* norm_mlp = args.in[6]; const float* norm_final = args.in[7];
#define WSL() ({ unsigned char* _p = ws; asm volatile("" : "+s"(_p)); _p; })
#define rsb ((float*)(WSL() + WS_RS))
#define HB ((bf16*)(WSL() + WS_HB))
#define MEMB ((bf16*)(WSL() + WS_MEMB))
#define LAT ((bf16*)(WSL() + WS_LAT))
#define CS ((float2*)(WSL() + WS_CS))
#define KPE ((bf16*)(WSL() + WS_KPE))
#define OB ((bf16*)(WSL() + WS_OB))
#define QB_ ((bf16*)(WSL() + WS_Q))
#define KN ((bf16*)(WSL() + WS_KN))
#define VV ((bf16*)(WSL() + WS_V))
#define K1 ((bf16*)(WSL() + WS_K1))
#define V1 ((bf16*)(WSL() + WS_V1))
#define QX ((bf16*)(WSL() + WS_QX))
#define OX ((bf16*)(WSL() + WS_OX))
#define U ((bf16*)(WSL() + WS_U))
#define SSQP ((float*)(WSL() + WS_SSQ))
    float* hres = args.out;
    const int gw = vcu * NWAVES + wave, NGW = G * NWAVES;

    if (IN(PH_PRO)) {
        LAS float* scr = (LAS float*)(lds + RING_OFF + wave * 16384);
        struct Job { const float* W; int K, N; size_t dst; const float* gain; int permq; };
        constexpr int C0 = 352, C1 = C0 + 288, C2 = C1 + 256, C3 = C2 + 512, C4 = C3 + 256, C5 = C4 + 256, C6 = C5 + 512, C7 = C6 + 512, C8 = C7 + 256, C9 = C8 + 256,
                      C10 = C9 + 2048, C11 = C10 + 2048, C12 = C11 + 2048, C13 = C12 + 2048, C14 = C13 + 1536, C15 = C14 + 512;
        for (int fit = gw; fit < C15; fit += NGW) {
            Job jb; int it;
            if (fit < C0) { it = fit; jb = {args.in[8], DM, NLAT, WS_WDKV, norm_mix, 0}; }
            else if (fit < C1) { it = fit - C0; jb = {args.in[11], QLORA, 1536, WS_WUQ, args.in[9], 1}; }
            else if (fit < C2) { it = fit - C1; jb = {args.in[12], KVLORA, 2048, WS_WUKV, args.in[10], 0}; }
            else if (fit < C3) { it = fit - C2; jb = {args.in[13], DM, DM, WS_WO0, nullptr, 0}; }
            else if (fit < C4) { it = fit - C3; jb = {args.in[16], DM, 512, WS_WXQ, norm_cross, 0}; }
            else if (fit < C5) { it = fit - C4; jb = {args.in[16] + (size_t)DM * 512, DM, 512, WS_WXQ + (size_t)512 * DM * 2, norm_cross + DM, 0}; }
            else if (fit < C6) { it = fit - C5; jb = {args.in[17], DM, DM, WS_WXKV, norm_mem, 0}; }
            else if (fit < C7) { it = fit - C6; jb = {args.in[17] + (size_t)DM * DM, DM, DM, WS_WXKV + (size_t)DM * DM * 2, norm_mem + DM, 0}; }
            else if (fit < C8) { it = fit - C7; jb = {args.in[18], 512, DM, WS_WXO, nullptr, 0}; }
            else if (fit < C9) { it = fit - C8; jb = {args.in[18] + (size_t)512 * DM, 512, DM, WS_WXO + (size_t)DM * 512 * 2, nullptr, 0}; }
            else if (fit < C10) { it = fit - C9; jb = {args.in[19], DM, DFF, WS_WIN, norm_mlp, 0}; }
            else if (fit < C11) { it = fit - C10; jb = {args.in[19] + (size_t)DM * DFF, DM, DFF, WS_WIN + (size_t)DFF * DM * 2, norm_mlp + DM, 0}; }
            else if (fit < C12) { it = fit - C11; jb = {args.in[20], DFF, DM, WS_WOUT, nullptr, 0}; }
            else if (fit < C13) { it = fit - C12; jb = {args.in[20] + (size_t)DFF * DM, DFF, DM, WS_WOUT + (size_t)DM * DFF * 2, nullptr, 0}; }
            else if (fit < C14) { it = fit - C13; jb = {args.in[14], DM, 3072, WS_WQKV, norm_mix + DM, 0}; }
            else { it = fit - C14; jb = {args.in[15], DM, DM, WS_WO1, nullptr, 0}; }
            transpose_item(jb.W, jb.K, jb.N, (bf16*)(WSL() + jb.dst), jb.gain, jb.permq, scr, it, lane);
        }
        { GAS v4u* z = (GAS v4u*)(WSL() + WS_WDKV + (size_t)NLAT * DM * 2); const int n16 = (NLATP - NLAT) * DM * 2 / 16;
            for (int i = blockIdx.x * (NWAVES * 64) + tid; i < n16; i += G * NWAVES * 64) z[i] = (v4u){0u, 0u, 0u, 0u}; }
        for (int i = blockIdx.x * (NWAVES * 64) + tid; i < T * 32; i += G * NWAVES * 64) {
            const int tok = i >> 5, f = i & 31;
            const float inv = powf(10000.0f, -(float)(2 * f) / 64.0f);
            const float ang = (float)positions[tok] * inv;
            CS[i] = make_float2(cosf(ang), sinf(ang));
        }
        for (int m = gw; m < T; m += NGW) rowstat_1024(x + (size_t)m * DM, HB + (size_t)m * DM, rsb + RS_X + m, lane);
        for (int m = gw; m < TM; m += NGW) rowstat_1024(mem + (size_t)m * DM, MEMB + (size_t)m * DM, rsb + RS_MEM + m, lane);
    }
    SEAM(PH_PRO);

    if (IN(PH_DKV)) {
        { pg8::Gemm g{HB, (const bf16*)(WSL() + WS_WDKV), T, NLATP, DM, DM}; pg8::StaticOrder S; S.init(T, NLATP, G, (int)blockIdx.x);
          pg8::EpiB<FLat> E{{LAT, rsb + RS_X}}; pg8::gemm_phase<pg8::EpiB<FLat>, pg8::StaticOrder, true>(lds + RING_OFF, g, S, E); }
        for (int l = 0; l < 2; ++l) {
          pg8::Gemm g{MEMB, (const bf16*)(WSL() + WS_WXKV + (size_t)l * DM * DM * 2), TM, DM, DM, DM}; pg8::StaticOrder S; S.init(TM, DM, G, (int)((blockIdx.x + 64 - 32 * l) % G));
          bf16* kx = (bf16*)(WSL() + WS_KVX + (size_t)l * 4 * MiB);
          pg8::EpiB<FMemKV> E{{kx, kx + (size_t)TM * 512, rsb + RS_MEM}}; pg8::gemm_phase<pg8::EpiB<FMemKV>, pg8::StaticOrder, true>(lds + RING_OFF, g, S, E); }
    }
    SEAM(PH_DKV);

    if (IN(PH_LATSTAT)) {
        for (int m = gw; m < T; m += NGW) {
            const bf16* lr = LAT + (size_t)m * NLATP; float sq = 0.f, skv = 0.f;
#pragma unroll
            for (int j = 0; j < 3; ++j) { const int c = j * 64 + lane; const unsigned long long w = *(const GAS unsigned long long*)(lr + 4 * c);
                const float a0 = bf2f((unsigned short)w), a1 = bf2f((unsigned short)(w >> 16)), a2 = bf2f((unsigned short)(w >> 32)), a3 = bf2f((unsigned short)(w >> 48));
                const float s = (a0 * a0 + a1 * a1) + (a2 * a2 + a3 * a3);
                if (c < 96) sq += s; else if (c < 160) skv += s; }
            sq = wave_sum(sq); skv = wave_sum(skv);
            if (lane == 0) { rsb[RS_Q + m] = 1.0f / sqrtf(sq * (1.0f / QLORA) + EPS); rsb[RS_KV + m] = 1.0f / sqrtf(skv * (1.0f / KVLORA) + EPS); }
            if (lane < 32) { const float x1 = bf2f(lr[640 + lane]), x2 = bf2f(lr[672 + lane]); const float2 c = CS[(size_t)m * 32 + lane];
                *(GAS unsigned*)(KPE + (size_t)m * 64 + 2 * lane) = pk2(x1 * c.x - x2 * c.y, x1 * c.y + x2 * c.x); }
        }
    }
    SEAM(PH_LATSTAT);

    if (IN(PH_UQKV)) {
        { pg8::Gemm g{LAT, (const bf16*)(WSL() + WS_WUQ), T, 1536, QLORA, NLATP}; pg8::StaticOrder S; S.init(T, 1536, G, (int)blockIdx.x);
          pg8::EpiB<FQ0> E{{QB_, rsb + RS_Q, CS}}; pg8::gemm_phase<pg8::EpiB<FQ0>, pg8::StaticOrder, true>(lds + RING_OFF, g, S, E); }
        { pg8::Gemm g{LAT + QLORA, (const bf16*)(WSL() + WS_WUKV), T, 2048, KVLORA, NLATP}; pg8::StaticOrder S; S.init(T, 2048, G, (int)((blockIdx.x + 128) % G));
          pg8::EpiB<FKV0> E{{KN, VV, rsb + RS_KV}}; pg8::gemm_phase<pg8::EpiB<FKV0>, pg8::StaticOrder, true>(lds + RING_OFF, g, S, E); }
    }
    SEAM(PH_UQKV);

    if (IN(PH_ATT0)) {
        for (int pu = vcu; pu < 256; pu += G) { const int bh = pu >> 2, s = pu & 3, b = bh >> 3, h = bh & 7;
            for (int pass = 0; pass < 2; ++pass) { const int qb = pass ? s : 7 - s;
                att::attn_unit<att::MODE_MLA>(lds + RING_OFF, QB_ + ((size_t)bh * SEQ + qb * 256) * DQK, KN + (size_t)bh * SEQ * 128, KPE + (size_t)b * SEQ * 64, VV + (size_t)bh * SEQ * 128,
                    OB + ((size_t)b * SEQ + qb * 256) * DM + h * 128, DM, qb * 256, 0); } }
    }
    SEAM(PH_ATT0);

    for (int layer = 0; layer < 2; ++layer) {
        const int PB = layer ? PH_WO1 : PH_WO0;
        if (layer == 1) {
            if (IN(PH_QKV1)) { pg8::Gemm g{HB, (const bf16*)(WSL() + WS_WQKV), T, 3072, DM, DM}; pg8::StaticOrder S; S.init(T, 3072, G, (int)blockIdx.x);
                pg8::EpiB<FQKV1> E{{QB_, K1, V1, SSQP}}; pg8::gemm_phase<pg8::EpiB<FQKV1>, pg8::StaticOrder, true>(lds + RING_OFF, g, S, E); }
            SEAM(PH_QKV1);
            if (IN(PH_ATT1)) {
                for (int u = vcu; u < 512; u += G) { const int bh = u >> 3, qb = u & 7, b = bh >> 3, h = bh & 7;
                    att::attn_unit<att::MODE_SB>(lds + RING_OFF, QB_ + ((size_t)bh * SEQ + qb * 256) * 128, K1 + (size_t)bh * SEQ * 128, nullptr, V1 + (size_t)bh * SEQ * 128,
                        OB + ((size_t)b * SEQ + qb * 256) * DM + h * 128, DM, qb * 256, 0); }
            }
            SEAM(PH_ATT1);
        }
        if (IN(PB)) { pg8::Gemm g{OB, (const bf16*)(WSL() + (layer ? WS_WO1 : WS_WO0)), T, DM, DM, DM}; pg8::StaticOrder S; S.init(T, DM, G, (int)blockIdx.x);
            if (layer == 0) { pg8::EpiResN<true> E{x, HB, SSQP}; pg8::gemm_phase<pg8::EpiResN<true>, pg8::StaticOrder, true>(lds + RING_OFF, g, S, E); }
            else { pg8::EpiResN<false> E{nullptr, HB, SSQP}; pg8::gemm_phase<pg8::EpiResN<false>, pg8::StaticOrder, true>(lds + RING_OFF, g, S, E); } }
        SEAM(PB);
        if (IN(PB + 1)) { pg8::Gemm g{HB, (const bf16*)(WSL() + WS_WXQ + (size_t)layer * 512 * DM * 2), T, 512, DM, DM}; pg8::StaticOrder S; S.init(T, 512, G, (int)blockIdx.x);
            pg8::EpiB<FXQ> E{{QX, SSQP}}; pg8::gemm_phase<pg8::EpiB<FXQ>, pg8::StaticOrder, true>(lds + RING_OFF, g, S, E); }
        SEAM(PB + 1);
        if (IN(PB + 2)) { const bf16* kx = (const bf16*)(WSL() + WS_KVX + (size_t)layer * 4 * MiB); const bf16* vx = kx + (size_t)TM * 512;
            for (int u = vcu; u < 256; u += G) { const int bh = u >> 3, qb = u & 7, b = bh >> 2, h = bh & 3;
                att::attn_unit<att::MODE_CROSS>(lds + RING_OFF, QX + ((size_t)bh * SEQ + qb * 256) * 128, kx + (size_t)bh * MEMLEN * 128, nullptr, vx + (size_t)bh * MEMLEN * 128,
                    OX + ((size_t)b * SEQ + qb * 256) * 512 + h * 128, 512, 0, MEMLEN); } }
        SEAM(PB + 2);
        if (IN(PB + 3)) { pg8::Gemm g{OX, (const bf16*)(WSL() + WS_WXO + (size_t)layer * DM * 512 * 2), T, DM, 512, 512}; pg8::StaticOrder S; S.init(T, DM, G, (int)blockIdx.x);
            pg8::EpiResN<false> E{nullptr, HB, SSQP}; pg8::gemm_phase<pg8::EpiResN<false>, pg8::StaticOrder, true>(lds + RING_OFF, g, S, E); }
        SEAM(PB + 3);
        if (IN(PB + 4)) { pg8::Gemm g{HB, (const bf16*)(WSL() + WS_WIN + (size_t)layer * DFF * DM * 2), T, DFF, DM, DM}; pg8::StaticOrder S; S.init(T, DFF, G, (int)blockIdx.x);
            pg8::EpiB<FUp> E{{U, SSQP}}; pg8::gemm_phase<pg8::EpiB<FUp>, pg8::StaticOrder, true>(lds + RING_OFF, g, S, E); }
        SEAM(PB + 4);
        if (IN(PB + 5)) { pg8::Gemm g{U, (const bf16*)(WSL() + WS_WOUT + (size_t)layer * DM * DFF * 2), T, DM, DFF, DFF}; pg8::StaticOrder S; S.init(T, DM, G, (int)blockIdx.x);
            pg8::EpiResN<false> E{nullptr, HB, SSQP}; pg8::gemm_phase<pg8::EpiResN<false>, pg8::StaticOrder, true>(lds + RING_OFF, g, S, E); }
        SEAM(PB + 5);
        if (layer == 1) {
            if (IN(PH_FINAL)) {
                for (int m = gw; m < T; m += NGW) {
                    const GAS v4u* hr = (const GAS v4u*)(HB + (size_t)m * DM) + lane;
                    GAS f32x4* orow = (GAS f32x4*)(hres + (size_t)m * DM); const GAS f32x4* gr = (const GAS f32x4*)norm_final;
                    f32x4 va[2], vb[2]; float s = 0.f;
#pragma unroll
                    for (int j = 0; j < 2; ++j) { const v4u w = hr[64 * j];
                        va[j] = (f32x4){__builtin_bit_cast(float, w.x << 16), __builtin_bit_cast(float, w.x & 0xffff0000u), __builtin_bit_cast(float, w.y << 16), __builtin_bit_cast(float, w.y & 0xffff0000u)};
                        vb[j] = (f32x4){__builtin_bit_cast(float, w.z << 16), __builtin_bit_cast(float, w.z & 0xffff0000u), __builtin_bit_cast(float, w.w << 16), __builtin_bit_cast(float, w.w & 0xffff0000u)};
                        s += ((va[j].x * va[j].x + va[j].y * va[j].y) + (va[j].z * va[j].z + va[j].w * va[j].w)) + ((vb[j].x * vb[j].x + vb[j].y * vb[j].y) + (vb[j].z * vb[j].z + vb[j].w * vb[j].w)); }
                    const float r = 1.0f / sqrtf(wave_sum(s) * (1.0f / 1024.0f) + EPS);
#pragma unroll
                    for (int j = 0; j < 2; ++j) { const int c4 = 2 * (lane + 64 * j); orow[c4] = va[j] * r * gr[c4]; orow[c4 + 1] = vb[j] * r * gr[c4 + 1]; }
                }
            }
        }
    }
    if (PROBE_MASK) { const unsigned long long t_now = __builtin_amdgcn_s_memrealtime(); if ((PROBE_MASK >> (NPH - 1)) & 1u) t_acc += t_now - t_prev;
        if (blockIdx.x == 0 && tid == 0) { while (__builtin_amdgcn_s_memrealtime() - t_now < 4ull * t_acc) __builtin_amdgcn_s_sleep(32); } }
#undef IN
#undef SEAM
}

#ifndef MK_N_LAUNCHES
#define MK_N_LAUNCHES 1
#endif
extern "C" void kernel_launch(void* const* d_in, const int* in_sizes, int n_in, void* d_out, int out_size, void* d_ws, size_t ws_size, hipStream_t stream) {
    static int grid = 0;
    if (grid == 0) {
        if (n_in != 21 || in_sizes[0] != T * DM || out_size != T * DM || ws_size < WS_END) { fprintf(stderr, "kernel_launch: unexpected shapes (n_in %d, in0 %d, out %d, ws %zu)\n", n_in, n_in > 0 ? in_sizes[0] : -1, out_size, ws_size); grid = -1; return; }
        int dev = 0, cus = 0, per_cu = 0;
        if (hipGetDevice(&dev) != hipSuccess || hipDeviceGetAttribute(&cus, hipDeviceAttributeMultiprocessorCount, dev) != hipSuccess) { grid = -1; return; }
        if (hipFuncSetAttribute((const void*)mk_fwd, hipFuncAttributeMaxDynamicSharedMemorySize, LDS_BYTES) != hipSuccess) { fprintf(stderr, "kernel_launch: hipFuncSetAttribute failed\n"); grid = -1; return; }
        if (hipOccupancyMaxActiveBlocksPerMultiprocessor(&per_cu, (const void*)mk_fwd, NWAVES * 64, LDS_BYTES) != hipSuccess || per_cu < 1)
            fprintf(stderr, "kernel_launch: note: occupancy query reports %d workgroups per CU\n", per_cu);
        (void)hipGetLastError();
        grid = cus;
    }
    if (grid < 0) return;
    (void)hipMemsetAsync((char*)d_ws + WS_CTL, 0, CTL_ZERO_BYTES, stream);
    Args a{};
    for (int i = 0; i < 21; ++i) a.in[i] = (const float*)d_in[i];
    a.out = (float*)d_out; a.ws = (unsigned char*)d_ws;
#if MK_N_LAUNCHES == 1
    a.ph_lo = 0; a.ph_hi = NPH;
    hipLaunchKernelGGL(mk_fwd, dim3(grid), dim3(NWAVES * 64), LDS_BYTES, stream, a);
#else
    for (int p = 0; p < NPH; ++p) { a.ph_lo = p; a.ph_hi = p + 1; hipLaunchKernelGGL(mk_fwd, dim3(grid), dim3(NWAVES * 64), LDS_BYTES, stream, a); }
#endif
}
```

```cpp
#include <hip/hip_runtime.h>
#include <cstdio>
#include <cstdint>
namespace pg8 {
#define PG8_LAS __attribute__((address_space(3)))
typedef unsigned short bf16_t;
typedef short bf16x8 __attribute__((ext_vector_type(8)));
typedef float f32x4 __attribute__((ext_vector_type(4)));
typedef unsigned u32x4 __attribute__((ext_vector_type(4)));
constexpr int BM = 256, BK = 64, HALF = 128, HTB = HALF * BK * 2  , STAGE_BYTES = 8 * HTB, NXCD = 8, WGM = 8;

__host__ __device__ __forceinline__ int lds_byte(int r, int c) { const int st = (r >> 4) * 2 + (c >> 5), rr = r & 15, cc = c & 31, ob = rr * 64 + cc * 2; return st * 1024 + (ob ^ (((ob >> 9) & 1) << 5)); }
__host__ __device__ __forceinline__ void stage_rc(int b, int& R, int& C) { const int st = b / 1024, sb = b % 1024, swz = sb ^ (((sb >> 9) & 1) << 5); R = (st >> 1) * 16 + swz / 64; C = (st & 1) * 32 + (swz % 64) / 2; }
__host__ __device__ __forceinline__ int perm32(int rho) { const int n = rho >> 4, i = rho & 15; return 8 * (i >> 2) + 4 * n + (i & 3); }

struct Unit { int pm, pn; };
struct Gemm { const bf16_t* A; const bf16_t* Bt; int M, N, K, lda; };

struct StaticOrder {
    int nM, nN, nwg, G, c;
    __host__ __device__ void init(int M, int N, int G_, int c_) { nM = M / BM; nN = N / BM; nwg = nM * nN; G = G_; c = c_; }
    __host__ __device__ bool next(int i, Unit& u) const {
        const long L = (long)i * G + c; if (L >= nwg) return false;
        int wgid = (int)L; { const int q = nwg / NXCD, r = nwg % NXCD, xcd = wgid % NXCD, off = wgid / NXCD; wgid = (xcd < r ? xcd * (q + 1) : r * (q + 1) + (xcd - r) * q) + off; }
        const int nig = WGM * nN, gid = wgid / nig, fm = gid * WGM, gsz = (nM - fm) < WGM ? (nM - fm) : WGM;
        u.pm = fm + ((wgid % nig) % gsz); u.pn = (wgid % nig) / gsz; return true;
    }
};

__device__ __forceinline__ unsigned cvt_pk_bf16(float lo, float hi) { unsigned r; asm volatile("v_cvt_pk_bf16_f32 %0, %1, %2" : "=v"(r) : "v"(lo), "v"(hi)); return r; }

template <class F> struct EpiB {
    static constexpr bool PERM = true;
    F f;
    __device__ __forceinline__ void operator()(const f32x4 (&acc)[2][2][4][2], const Unit& u, int wr, int wc, int fr, int fq) const {
        const int row0 = u.pm * BM + wr * 64 + fr, col0 = u.pn * BM + wc * 32 + 8 * fq;
#pragma unroll
        for (int ai = 0; ai < 2; ++ai)
#pragma unroll
            for (int m = 0; m < 4; ++m) { const int row = row0 + ai * HALF + m * 16; const float rsc = f.rowscale(row);
#pragma unroll
                for (int bj = 0; bj < 2; ++bj) f(row, col0 + bj * HALF, acc[ai][bj][m][0] * rsc, acc[ai][bj][m][1] * rsc); }
    }
};
struct EpiRes {
    static constexpr bool PERM = false;
    const float* base; float* out; int ldc;
    __device__ __forceinline__ void operator()(const f32x4 (&acc)[2][2][4][2], const Unit& u, int wr, int wc, int fr, int fq) const {
        const int row0 = u.pm * BM + wr * 64 + fr, col0 = u.pn * BM + wc * 32 + 4 * fq;
#pragma unroll
        for (int ai = 0; ai < 2; ++ai)
#pragma unroll
            for (int m = 0; m < 4; ++m) { const size_t off = (size_t)(row0 + ai * HALF + m * 16) * ldc + col0;
#pragma unroll
                for (int bj = 0; bj < 2; ++bj)
#pragma unroll
                    for (int n = 0; n < 2; ++n) { const size_t o = off + bj * HALF + n * 16; *(f32x4*)(out + o) = *(const f32x4*)(base + o) + acc[ai][bj][m][n]; } }
    }
};

template <bool BASE_F32> struct EpiResN {
    static constexpr bool PERM = true;
    const float* basef; bf16_t* hb; float* ssqp;
    __device__ __forceinline__ void operator()(const f32x4 (&acc)[2][2][4][2], const Unit& u, int wr, int wc, int fr, int fq) const {
        const int row0 = u.pm * BM + wr * 64 + fr, col0 = u.pn * BM + wc * 32 + 8 * fq;
#pragma unroll
        for (int ai = 0; ai < 2; ++ai)
#pragma unroll
            for (int m = 0; m < 4; ++m) { const int row = row0 + ai * HALF + m * 16; float ss = 0.f;
#pragma unroll
                for (int bj = 0; bj < 2; ++bj) { const size_t o = (size_t)row * 1024 + col0 + bj * HALF;
                    f32x4 a, b;
                    if (BASE_F32) { a = *(const f32x4*)(basef + o); b = *(const f32x4*)(basef + o + 4); }
                    else { const u32x4 w = *(const u32x4*)(hb + o);
                        a = (f32x4){__builtin_bit_cast(float, w.x << 16), __builtin_bit_cast(float, w.x & 0xffff0000u), __builtin_bit_cast(float, w.y << 16), __builtin_bit_cast(float, w.y & 0xffff0000u)};
                        b = (f32x4){__builtin_bit_cast(float, w.z << 16), __builtin_bit_cast(float, w.z & 0xffff0000u), __builtin_bit_cast(float, w.w << 16), __builtin_bit_cast(float, w.w & 0xffff0000u)}; }
                    a = a + acc[ai][bj][m][0]; b = b + acc[ai][bj][m][1];
                    u32x4 w2; w2.x = cvt_pk_bf16(a[0], a[1]); w2.y = cvt_pk_bf16(a[2], a[3]); w2.z = cvt_pk_bf16(b[0], b[1]); w2.w = cvt_pk_bf16(b[2], b[3]); *(u32x4*)(hb + o) = w2;
                    ss += ((a[0] * a[0] + a[1] * a[1]) + (a[2] * a[2] + a[3] * a[3])) + ((b[0] * b[0] + b[1] * b[1]) + (b[2] * b[2] + b[3] * b[3])); }
                ss += __shfl_xor(ss, 16); ss += __shfl_xor(ss, 32);
                if (fq == 0) ssqp[(size_t)row * 16 + u.pn * 4 + wc] = ss; }
    }
};

template <class Epi, class Sched, bool ALIGN_EPI>
__device__ __forceinline__ void gemm_phase(PG8_LAS unsigned char* lds, const Gemm g, const Sched& S, const Epi& E) {
    int tid = threadIdx.x; asm volatile("" : "+v"(tid));
    const int wid = __builtin_amdgcn_readfirstlane(tid >> 6), lane = tid & 63, wr = wid >> 2, wc = wid & 3, fr = lane & 15, fq = lane >> 4;
    const int K = g.K, nt = K / BK;
    unsigned voffA[2], voffB[2];
#pragma unroll
    for (int i = 0; i < 2; ++i) { int R, C; stage_rc(tid * 16 + i * 8192, R, C); const int Rb = Epi::PERM ? ((R & ~31) + perm32(R & 31)) : R;
        voffA[i] = (unsigned)(R * g.lda + C) * 2u; voffB[i] = (unsigned)(Rb * K + C) * 2u; }
    const size_t kstep = (size_t)(BK * 2);
    const size_t hstepA = (size_t)HALF * g.lda * 2, hstepB = (size_t)HALF * K * 2;
    const size_t tstepA = 2 * hstepA, tstepB = 2 * hstepB;
    const unsigned ldsw = (unsigned)wid * 1024u;
    const int aoff = lds_byte(wr * 64 + fr, fq * 8), boff = lds_byte(wc * 32 + fr, fq * 8);
#define PG8_SA(b, h) (((b) * 2 + (h)) * HTB)
#define PG8_SB(b, h) ((4 + (b) * 2 + (h)) * HTB)
#define PG8_STAGE(bufoff, gbase, voff) do { _Pragma("unroll") for (int _i = 0; _i < 2; ++_i) \
        __builtin_amdgcn_global_load_lds((const unsigned*)((const char*)(gbase) + (voff)[_i]), (PG8_LAS unsigned*)(lds + (bufoff) + ldsw + _i * 8192), 16, 0, 0); } while (0)
#define PG8_LDA(dst, b, h) do { _Pragma("unroll") for (int m = 0; m < 4; ++m) _Pragma("unroll") for (int k = 0; k < 2; ++k) dst[m][k] = *(const PG8_LAS bf16x8*)(lds + PG8_SA(b, h) + aoff + m * 2048 + k * 1024); } while (0)
#define PG8_LDB(dst, b, h) do { _Pragma("unroll") for (int n = 0; n < 2; ++n) _Pragma("unroll") for (int k = 0; k < 2; ++k) dst[n][k] = *(const PG8_LAS bf16x8*)(lds + PG8_SB(b, h) + boff + n * 2048 + k * 1024); } while (0)
#define PG8_MMA(ai, bj, At, Bt) do { __builtin_amdgcn_s_setprio(1); _Pragma("unroll") for (int m = 0; m < 4; ++m) _Pragma("unroll") for (int n = 0; n < 2; ++n) _Pragma("unroll") for (int k = 0; k < 2; ++k) \
        acc[ai][bj][m][n] = __builtin_amdgcn_mfma_f32_16x16x32_bf16(Bt[n][k], At[m][k], acc[ai][bj][m][n], 0, 0, 0); __builtin_amdgcn_s_setprio(0); } while (0)
#define PG8_WAIT_V(n) asm volatile("s_waitcnt vmcnt(" #n ")" ::: "memory")
#define PG8_WAIT_L(n) asm volatile("s_waitcnt lgkmcnt(" #n ")" ::: "memory")
#define PG8_BAR __builtin_amdgcn_s_barrier()
#define PG8_SCHED __builtin_amdgcn_sched_barrier(0)
    Unit cur, nxt; int ui = 0;
    if (!S.next(0, cur)) return;
    f32x4 acc[2][2][4][2];
#pragma unroll
    for (int a = 0; a < 2; ++a)
#pragma unroll
        for (int b = 0; b < 2; ++b)
#pragma unroll
            for (int m = 0; m < 4; ++m)
#pragma unroll
                for (int n = 0; n < 2; ++n) acc[a][b][m][n] = (f32x4){0.f, 0.f, 0.f, 0.f};
    bf16x8 At[4][2], B0[2][2], B1[2][2];
    const char* cA = (const char*)g.A + (size_t)cur.pm * tstepA; const char* cB = (const char*)g.Bt + (size_t)cur.pn * tstepB;
    PG8_STAGE(PG8_SB(0, 0), cB, voffB); PG8_STAGE(PG8_SB(0, 1), cB + hstepB, voffB); PG8_STAGE(PG8_SA(0, 0), cA, voffA); PG8_STAGE(PG8_SA(0, 1), cA + hstepA, voffA);
    if (wr == 1) PG8_BAR;
    PG8_WAIT_V(2); PG8_BAR;
    PG8_STAGE(PG8_SB(1, 0), cB + kstep, voffB); PG8_STAGE(PG8_SA(1, 0), cA + kstep, voffA); PG8_STAGE(PG8_SB(1, 1), cB + hstepB + kstep, voffB);
    PG8_WAIT_V(6); PG8_BAR;
    for (;;) {
        const bool has_next = S.next(ui + 1, nxt);
        const char* nA = has_next ? (const char*)g.A + (size_t)nxt.pm * tstepA : cA; const char* nB = has_next ? (const char*)g.Bt + (size_t)nxt.pn * tstepB : cB;
#pragma nounroll
        for (int t = 0; t < nt; t += 2) {
            const bool last = (t == nt - 2);
            const char* a1 = cA + (size_t)(t + 1) * kstep;
            const char* a2 = last ? nA : cA + (size_t)(t + 2) * kstep; const char* b2 = last ? nB : cB + (size_t)(t + 2) * kstep;
            const char* a3 = a2 + kstep; const char* b3 = b2 + kstep;
            PG8_LDB(B0, 0, 0); PG8_LDB(B1, 0, 1); PG8_SCHED; PG8_LDA(At, 0, 0); PG8_STAGE(PG8_SA(1, 1), a1 + hstepA, voffA);
            PG8_WAIT_V(8); PG8_WAIT_L(0); PG8_BAR; PG8_MMA(0, 0, At, B0); PG8_MMA(0, 1, At, B1); PG8_BAR; PG8_SCHED;
            PG8_LDA(At, 0, 1); PG8_STAGE(PG8_SB(0, 0), b2, voffB); PG8_STAGE(PG8_SB(0, 1), b2 + hstepB, voffB); PG8_STAGE(PG8_SA(0, 0), a2, voffA);
            PG8_WAIT_V(8); PG8_WAIT_L(0); PG8_BAR; PG8_MMA(1, 0, At, B0); PG8_MMA(1, 1, At, B1); PG8_BAR; PG8_SCHED;
            PG8_LDB(B0, 1, 0); PG8_LDB(B1, 1, 1); PG8_SCHED; PG8_LDA(At, 1, 0); PG8_STAGE(PG8_SA(0, 1), a2 + hstepA, voffA);
            PG8_WAIT_V(8); PG8_WAIT_L(0); PG8_BAR; PG8_MMA(0, 0, At, B0); PG8_MMA(0, 1, At, B1); PG8_BAR; PG8_SCHED;
            PG8_LDA(At, 1, 1); PG8_STAGE(PG8_SB(1, 0), b3, voffB); PG8_STAGE(PG8_SB(1, 1), b3 + hstepB, voffB); PG8_STAGE(PG8_SA(1, 0), a3, voffA);
            PG8_WAIT_V(8); PG8_WAIT_L(0); PG8_BAR; PG8_MMA(1, 0, At, B0); PG8_MMA(1, 1, At, B1); PG8_BAR; PG8_SCHED;
        }
        if constexpr (ALIGN_EPI) { if (wr == 0) PG8_BAR; }
        E(acc, cur, wr, wc, fr, fq);
        if (!has_next) break;
#pragma unroll
        for (int a = 0; a < 2; ++a)
#pragma unroll
            for (int b = 0; b < 2; ++b)
#pragma unroll
                for (int m = 0; m < 4; ++m)
#pragma unroll
                    for (int n = 0; n < 2; ++n) acc[a][b][m][n] = (f32x4){0.f, 0.f, 0.f, 0.f};
        cur = nxt; cA = nA; cB = nB; ++ui;
        if constexpr (ALIGN_EPI) { if (wr == 1) PG8_BAR; }
    }
    PG8_WAIT_V(0);
    if constexpr (!ALIGN_EPI) { if (wr == 0) PG8_BAR; }
    PG8_BAR;
#undef PG8_SA
#undef PG8_SB
#undef PG8_STAGE
#undef PG8_LDA
#undef PG8_LDB
#undef PG8_MMA
#undef PG8_WAIT_V
#undef PG8_WAIT_L
#undef PG8_BAR
#undef PG8_SCHED
}
}
namespace att {
typedef unsigned short bf16_t;
typedef short bf16x8 __attribute__((ext_vector_type(8)));
typedef short s16x4 __attribute__((ext_vector_type(4)));
typedef float f32x16 __attribute__((ext_vector_type(16)));
typedef float f32x4 __attribute__((ext_vector_type(4)));
typedef unsigned u32x4 __attribute__((ext_vector_type(4)));
#define ATT_LAS __attribute__((address_space(3)))
constexpr int KVBLK = 64, QBLK = 32, QB = 256;
constexpr int L_K = 0, L_V = 16384, L_PE = 32768, BUFB = 40960, L_WS = 2 * BUFB, L_FLAG = L_WS + 2048, LDS_BYTES = L_FLAG + 64;
enum { MODE_MLA = 0, MODE_CROSS = 1, MODE_SB = 2 };

#define ATT_KSWZ(row, colB) ((row) * 256 + ((colB) ^ (((row) & 7) << 4)))
#define ATT_PESWZ(row, ch) ((row) * 128 + ((((ch) ^ (((row) >> 1) & 7))) << 4))
#define ATT_SBAR() __builtin_amdgcn_sched_barrier(0)
__device__ __forceinline__ int v_st(int k, int c) { const int kk = (k & ~0xC) | ((k & 4) << 1) | ((k & 8) >> 1); return ((kk >> 3) * 4 + (c >> 5)) * 512 + ((kk & 7) * 32 + (c & 31)) * 2; }
__device__ __forceinline__ int v_rd_base(int lane) { return ((lane & 3) << 3) | (((lane >> 2) & 3) << 6) | (((lane >> 4) & 1) << 5) | (((lane >> 5) & 1) << 8); }
__device__ __forceinline__ int crow(int r, int hi) { return (r & 3) + 8 * (r >> 2) + 4 * hi; }
__device__ __forceinline__ unsigned cvtpk(float lo, float hi) { unsigned r; asm volatile("v_cvt_pk_bf16_f32 %0, %1, %2" : "=v"(r) : "v"(lo), "v"(hi)); return r; }
__device__ __forceinline__ float swap_add(float v) { auto rr = __builtin_amdgcn_permlane32_swap(__float_as_uint(v), __float_as_uint(v), false, false); return __uint_as_float(rr[0]) + __uint_as_float(rr[1]); }
__device__ __forceinline__ float swap_max(float v) { auto rr = __builtin_amdgcn_permlane32_swap(__float_as_uint(v), __float_as_uint(v), false, false); return fmaxf(__uint_as_float(rr[0]), __uint_as_float(rr[1])); }
__device__ __forceinline__ float swap_other(float v, int hi) { auto rr = __builtin_amdgcn_permlane32_swap(__float_as_uint(v), __float_as_uint(v), false, false);
    const float a = __uint_as_float(rr[0]), b = __uint_as_float(rr[1]); return hi ? a : b; }

__device__ __forceinline__ void pack_p(const f32x16& p0, const f32x16& p1, bf16x8& pa0, bf16x8& pa1, bf16x8& pa2, bf16x8& pa3) {
#define ATT_PK4(P, B_, OUT) do { unsigned a0 = cvtpk(P[B_+0], P[B_+1]), a1 = cvtpk(P[B_+2], P[B_+3]);                          \
        unsigned b0 = cvtpk(P[B_+4], P[B_+5]), b1 = cvtpk(P[B_+6], P[B_+7]);                                             \
        auto r0 = __builtin_amdgcn_permlane32_swap(a0, b0, false, false); auto r1 = __builtin_amdgcn_permlane32_swap(a1, b1, false, false); \
        u32x4 w = {r0[0], r1[0], r0[1], r1[1]}; OUT = *reinterpret_cast<bf16x8*>(&w); } while (0)
    ATT_PK4(p0, 0, pa0); ATT_PK4(p0, 8, pa1); ATT_PK4(p1, 0, pa2); ATT_PK4(p1, 8, pa3);
#undef ATT_PK4
}
__device__ __forceinline__ void pv_tile(f32x16* o, int vb0, bf16x8 pa0, bf16x8 pa1, bf16x8 pa2, bf16x8 pa3) {
#define ATT_TRRD(dst, off) asm volatile("ds_read_b64_tr_b16 %0, %1 offset:%2" : "=&v"(dst) : "v"(vb0), "i"(off) : "memory")
#define ATT_PV_D0(d0) do { s16x4 l0, l1, l2, l3, h0, h1, h2, h3; constexpr int b_ = (d0) * 512;   \
        ATT_TRRD(l0, b_); ATT_TRRD(h0, b_ + 2048); ATT_TRRD(l1, b_ + 4096); ATT_TRRD(h1, b_ + 6144); ATT_TRRD(l2, b_ + 8192); ATT_TRRD(h2, b_ + 10240); ATT_TRRD(l3, b_ + 12288); ATT_TRRD(h3, b_ + 14336); \
        asm volatile("s_waitcnt lgkmcnt(0)" ::: "memory"); ATT_SBAR();   \
        o[d0] = __builtin_amdgcn_mfma_f32_32x32x16_bf16((bf16x8){l0[0], l0[1], l0[2], l0[3], h0[0], h0[1], h0[2], h0[3]}, pa0, o[d0], 0, 0, 0);   \
        o[d0] = __builtin_amdgcn_mfma_f32_32x32x16_bf16((bf16x8){l1[0], l1[1], l1[2], l1[3], h1[0], h1[1], h1[2], h1[3]}, pa1, o[d0], 0, 0, 0);   \
        o[d0] = __builtin_amdgcn_mfma_f32_32x32x16_bf16((bf16x8){l2[0], l2[1], l2[2], l2[3], h2[0], h2[1], h2[2], h2[3]}, pa2, o[d0], 0, 0, 0);   \
        o[d0] = __builtin_amdgcn_mfma_f32_32x32x16_bf16((bf16x8){l3[0], l3[1], l3[2], l3[3], h3[0], h3[1], h3[2], h3[3]}, pa3, o[d0], 0, 0, 0); } while (0)
    ATT_PV_D0(0); ATT_PV_D0(1); ATT_PV_D0(2); ATT_PV_D0(3);
#undef ATT_PV_D0
#undef ATT_TRRD
}

template <int MODE, bool FUSEQ = false>
__device__ __forceinline__ void attn_unit(ATT_LAS unsigned char* lds, const bf16_t* Qb, const bf16_t* Kn, const bf16_t* Kpe, const bf16_t* Vp, bf16_t* Ob, int ostride, int q0, int nkeys,
                                          const bf16_t* Hrows = nullptr, const bf16_t* Wh = nullptr, const float* ssqp = nullptr, float qscale = 1.0f) {
    constexpr int DKQ = (MODE == MODE_MLA) ? 192 : 128, NQF = DKQ / 16;
    int tid = threadIdx.x; asm volatile("" : "+v"(tid));
    const int wid = __builtin_amdgcn_readfirstlane(tid >> 6), lane = tid & 63, r32 = lane & 31, hi = lane >> 5;
    volatile ATT_LAS int* flags = (volatile ATT_LAS int*)(lds + L_FLAG);
    const int vb0 = (int)(unsigned)(uintptr_t)(lds + L_V) + v_rd_base(lane);
    bf16x8 qr[NQF];
    if (!FUSEQ) {
#pragma unroll
        for (int d0 = 0; d0 < NQF; ++d0) qr[d0] = *(const bf16x8*)(Qb + (size_t)(wid * QBLK + r32) * DKQ + d0 * 16 + hi * 8);
    } else {
        f32x16 qa[4]; qa[0] = f32x16{}; qa[1] = f32x16{}; qa[2] = f32x16{}; qa[3] = f32x16{};
        const bf16_t* hrow = Hrows + (size_t)(wid * QBLK + r32) * 1024 + hi * 8;
        const int wr0 = tid >> 4, wch = tid & 15;
        const bf16_t* wsrc = Wh + (size_t)wr0 * 1024 + wch * 8;
        const int wws = ATT_KSWZ(wr0, wch * 16);
        u32x4 wv[4];
        bf16x8 hb_[8], hn_[8];
#pragma unroll
        for (int i = 0; i < 4; ++i) wv[i] = *(const u32x4*)(wsrc + (size_t)i * 32 * 1024);
#pragma unroll
        for (int ks = 0; ks < 8; ++ks) hb_[ks] = *(const bf16x8*)(hrow + ks * 16);
#pragma unroll
        for (int i = 0; i < 4; ++i) *(ATT_LAS u32x4*)(lds + wws + i * 32 * 256) = wv[i];
#pragma unroll
        for (int ks = 0; ks < 8; ++ks) asm volatile("" : "+v"(hb_[ks]));
        __syncthreads();
#pragma nounroll
        for (int c = 0; c < 8; ++c) {
            ATT_LAS unsigned char* wb = lds + (c & 1) * 32768;
            const bool morec = (c + 1 < 8);
            if (morec) {
#pragma unroll
                for (int i = 0; i < 4; ++i) wv[i] = *(const u32x4*)(wsrc + (size_t)i * 32 * 1024 + (c + 1) * 128);
#pragma unroll
                for (int ks = 0; ks < 8; ++ks) hn_[ks] = *(const bf16x8*)(hrow + (c + 1) * 128 + ks * 16); }
#pragma unroll
            for (int ks = 0; ks < 8; ++ks) {
#pragma unroll
                for (int blk = 0; blk < 4; ++blk) {
                    const bf16x8 af = *(const ATT_LAS bf16x8*)(wb + ATT_KSWZ(r32, ((ks & 3) * 16 + hi * 8) * 2) + (ks >> 2) * 128 + blk * 32 * 256);
                    qa[blk] = __builtin_amdgcn_mfma_f32_32x32x16_bf16(af, hb_[ks], qa[blk], 0, 0, 0);
                }
            }
            if (morec) {
#pragma unroll
                for (int i = 0; i < 4; ++i) *(ATT_LAS u32x4*)(lds + ((c + 1) & 1) * 32768 + wws + i * 32 * 256) = wv[i];
#pragma unroll
                for (int ks = 0; ks < 8; ++ks) hb_[ks] = hn_[ks]; }
            __syncthreads();
        }
        { const f32x4* pp = (const f32x4*)(ssqp + (size_t)(wid * QBLK + r32) * 16); const f32x4 a = pp[0], b = pp[1], cc = pp[2], d = pp[3];
          const float sm = (((a[0] + a[1]) + (a[2] + a[3])) + ((b[0] + b[1]) + (b[2] + b[3]))) + (((cc[0] + cc[1]) + (cc[2] + cc[3])) + ((d[0] + d[1]) + (d[2] + d[3])));
          const float sc_ = qscale / sqrtf(sm * (1.0f / 1024.0f) + 1e-6f);
#pragma unroll
          for (int blk = 0; blk < 4; ++blk) qa[blk] = qa[blk] * sc_; }
#define ATT_PK4(P, B_, OUT) do { unsigned a0 = cvtpk(P[B_+0], P[B_+1]), a1 = cvtpk(P[B_+2], P[B_+3]);                          \
        unsigned b0 = cvtpk(P[B_+4], P[B_+5]), b1 = cvtpk(P[B_+6], P[B_+7]);                                             \
        auto r0 = __builtin_amdgcn_permlane32_swap(a0, b0, false, false); auto r1 = __builtin_amdgcn_permlane32_swap(a1, b1, false, false); \
        u32x4 w = {r0[0], r1[0], r0[1], r1[1]}; OUT = *reinterpret_cast<bf16x8*>(&w); } while (0)
#pragma unroll
        for (int blk = 0; blk < 4; ++blk) { ATT_PK4(qa[blk], 0, qr[2 * blk]); ATT_PK4(qa[blk], 8, qr[2 * blk + 1]); }
#undef ATT_PK4
    }
    const int qlo = q0 + wid * QBLK;
    const int qpos = qlo + r32;
    float m_reg = -1e30f, l_reg = 0.f, Rrun = 0.f;
    f32x16 o[4]; o[0] = f32x16{}; o[1] = f32x16{}; o[2] = f32x16{}; o[3] = f32x16{};
    const int sr = tid >> 4, sc = (tid & 15) * 8;
    const int kws = ATT_KSWZ(sr, sc * 2), vst0 = v_st(sr, sc), vst1 = v_st(32 + sr, sc);
    const int per = tid >> 3, pech = tid & 7, pews = ATT_PESWZ(per, pech);
    int NT;
    if (MODE == MODE_CROSS) NT = nkeys / KVBLK; else NT = (q0 + QB) / KVBLK;
    u32x4 k0v, k1v, v0v, v1v, pev;
#define ATT_LOAD(kb_) do { k0v = *(const u32x4*)(Kn + (size_t)((kb_) + sr) * 128 + sc); k1v = *(const u32x4*)(Kn + (size_t)((kb_) + 32 + sr) * 128 + sc); \
        v0v = *(const u32x4*)(Vp + (size_t)((kb_) + sr) * 128 + sc); v1v = *(const u32x4*)(Vp + (size_t)((kb_) + 32 + sr) * 128 + sc); \
        if (MODE == MODE_MLA) pev = *(const u32x4*)(Kpe + (size_t)((kb_) + per) * 64 + pech * 8); } while (0)
#define ATT_WRITE(bo_) do { *(ATT_LAS u32x4*)(lds + (bo_) + L_K + kws) = k0v; *(ATT_LAS u32x4*)(lds + (bo_) + L_K + kws + 32 * 256) = k1v; \
        *(ATT_LAS u32x4*)(lds + (bo_) + L_V + vst0) = v0v; *(ATT_LAS u32x4*)(lds + (bo_) + L_V + vst1) = v1v; \
        if (MODE == MODE_MLA) *(ATT_LAS u32x4*)(lds + (bo_) + L_PE + pews) = pev; } while (0)
#define ATT_TILE(it_) ((MODE == MODE_SB) ? (NT - 1 - (it_)) : (it_))
    ATT_LOAD(ATT_TILE(0) * KVBLK);
    ATT_WRITE(0);
#pragma unroll
    for (int d0 = 0; d0 < NQF; ++d0) asm volatile("" : "+v"(qr[d0]));
    __syncthreads();
    for (int it = 0; it < NT; ++it) {
        const int kb = ATT_TILE(it) * KVBLK;
        const int bo = (it & 1) * BUFB;
        ATT_LAS unsigned char* ldsb = lds + bo;
        const bool more = (it + 1 < NT);
        if (more) ATT_LOAD(ATT_TILE(it + 1) * KVBLK);
        bool act = true;
        if (MODE == MODE_MLA) act = (kb <= qlo + QBLK - 1);
        if (MODE == MODE_SB) act = (kb < qlo + QBLK - 1);
        if (act && MODE != MODE_SB) {
            f32x16 p0 = f32x16{}, p1 = f32x16{};
#pragma unroll
            for (int d0 = 0; d0 < 8; ++d0) {
                const int off = ATT_KSWZ(r32, ((d0 & 3) * 16 + hi * 8) * 2) + (d0 >> 2) * 128;
                const bf16x8 b0 = *(const ATT_LAS bf16x8*)(ldsb + L_K + off);
                const bf16x8 b1 = *(const ATT_LAS bf16x8*)(ldsb + L_K + off + 32 * 256);
                p0 = __builtin_amdgcn_mfma_f32_32x32x16_bf16(b0, qr[d0], p0, 0, 0, 0);
                p1 = __builtin_amdgcn_mfma_f32_32x32x16_bf16(b1, qr[d0], p1, 0, 0, 0);
            }
            if (MODE == MODE_MLA) {
#pragma unroll
                for (int d0 = 8; d0 < NQF; ++d0) {
                    const int off = ATT_PESWZ(r32, (d0 - 8) * 2 + hi);
                    const bf16x8 b0 = *(const ATT_LAS bf16x8*)(ldsb + L_PE + off);
                    const bf16x8 b1 = *(const ATT_LAS bf16x8*)(ldsb + L_PE + off + 32 * 128);
                    p0 = __builtin_amdgcn_mfma_f32_32x32x16_bf16(b0, qr[d0], p0, 0, 0, 0);
                    p1 = __builtin_amdgcn_mfma_f32_32x32x16_bf16(b1, qr[d0], p1, 0, 0, 0);
                }
            }
            bf16x8 pa0, pa1, pa2, pa3;
            if (MODE == MODE_MLA && kb + KVBLK - 1 > qlo) {
                const float NEG = -__builtin_inff();
#pragma unroll
                for (int r = 0; r < 16; ++r) { const int key = kb + crow(r, hi); if (key > qpos) p0[r] = NEG; if (key + 32 > qpos) p1[r] = NEG; }
            }
            float pmax = p0[0];
#pragma unroll
            for (int r = 1; r < 16; ++r) pmax = fmaxf(pmax, p0[r]);
#pragma unroll
            for (int r = 0; r < 16; ++r) pmax = fmaxf(pmax, p1[r]);
            pmax = swap_max(pmax);
            const float mn = fmaxf(m_reg, pmax), alpha = __builtin_amdgcn_exp2f(m_reg - mn); m_reg = mn;
            float ps = 0.f;
#pragma unroll
            for (int r = 0; r < 16; ++r) { p0[r] = __builtin_amdgcn_exp2f(p0[r] - mn); ps += p0[r]; }
#pragma unroll
            for (int r = 0; r < 16; ++r) { p1[r] = __builtin_amdgcn_exp2f(p1[r] - mn); ps += p1[r]; }
            ps = swap_add(ps);
            l_reg = l_reg * alpha + ps;
            if (__any(alpha < 1.f)) {
#pragma unroll
                for (int d_ = 0; d_ < 4; ++d_) o[d_] = o[d_] * alpha;
            }
            pack_p(p0, p1, pa0, pa1, pa2, pa3);
            ATT_SBAR();
            pv_tile(o, vb0 + bo, pa0, pa1, pa2, pa3);
        }
        if (act && MODE == MODE_SB) {
            const bool needmask = (kb + KVBLK - 1 >= qlo);
            bf16x8 pa[4];
#pragma unroll
            for (int half = 1; half >= 0; --half) {
                f32x16 p = f32x16{};
#pragma unroll
                for (int d0 = 0; d0 < 8; ++d0) {
                    const int off = ATT_KSWZ(r32, ((d0 & 3) * 16 + hi * 8) * 2) + (d0 >> 2) * 128 + half * 32 * 256;
                    const bf16x8 b0 = *(const ATT_LAS bf16x8*)(ldsb + L_K + off);
                    p = __builtin_amdgcn_mfma_f32_32x32x16_bf16(b0, qr[d0], p, 0, 0, 0);
                }
                f32x16 L;
#pragma unroll
                for (int r = 0; r < 16; ++r) { const float z = p[r], az = fabsf(z); const float sp = fmaxf(z, 0.f) + __builtin_amdgcn_logf(1.f + __builtin_amdgcn_exp2f(-az)); L[r] = -sp; p[r] = z - sp; }
                if (needmask) {
#pragma unroll
                    for (int r = 0; r < 16; ++r) { const int key = kb + half * 32 + crow(r, hi); if (key >= qpos) L[r] = 0.f; }
                }
                float g[4], h[4];
#pragma unroll
                for (int i = 0; i < 4; ++i) g[i] = (L[4 * i] + L[4 * i + 1]) + (L[4 * i + 2] + L[4 * i + 3]);
#pragma unroll
                for (int i = 0; i < 4; ++i) h[i] = swap_other(g[i], hi);
                float os[4]; float run = Rrun;
#pragma unroll
                for (int i = 3; i >= 0; --i) { os[i] = run; run += g[i] + h[i]; }
#pragma unroll
                for (int i = 0; i < 4; ++i) {
                    float e = os[i] + (hi == 0 ? h[i] : 0.f);
#pragma unroll
                    for (int j = 3; j >= 0; --j) { const float lsg = p[4 * i + j]; p[4 * i + j] = __builtin_amdgcn_exp2f(lsg + e); e += L[4 * i + j]; }
                }
                if (needmask) {
#pragma unroll
                    for (int r = 0; r < 16; ++r) { const int key = kb + half * 32 + crow(r, hi); if (key >= qpos) p[r] = 0.f; }
                }
                Rrun = run;
#define ATT_PK4(P, B_, OUT) do { unsigned a0 = cvtpk(P[B_+0], P[B_+1]), a1 = cvtpk(P[B_+2], P[B_+3]);                          \
        unsigned b0 = cvtpk(P[B_+4], P[B_+5]), b1 = cvtpk(P[B_+6], P[B_+7]);                                             \
        auto r0 = __builtin_amdgcn_permlane32_swap(a0, b0, false, false); auto r1 = __builtin_amdgcn_permlane32_swap(a1, b1, false, false); \
        u32x4 w = {r0[0], r1[0], r0[1], r1[1]}; OUT = *reinterpret_cast<bf16x8*>(&w); } while (0)
                ATT_PK4(p, 0, pa[2 * half]); ATT_PK4(p, 8, pa[2 * half + 1]);
#undef ATT_PK4
            }
            ATT_SBAR();
            pv_tile(o, vb0 + bo, pa[0], pa[1], pa[2], pa[3]);
        }
        if (MODE == MODE_SB) { const int dn = (act && __all(Rrun < -152.0f)) ? 1 : 0; if (lane == 0) flags[(it & 1) * 8 + wid] = dn; }
        if (more) ATT_WRITE(bo ^ BUFB);
        __syncthreads();
        if (MODE == MODE_SB && more) { int alld = 1;
#pragma unroll
            for (int w = 0; w < 8; ++w) alld &= flags[(it & 1) * 8 + w];
            if (alld) break; }
    }
#undef ATT_LOAD
#undef ATT_WRITE
#undef ATT_TILE
    const float inv = (MODE != MODE_SB) ? 1.0f / l_reg : 1.0f;
    bf16_t* Ow = Ob + (size_t)(wid * QBLK + r32) * ostride + hi * 8;
#define ATT_PK4(P, B_, OUT) do { unsigned a0 = cvtpk(P[B_+0] * inv, P[B_+1] * inv), a1 = cvtpk(P[B_+2] * inv, P[B_+3] * inv);                          \
        unsigned b0 = cvtpk(P[B_+4] * inv, P[B_+5] * inv), b1 = cvtpk(P[B_+6] * inv, P[B_+7] * inv);                                             \
        auto r0 = __builtin_amdgcn_permlane32_swap(a0, b0, false, false); auto r1 = __builtin_amdgcn_permlane32_swap(a1, b1, false, false); \
        OUT = (u32x4){r0[0], r1[0], r0[1], r1[1]}; } while (0)
#pragma unroll
    for (int d0 = 0; d0 < 4; ++d0) { u32x4 f0, f1; ATT_PK4(o[d0], 0, f0); ATT_PK4(o[d0], 8, f1);
        *(u32x4*)(Ow + d0 * 32) = f0; *(u32x4*)(Ow + d0 * 32 + 16) = f1; }
#undef ATT_PK4
    __syncthreads();
}
}
constexpr int NWAVES = 8;
constexpr int BATCH = 8, SEQ = 2048, DM = 1024, T = BATCH * SEQ;
constexpr int MEMLEN = 256, TM = BATCH * MEMLEN;
constexpr int QLORA = 384, KVLORA = 256, ROPE = 64, NLAT = 704, NLATP = 768;
constexpr int HEADS = 8, NOPE = 128, DQK = 192, DV = 128;
constexpr int XH = 4, DFF = 4096;
constexpr float EPS = 1e-6f;
constexpr float LOG2E = 1.4426950408889634f;
constexpr float QSCALE_MLA = 0.07216878364870322f * LOG2E;
constexpr float QSCALE_128 = 0.08838834764831845f * LOG2E;

constexpr size_t MiB = 1u << 20;
constexpr size_t WS_CTL = 0, CTL_ZERO_BYTES = 64 * 1024;
constexpr size_t WS_RS = 1 * MiB / 2;
constexpr size_t WS_WDKV = 1 * MiB;
constexpr size_t WS_WUQ = WS_WDKV + (size_t)NLATP * DM * 2;
constexpr size_t WS_WUKV = WS_WUQ + (size_t)1536 * 384 * 2;
constexpr size_t WS_WO0 = WS_WUKV + (size_t)2048 * 256 * 2;
constexpr size_t WS_WXQ = WS_WO0 + (size_t)DM * DM * 2;
constexpr size_t WS_WXKV = WS_WXQ + 2 * (size_t)512 * DM * 2;
constexpr size_t WS_WXO = WS_WXKV + 2 * (size_t)DM * DM * 2;
constexpr size_t WS_WIN = WS_WXO + 2 * (size_t)DM * 512 * 2;
constexpr size_t WS_WOUT = WS_WIN + 2 * (size_t)DFF * DM * 2;
constexpr size_t WS_WQKV = WS_WOUT + 2 * (size_t)DM * DFF * 2;
constexpr size_t WS_WO1 = WS_WQKV + (size_t)3072 * DM * 2;
constexpr size_t WS_WEND = WS_WO1 + (size_t)DM * DM * 2;
static_assert(WS_WEND <= 56 * MiB, "weights");
constexpr size_t WS_HB = 56 * MiB;
constexpr size_t WS_KVX = 88 * MiB;
constexpr size_t WS_CS = 96 * MiB;
constexpr size_t WS_KPE = 100 * MiB;
constexpr size_t WS_MEMB = 102 * MiB;
constexpr size_t WS_SSQ = 106 * MiB;
constexpr size_t WS_X = 107 * MiB;
constexpr size_t WS_LAT = WS_X;
constexpr size_t WS_OB = WS_X;
constexpr size_t WS_Q = WS_X + 32 * MiB;
constexpr size_t WS_KN = WS_X + 80 * MiB;
constexpr size_t WS_V = WS_X + 112 * MiB;
constexpr size_t WS_K1 = WS_X + 64 * MiB, WS_V1 = WS_X + 96 * MiB;
constexpr size_t WS_QX = WS_X, WS_OX = WS_X + 16 * MiB;
constexpr size_t WS_U = WS_X;
constexpr size_t WS_END = WS_X + 144 * MiB;
static_assert(WS_END <= 256 * MiB, "d_ws map");
constexpr int RS_X = 0, RS_Q = T, RS_KV = 2 * T, RS_H = 3 * T, RS_MEM = 4 * T;
constexpr int CW_BAR = 1024;

constexpr int RING_OFF = 0, RING_BYTES = 131072;
constexpr int LDSCTL_OFF = RING_BYTES, MISC_OFF = LDSCTL_OFF + 320;
constexpr int LDS_BYTES = 147456;

#define GAS __attribute__((address_space(1)))
#define LAS __attribute__((address_space(3)))
typedef unsigned short bf16;
typedef unsigned v4u __attribute__((ext_vector_type(4)));
typedef float f32x4 __attribute__((ext_vector_type(4)));
typedef GAS unsigned gu32;
#define RLX_AGENT __ATOMIC_RELAXED, __HIP_MEMORY_SCOPE_AGENT
#define LDS_WAIT() asm volatile("s_waitcnt lgkmcnt(0)" ::: "memory")
#define VM_WAIT() asm volatile("s_waitcnt vmcnt(0)" ::: "memory")
__device__ __forceinline__ unsigned f2bf(float f) { unsigned u = __builtin_bit_cast(unsigned, f); return (u + 0x7fffu + ((u >> 16) & 1u)) >> 16; }
__device__ __forceinline__ unsigned pk2(float lo, float hi) { return f2bf(lo) | (f2bf(hi) << 16); }
__device__ __forceinline__ float bf2f(unsigned short b) { return __builtin_bit_cast(float, (unsigned)b << 16); }
__device__ __forceinline__ void store8(bf16* p, f32x4 a, f32x4 b) { v4u w; w.x = pg8::cvt_pk_bf16(a[0], a[1]); w.y = pg8::cvt_pk_bf16(a[2], a[3]); w.z = pg8::cvt_pk_bf16(b[0], b[1]); w.w = pg8::cvt_pk_bf16(b[2], b[3]); *(v4u*)p = w; }

#define XB_TMO      128
#define XB_XCNT(j)  (256  + 64 * (j))
#define XB_XSUB(j)  (1280 + 64 * (j))
#define XB_XGEN(j)  (2304 + 64 * (j))
#define XB_TOP      3328
#define XB_TOPGEN   3392
#define XCD_BAR_WORDS 3456
#define XB_SPIN_CAP (1u << 18)
__device__ __forceinline__ unsigned xb_ld(unsigned* p)              { return __hip_atomic_load(p, __ATOMIC_RELAXED, __HIP_MEMORY_SCOPE_AGENT); }
__device__ __forceinline__ unsigned xb_add(unsigned* p, unsigned v) { return __hip_atomic_fetch_add(p, v, __ATOMIC_RELAXED, __HIP_MEMORY_SCOPE_AGENT); }
__device__ __forceinline__ unsigned xb_xcc_id() { return (unsigned)__builtin_amdgcn_s_getreg((3 << 11) | 20) & 0xFu; }
#define XB_SPIN(cond, bar) do { unsigned _sp = 0; while (cond) { __builtin_amdgcn_s_sleep(1); \
    if ((++_sp & 255u) == 0u) { if (xb_ld(&(bar)[XB_TMO])) break; if (_sp > XB_SPIN_CAP) { atomicAdd(&(bar)[XB_TMO], 1u); break; } } } } while (0)
struct XcdBarrier { unsigned* bar; unsigned x; volatile LAS unsigned* st; };
__device__ __forceinline__ XcdBarrier xcd_barrier_post(unsigned* bar, volatile LAS unsigned* st) {
    XcdBarrier b; b.bar = bar; b.x = xb_xcc_id(); b.st = st;
    if (threadIdx.x == 0) (void)xb_add(&bar[XB_XCNT(b.x)], 1u);
    return b;
}
__device__ __forceinline__ void xcd_barrier_complete(unsigned* bar, unsigned x, unsigned& nloc, unsigned& nx) {
    const unsigned G = gridDim.x * gridDim.y * gridDim.z;
    unsigned sum, cnt, mine, sp = 0u;
    for (;;) {
        sum = 0u; cnt = 0u; mine = 0u;
#pragma unroll
        for (unsigned j = 0; j < 16; ++j) { const unsigned c = xb_ld(&bar[XB_XCNT(j)]); sum += c; cnt += (c > 0u) ? 1u : 0u; mine = (j == x) ? c : mine; }
        if (sum == G) break;
        __builtin_amdgcn_s_sleep(1);
        if ((++sp & 255u) == 0u) { if (xb_ld(&bar[XB_TMO])) break; if (sp > XB_SPIN_CAP) { atomicAdd(&bar[XB_TMO], 1u); break; } }
    }
    nloc = mine > 0u ? mine : 1u; nx = cnt > 0u ? cnt : 1u;
}
__device__ __forceinline__ void xcd_barrier(const XcdBarrier& b) {
    asm volatile("s_waitcnt vmcnt(0)" ::: "memory");
    __syncthreads();
    if (threadIdx.x == 0) {
        unsigned* bar = b.bar;
        __builtin_amdgcn_s_waitcnt(0);
        unsigned nloc = b.st[0], nx = b.st[1];
        if (nloc == 0u) { xcd_barrier_complete(bar, b.x, nloc, nx); b.st[0] = nloc; b.st[1] = nx; }
        const unsigned old = xb_add(&bar[XB_XSUB(b.x)], 1u);
        const unsigned gen = old / nloc;
        if (old + 1u == (gen + 1u) * nloc) {
            __builtin_amdgcn_fence(__ATOMIC_RELEASE, "agent");
            asm volatile("s_waitcnt vmcnt(0)" ::: "memory");
            const unsigned og = xb_add(&bar[XB_TOP], 1u);
            const unsigned tg = og / nx;
            if (og + 1u == (tg + 1u) * nx) xb_add(&bar[XB_TOPGEN], 1u);
            else XB_SPIN(xb_ld(&bar[XB_TOPGEN]) == tg, bar);
            __builtin_amdgcn_fence(__ATOMIC_ACQUIRE, "agent");
            xb_add(&bar[XB_XGEN(b.x)], 1u);
            asm volatile("s_waitcnt vmcnt(0)" ::: "memory");
        } else {
            XB_SPIN(xb_ld(&bar[XB_XGEN(b.x)]) == gen, bar);
            __builtin_amdgcn_fence(__ATOMIC_ACQUIRE, "agent");
            asm volatile("s_waitcnt vmcnt(0)" ::: "memory");
        }
    }
    __syncthreads();
}

__device__ __forceinline__ float wave_sum(float v) {
#pragma unroll
    for (int o = 1; o < 64; o <<= 1) v += __shfl_xor(v, o);
    return v;
}
__device__ __forceinline__ void transpose_item(const float* W, int K, int N, bf16* WT, const float* gain, int permq, LAS float* scr, int item, int lane) {
    const int nblk = N / 32, kb = item / nblk, nb = item - kb * nblk, k0 = 64 * kb, n0 = 32 * nb;
    const int lr = lane >> 3, lc = (lane & 7) * 4;
    f32x4 v[8];
#pragma unroll
    for (int i = 0; i < 8; ++i) v[i] = *(const GAS f32x4*)(W + (size_t)(k0 + i * 8 + lr) * N + n0 + lc);
    if (gain) {
#pragma unroll
        for (int i = 0; i < 8; ++i) v[i] = v[i] * gain[k0 + i * 8 + lr];
    }
#pragma unroll
    for (int i = 0; i < 8; ++i) { LAS float* d = scr + (i * 8 + lr) * 33 + lc; d[0] = v[i][0]; d[1] = v[i][1]; d[2] = v[i][2]; d[3] = v[i][3]; }
    LDS_WAIT(); asm volatile("" ::: "memory");
    const int c = lane & 7;
#pragma unroll
    for (int j = 0; j < 4; ++j) { const int n = (lane >> 3) + 8 * j; const LAS float* sp = scr + (8 * c) * 33 + n;
        v4u o; o.x = pk2(sp[0 * 33], sp[1 * 33]); o.y = pk2(sp[2 * 33], sp[3 * 33]); o.z = pk2(sp[4 * 33], sp[5 * 33]); o.w = pk2(sp[6 * 33], sp[7 * 33]);
        int drow = n0 + n;
        if (permq) { const int h = drow / DQK, d = drow - h * DQK; if (d >= NOPE) { const int cc = d - NOPE; drow = h * DQK + NOPE + 2 * (cc & 31) + (cc >> 5); } }
        *(GAS v4u*)(WT + (size_t)drow * K + k0 + 8 * c) = o; }
    LDS_WAIT(); asm volatile("" ::: "memory");
}
__device__ __forceinline__ void rowstat_1024(const float* xrow, bf16* orow, float* rs, int lane) {
    const GAS f32x4* xr = (const GAS f32x4*)xrow + lane;
    f32x4 v[4]; float s = 0.f;
#pragma unroll
    for (int j = 0; j < 4; ++j) { v[j] = xr[64 * j]; s += (v[j].x * v[j].x + v[j].y * v[j].y) + (v[j].z * v[j].z + v[j].w * v[j].w); }
    const float r = 1.0f / sqrtf(wave_sum(s) * (1.0f / 1024.0f) + EPS);
    if (lane == 0) *rs = r;
    GAS unsigned long long* o8 = (GAS unsigned long long*)orow + lane;
#pragma unroll
    for (int j = 0; j < 4; ++j) o8[64 * j] = (unsigned long long)pk2(v[j].x, v[j].y) | ((unsigned long long)pk2(v[j].z, v[j].w) << 32);
}

__device__ __forceinline__ float rs_from_partials(const float* ssqp, int row) {
    const f32x4* p = (const f32x4*)(ssqp + (size_t)row * 16); const f32x4 a = p[0], b = p[1], c = p[2], d = p[3];
    const float s = (((a[0] + a[1]) + (a[2] + a[3])) + ((b[0] + b[1]) + (b[2] + b[3]))) + (((c[0] + c[1]) + (c[2] + c[3])) + ((d[0] + d[1]) + (d[2] + d[3])));
    return 1.0f / sqrtf(s * (1.0f / 1024.0f) + EPS); }
struct FLat { bf16* lat; const float* rs;
    __device__ __forceinline__ float rowscale(int row) const { return rs[row]; }
    __device__ __forceinline__ void operator()(int row, int col, f32x4 v0, f32x4 v1) const { store8(lat + (size_t)row * NLATP + col, v0, v1); } };
struct FMemKV { bf16* kx; bf16* vx; const float* rs;
    __device__ __forceinline__ float rowscale(int row) const { return rs[row]; }
    __device__ __forceinline__ void operator()(int row, int col, f32x4 v0, f32x4 v1) const {
        const int b = row >> 8, m = row & 255, t = col >> 9, c = col & 511, h = c >> 7, d = c & 127;
        bf16* p = (t ? vx : kx) + ((size_t)((b * XH + h) * MEMLEN + m)) * 128 + d; store8(p, v0, v1); } };
struct FQ0 { bf16* q; const float* rs; const float2* cs;
    __device__ __forceinline__ float rowscale(int row) const { return rs[row] * QSCALE_MLA; }
    __device__ __forceinline__ void operator()(int row, int col, f32x4 v0, f32x4 v1) const {
        const int h = col / DQK, d = col - h * DQK;
        if (d >= NOPE) { const float2* c = cs + (size_t)row * 32 + ((d - NOPE) >> 1);
            const float2 c0 = c[0], c1 = c[1], c2 = c[2], c3 = c[3];
            const f32x4 a = v0, b = v1;
            v0[0] = a[0] * c0.x - a[1] * c0.y; v0[1] = a[0] * c0.y + a[1] * c0.x; v0[2] = a[2] * c1.x - a[3] * c1.y; v0[3] = a[2] * c1.y + a[3] * c1.x;
            v1[0] = b[0] * c2.x - b[1] * c2.y; v1[1] = b[0] * c2.y + b[1] * c2.x; v1[2] = b[2] * c3.x - b[3] * c3.y; v1[3] = b[2] * c3.y + b[3] * c3.x; }
        const int bb = row >> 11, si = row & 2047;
        store8(q + ((size_t)((bb * HEADS + h) * SEQ + si)) * DQK + d, v0, v1); } };
struct FKV0 { bf16* kn; bf16* v; const float* rs;
    __device__ __forceinline__ float rowscale(int row) const { return rs[row]; }
    __device__ __forceinline__ void operator()(int row, int col, f32x4 v0, f32x4 v1) const {
        const int h = col >> 8, j = col & 255, bb = row >> 11, si = row & 2047;
        bf16* p = (j < 128 ? kn : v) + ((size_t)((bb * HEADS + h) * SEQ + si)) * 128 + (j & 127); store8(p, v0, v1); } };
struct FXQ { bf16* qx; const float* ssqp;
    __device__ __forceinline__ float rowscale(int row) const { return rs_from_partials(ssqp, row) * QSCALE_128; }
    __device__ __forceinline__ void operator()(int row, int col, f32x4 v0, f32x4 v1) const {
        const int h = col >> 7, d = col & 127, bb = row >> 11, si = row & 2047;
        store8(qx + ((size_t)((bb * XH + h) * SEQ + si)) * 128 + d, v0, v1); } };
struct FUp { bf16* u; const float* ssqp;
    __device__ __forceinline__ float rowscale(int row) const { return rs_from_partials(ssqp, row); }
    __device__ __forceinline__ void operator()(int row, int col, f32x4 v0, f32x4 v1) const {
#pragma unroll
        for (int j = 0; j < 4; ++j) { const float a = fmaxf(v0[j], 0.f), b = fmaxf(v1[j], 0.f); v0[j] = a * a; v1[j] = b * b; }
        store8(u + (size_t)row * DFF + col, v0, v1); } };
struct FQKV1 { bf16* q; bf16* k; bf16* v; const float* ssqp;
    __device__ __forceinline__ float rowscale(int row) const { return rs_from_partials(ssqp, row); }
    __device__ __forceinline__ void operator()(int row, int col, f32x4 v0, f32x4 v1) const { const int t = col >> 10, c = col & 1023, h = c >> 7, d = c & 127, bb = row >> 11, si = row & 2047;
        const float s = (t == 0 ? QSCALE_128 : 1.0f);
        bf16* p = q + (size_t)t * (32u << 19) + ((size_t)((bb * HEADS + h) * SEQ + si)) * 128 + d; store8(p, v0 * s, v1 * s); } };

struct Args { const float* in[21]; float* out; unsigned char* ws; int ph_lo, ph_hi; };
static_assert(sizeof(Args) == 21 * 8 + 8 + 8 + 8, "Args has no padding");

enum { PH_PRO = 0, PH_DKV, PH_LATSTAT, PH_UQKV, PH_ATT0, PH_WO0, PH_XA0, PH_XO0, PH_UP0, PH_DN0,
       PH_QKV1, PH_ATT1, PH_WO1, PH_XA1, PH_XO1, PH_UP1, PH_DN1, PH_FINAL, NPH };

__global__ void __launch_bounds__(NWAVES * 64, 2) mk_fwd(Args args) {
    extern __shared__ __attribute__((aligned(16))) unsigned char lds_raw[];
    LAS unsigned char* lds = (LAS unsigned char*)lds_raw;
    volatile LAS unsigned* MISC = (volatile LAS unsigned*)(lds + MISC_OFF);
    const int tid = threadIdx.x, lane = tid & 63, wave = __builtin_amdgcn_readfirstlane(tid >> 6);
    const int G = gridDim.x; int vcu; { const int bx = blockIdx.x; vcu = (G % 8 == 0) ? (bx % 8) * (G / 8) + bx / 8 : bx; }
    unsigned char* ws = args.ws;
    gu32* ctl = (gu32*)(ws + WS_CTL);
    for (int u = tid; u < (LDS_BYTES - LDSCTL_OFF) / 4; u += NWAVES * 64) ((LAS unsigned*)(lds + LDSCTL_OFF))[u] = 0u;
    __syncthreads();
    const int lo = args.ph_lo, hi = args.ph_hi;
    const bool one_phase = (hi - lo == 1);
    XcdBarrier bar; bar.bar = (unsigned*)(ctl + CW_BAR); bar.x = 0; bar.st = nullptr;
    if (!one_phase) bar = xcd_barrier_post((unsigned*)(ctl + CW_BAR), MISC + 8);
#define IN(k) (lo <= (k) && (k) < hi)
#ifndef PROBE_MASK
#define PROBE_MASK 0u
#endif
#ifndef PROBE_DBLBAR
#define PROBE_DBLBAR 0
#endif
    unsigned long long t_prev = PROBE_MASK ? __builtin_amdgcn_s_memrealtime() : 0ull, t_acc = 0ull;
#define SEAM(k) do { if (IN(k) && IN((k) + 1)) { xcd_barrier(bar); if (PROBE_DBLBAR) xcd_barrier(bar); } \
    if (PROBE_MASK) { const unsigned long long t_now = __builtin_amdgcn_s_memrealtime(); if ((PROBE_MASK >> (k)) & 1u) t_acc += t_now - t_prev; t_prev = t_now; } } while (0)

    const float* x = args.in[0]; const float* mem = args.in[1]; const int* positions = (const int*)args.in[2];
    const float* norm_mix = args.in[3]; const float* norm_cross = args.in[4]; const float* norm_mem = args.in[5]; const float* norm_mlp = args.in[6]; const float* norm_final = args.in[7];
#define WSL() ({ unsigned char* _p = ws; asm volatile("" : "+s"(_p)); _p; })
#define rsb ((float*)(WSL() + WS_RS))
#define HB ((bf16*)(WSL() + WS_HB))
#define MEMB ((bf16*)(WSL() + WS_MEMB))
#define LAT ((bf16*)(WSL() + WS_LAT))
#define CS ((float2*)(WSL() + WS_CS))
#define KPE ((bf16*)(WSL() + WS_KPE))
#define OB ((bf16*)(WSL() + WS_OB))
#define QB_ ((bf16*)(WSL() + WS_Q))
#define KN ((bf16*)(WSL() + WS_KN))
#define VV ((bf16*)(WSL() + WS_V))
#define K1 ((bf16*)(WSL() + WS_K1))
#define V1 ((bf16*)(WSL() + WS_V1))
#define QX ((bf16*)(WSL() + WS_QX))
#define OX ((bf16*)(WSL() + WS_OX))
#define U ((bf16*)(WSL() + WS_U))
#define SSQP ((float*)(WSL() + WS_SSQ))
    float* hres = args.out;
    const int gw = vcu * NWAVES + wave, NGW = G * NWAVES;

    if (IN(PH_PRO)) {
        LAS float* scr = (LAS float*)(lds + RING_OFF + wave * 16384);
        struct Job { const float* W; int K, N; size_t dst; const float* gain; int permq; };
        constexpr int C0 = 352, C1 = C0 + 288, C2 = C1 + 256, C3 = C2 + 512, C4 = C3 + 256, C5 = C4 + 256, C6 = C5 + 512, C7 = C6 + 512, C8 = C7 + 256, C9 = C8 + 256,
                      C10 = C9 + 2048, C11 = C10 + 2048, C12 = C11 + 2048, C13 = C12 + 2048, C14 = C13 + 1536, C15 = C14 + 512;
        for (int fit = gw; fit < C15; fit += NGW) {
            Job jb; int it;
            if (fit < C0) { it = fit; jb = {args.in[8], DM, NLAT, WS_WDKV, norm_mix, 0}; }
            else if (fit < C1) { it = fit - C0; jb = {args.in[11], QLORA, 1536, WS_WUQ, args.in[9], 1}; }
            else if (fit < C2) { it = fit - C1; jb = {args.in[12], KVLORA, 2048, WS_WUKV, args.in[10], 0}; }
            else if (fit < C3) { it = fit - C2; jb = {args.in[13], DM, DM, WS_WO0, nullptr, 0}; }
            else if (fit < C4) { it = fit - C3; jb = {args.in[16], DM, 512, WS_WXQ, norm_cross, 0}; }
            else if (fit < C5) { it = fit - C4; jb = {args.in[16] + (size_t)DM * 512, DM, 512, WS_WXQ + (size_t)512 * DM * 2, norm_cross + DM, 0}; }
            else if (fit < C6) { it = fit - C5; jb = {args.in[17], DM, DM, WS_WXKV, norm_mem, 0}; }
            else if (fit < C7) { it = fit - C6; jb = {args.in[17] + (size_t)DM * DM, DM, DM, WS_WXKV + (size_t)DM * DM * 2, norm_mem + DM, 0}; }
            else if (fit < C8) { it = fit - C7; jb = {args.in[18], 512, DM, WS_WXO, nullptr, 0}; }
            else if (fit < C9) { it = fit - C8; jb = {args.in[18] + (size_t)512 * DM, 512, DM, WS_WXO + (size_t)DM * 512 * 2, nullptr, 0}; }
            else if (fit < C10) { it = fit - C9; jb = {args.in[19], DM, DFF, WS_WIN, norm_mlp, 0}; }
            else if (fit < C11) { it = fit - C10; jb = {args.in[19] + (size_t)DM * DFF, DM, DFF, WS_WIN + (size_t)DFF * DM * 2, norm_mlp + DM, 0}; }
            else if (fit < C12) { it = fit - C11; jb = {args.in[20], DFF, DM, WS_WOUT, nullptr, 0}; }
            else if (fit < C13) { it = fit - C12; jb = {args.in[20] + (size_t)DFF * DM, DFF, DM, WS_WOUT + (size_t)DM * DFF * 2, nullptr, 0}; }
            else if (fit < C14) { it = fit - C13; jb = {args.in[14], DM, 3072, WS_WQKV, norm_mix + DM, 0}; }
            else { it = fit - C14; jb = {args.in[15], DM, DM, WS_WO1, nullptr, 0}; }
            transpose_item(jb.W, jb.K, jb.N, (bf16*)(WSL() + jb.dst), jb.gain, jb.permq, scr, it, lane);
        }
        { GAS v4u* z = (GAS v4u*)(WSL() + WS_WDKV + (size_t)NLAT * DM * 2); const int n16 = (NLATP - NLAT) * DM * 2 / 16;
            for (int i = blockIdx.x * (NWAVES * 64) + tid; i < n16; i += G * NWAVES * 64) z[i] = (v4u){0u, 0u, 0u, 0u}; }
        for (int i = blockIdx.x * (NWAVES * 64) + tid; i < T * 32; i += G * NWAVES * 64) {
            const int tok = i >> 5, f = i & 31;
            const float inv = powf(10000.0f, -(float)(2 * f) / 64.0f);
            const float ang = (float)positions[tok] * inv;
            CS[i] = make_float2(cosf(ang), sinf(ang));
        }
        for (int m = gw; m < T; m += NGW) rowstat_1024(x + (size_t)m * DM, HB + (size_t)m * DM, rsb + RS_X + m, lane);
        for (int m = gw; m < TM; m += NGW) rowstat_1024(mem + (size_t)m * DM, MEMB + (size_t)m * DM, rsb + RS_MEM + m, lane);
    }
    SEAM(PH_PRO);

    if (IN(PH_DKV)) {
        { pg8::Gemm g{HB, (const bf16*)(WSL() + WS_WDKV), T, NLATP, DM, DM}; pg8::StaticOrder S; S.init(T, NLATP, G, (int)blockIdx.x);
          pg8::EpiB<FLat> E{{LAT, rsb + RS_X}}; pg8::gemm_phase<pg8::EpiB<FLat>, pg8::StaticOrder, true>(lds + RING_OFF, g, S, E); }
        for (int l = 0; l < 2; ++l) {
          pg8::Gemm g{MEMB, (const bf16*)(WSL() + WS_WXKV + (size_t)l * DM * DM * 2), TM, DM, DM, DM}; pg8::StaticOrder S; S.init(TM, DM, G, (int)((blockIdx.x + 64 - 32 * l) % G));
          bf16* kx = (bf16*)(WSL() + WS_KVX + (size_t)l * 4 * MiB);
          pg8::EpiB<FMemKV> E{{kx, kx + (size_t)TM * 512, rsb + RS_MEM}}; pg8::gemm_phase<pg8::EpiB<FMemKV>, pg8::StaticOrder, true>(lds + RING_OFF, g, S, E); }
    }
    SEAM(PH_DKV);

    if (IN(PH_LATSTAT)) {
        for (int m = gw; m < T; m += NGW) {
            const bf16* lr = LAT + (size_t)m * NLATP; float sq = 0.f, skv = 0.f;
#pragma unroll
            for (int j = 0; j < 3; ++j) { const int c = j * 64 + lane; const unsigned long long w = *(const GAS unsigned long long*)(lr + 4 * c);
                const float a0 = bf2f((unsigned short)w), a1 = bf2f((unsigned short)(w >> 16)), a2 = bf2f((unsigned short)(w >> 32)), a3 = bf2f((unsigned short)(w >> 48));
                const float s = (a0 * a0 + a1 * a1) + (a2 * a2 + a3 * a3);
                if (c < 96) sq += s; else if (c < 160) skv += s; }
            sq = wave_sum(sq); skv = wave_sum(skv);
            if (lane == 0) { rsb[RS_Q + m] = 1.0f / sqrtf(sq * (1.0f / QLORA) + EPS); rsb[RS_KV + m] = 1.0f / sqrtf(skv * (1.0f / KVLORA) + EPS); }
            if (lane < 32) { const float x1 = bf2f(lr[640 + lane]), x2 = bf2f(lr[672 + lane]); const float2 c = CS[(size_t)m * 32 + lane];
                *(GAS unsigned*)(KPE + (size_t)m * 64 + 2 * lane) = pk2(x1 * c.x - x2 * c.y, x1 * c.y + x2 * c.x); }
        }
    }
    SEAM(PH_LATSTAT);

    if (IN(PH_UQKV)) {
        { pg8::Gemm g{LAT, (const bf16*)(WSL() + WS_WUQ), T, 1536, QLORA, NLATP}; pg8::StaticOrder S; S.init(T, 1536, G, (int)blockIdx.x);
          pg8::EpiB<FQ0> E{{QB_, rsb + RS_Q, CS}}; pg8::gemm_phase<pg8::EpiB<FQ0>, pg8::StaticOrder, true>(lds + RING_OFF, g, S, E); }
        { pg8::Gemm g{LAT + QLORA, (const bf16*)(WSL() + WS_WUKV), T, 2048, KVLORA, NLATP}; pg8::StaticOrder S; S.init(T, 2048, G, (int)((blockIdx.x + 128) % G));
          pg8::EpiB<FKV0> E{{KN, VV, rsb + RS_KV}}; pg8::gemm_phase<pg8::EpiB<FKV0>, pg8::StaticOrder, true>(lds + RING_OFF, g, S, E); }
    }
    SEAM(PH_UQKV);

    if (IN(PH_ATT0)) {
        for (int pu = vcu; pu < 256; pu += G) { const int bh = pu >> 2, s = pu & 3, b = bh >> 3, h = bh & 7;
            for (int pass = 0; pass < 2; ++pass) { const int qb = pass ? s : 7 - s;
                att::attn_unit<att::MODE_MLA>(lds + RING_OFF, QB_ + ((size_t)bh * SEQ + qb * 256) * DQK, KN + (size_t)bh * SEQ * 128, KPE + (size_t)b * SEQ * 64, VV + (size_t)bh * SEQ * 128,
                    OB + ((size_t)b * SEQ + qb * 256) * DM + h * 128, DM, qb * 256, 0); } }
    }
    SEAM(PH_ATT0);

    for (int layer = 0; layer < 2; ++layer) {
        const int PB = layer ? PH_WO1 : PH_WO0;
        if (layer == 1) {
            if (IN(PH_QKV1)) { pg8::Gemm g{HB, (const bf16*)(WSL() + WS_WQKV), T, 3072, DM, DM}; pg8::StaticOrder S; S.init(T, 3072, G, (int)blockIdx.x);
                pg8::EpiB<FQKV1> E{{QB_, K1, V1, SSQP}}; pg8::gemm_phase<pg8::EpiB<FQKV1>, pg8::StaticOrder, true>(lds + RING_OFF, g, S, E); }
            SEAM(PH_QKV1);
            if (IN(PH_ATT1)) {
                for (int u = vcu; u < 512; u += G) { const int bh = u >> 3, qb = u & 7, b = bh >> 3, h = bh & 7;
                    att::attn_unit<att::MODE_SB>(lds + RING_OFF, QB_ + ((size_t)bh * SEQ + qb * 256) * 128, K1 + (size_t)bh * SEQ * 128, nullptr, V1 + (size_t)bh * SEQ * 128,
                        OB + ((size_t)b * SEQ + qb * 256) * DM + h * 128, DM, qb * 256, 0); }
            }
            SEAM(PH_ATT1);
        }
        if (IN(PB)) { pg8::Gemm g{OB, (const bf16*)(WSL() + (layer ? WS_WO1 : WS_WO0)), T, DM, DM, DM}; pg8::StaticOrder S; S.init(T, DM, G, (int)blockIdx.x);
            if (layer == 0) { pg8::EpiResN<true> E{x, HB, SSQP}; pg8::gemm_phase<pg8::EpiResN<true>, pg8::StaticOrder, true>(lds + RING_OFF, g, S, E); }
            else { pg8::EpiResN<false> E{nullptr, HB, SSQP}; pg8::gemm_phase<pg8::EpiResN<false>, pg8::StaticOrder, true>(lds + RING_OFF, g, S, E); } }
        SEAM(PB);
        if (IN(PB + 1)) { const bf16* kx = (const bf16*)(WSL() + WS_KVX + (size_t)layer * 4 * MiB); const bf16* vx = kx + (size_t)TM * 512;
            const bf16* wxq = (const bf16*)(WSL() + WS_WXQ + (size_t)layer * 512 * DM * 2);
            for (int u = vcu; u < 256; u += G) { const int bh = u >> 3, qb = u & 7, b = bh >> 2, h = bh & 3; const size_t row0 = (size_t)b * SEQ + qb * 256;
                att::attn_unit<att::MODE_CROSS, true>(lds + RING_OFF, nullptr, kx + (size_t)bh * MEMLEN * 128, nullptr, vx + (size_t)bh * MEMLEN * 128,
                    OX + row0 * 512 + h * 128, 512, 0, MEMLEN, HB + row0 * DM, wxq + (size_t)h * 128 * DM, SSQP + row0 * 16, QSCALE_128); } }
        SEAM(PB + 1);
        if (IN(PB + 2)) { pg8::Gemm g{OX, (const bf16*)(WSL() + WS_WXO + (size_t)layer * DM * 512 * 2), T, DM, 512, 512}; pg8::StaticOrder S; S.init(T, DM, G, (int)blockIdx.x);
            pg8::EpiResN<false> E{nullptr, HB, SSQP}; pg8::gemm_phase<pg8::EpiResN<false>, pg8::StaticOrder, true>(lds + RING_OFF, g, S, E); }
        SEAM(PB + 2);
        if (IN(PB + 3)) { pg8::Gemm g{HB, (const bf16*)(WSL() + WS_WIN + (size_t)layer * DFF * DM * 2), T, DFF, DM, DM}; pg8::StaticOrder S; S.init(T, DFF, G, (int)blockIdx.x);
            pg8::EpiB<FUp> E{{U, SSQP}}; pg8::gemm_phase<pg8::EpiB<FUp>, pg8::StaticOrder, true>(lds + RING_OFF, g, S, E); }
        SEAM(PB + 3);
        if (IN(PB + 4)) { pg8::Gemm g{U, (const bf16*)(WSL() + WS_WOUT + (size_t)layer * DM * DFF * 2), T, DM, DFF, DFF}; pg8::StaticOrder S; S.init(T, DM, G, (int)blockIdx.x);
            pg8::EpiResN<false> E{nullptr, HB, SSQP}; pg8::gemm_phase<pg8::EpiResN<false>, pg8::StaticOrder, true>(lds + RING_OFF, g, S, E); }
        SEAM(PB + 4);
        if (layer == 1) {
            if (IN(PH_FINAL)) {
                for (int m = gw; m < T; m += NGW) {
                    const GAS v4u* hr = (const GAS v4u*)(HB + (size_t)m * DM) + lane;
                    GAS f32x4* orow = (GAS f32x4*)(hres + (size_t)m * DM); const GAS f32x4* gr = (const GAS f32x4*)norm_final;
                    f32x4 va[2], vb[2]; float s = 0.f;
#pragma unroll
                    for (int j = 0; j < 2; ++j) { const v4u w = hr[64 * j];
                        va[j] = (f32x4){__builtin_bit_cast(float, w.x << 16), __builtin_bit_cast(float, w.x & 0xffff0000u), __builtin_bit_cast(float, w.y << 16), __builtin_bit_cast(float, w.y & 0xffff0000u)};
                        vb[j] = (f32x4){__builtin_bit_cast(float, w.z << 16), __builtin_bit_cast(float, w.z & 0xffff0000u), __builtin_bit_cast(float, w.w << 16), __builtin_bit_cast(float, w.w & 0xffff0000u)};
                        s += ((va[j].x * va[j].x + va[j].y * va[j].y) + (va[j].z * va[j].z + va[j].w * va[j].w)) + ((vb[j].x * vb[j].x + vb[j].y * vb[j].y) + (vb[j].z * vb[j].z + vb[j].w * vb[j].w)); }
                    const float r = 1.0f / sqrtf(wave_sum(s) * (1.0f / 1024.0f) + EPS);
#pragma unroll
                    for (int j = 0; j < 2; ++j) { const int c4 = 2 * (lane + 64 * j); orow[c4] = va[j] * r * gr[c4]; orow[c4 + 1] = vb[j] * r * gr[c4 + 1]; }
                }
            }
        }
    }
    if (PROBE_MASK) { const unsigned long long t_now = __builtin_amdgcn_s_memrealtime(); if ((PROBE_MASK >> (NPH - 1)) & 1u) t_acc += t_now - t_prev;
        if (blockIdx.x == 0 && tid == 0) { while (__builtin_amdgcn_s_memrealtime() - t_now < 4ull * t_acc) __builtin_amdgcn_s_sleep(32); } }
#undef IN
#undef SEAM
}

#ifndef MK_N_LAUNCHES
#define MK_N_LAUNCHES 1
#endif
extern "C" void kernel_launch(void* const* d_in, const int* in_sizes, int n_in, void* d_out, int out_size, void* d_ws, size_t ws_size, hipStream_t stream) {
    static int grid = 0;
    if (grid == 0) {
        if (n_in != 21 || in_sizes[0] != T * DM || out_size != T * DM || ws_size < WS_END) { fprintf(stderr, "kernel_launch: unexpected shapes (n_in %d, in0 %d, out %d, ws %zu)\n", n_in, n_in > 0 ? in_sizes[0] : -1, out_size, ws_size); grid = -1; return; }
        int dev = 0, cus = 0, per_cu = 0;
        if (hipGetDevice(&dev) != hipSuccess || hipDeviceGetAttribute(&cus, hipDeviceAttributeMultiprocessorCount, dev) != hipSuccess) { grid = -1; return; }
        if (hipFuncSetAttribute((const void*)mk_fwd, hipFuncAttributeMaxDynamicSharedMemorySize, LDS_BYTES) != hipSuccess) { fprintf(stderr, "kernel_launch: hipFuncSetAttribute failed\n"); grid = -1; return; }
        if (hipOccupancyMaxActiveBlocksPerMultiprocessor(&per_cu, (const void*)mk_fwd, NWAVES * 64, LDS_BYTES) != hipSuccess || per_cu < 1)
            fprintf(stderr, "kernel_launch: note: occupancy query reports %d workgroups per CU\n", per_cu);
        (void)hipGetLastError();
        grid = cus;
    }
    if (grid < 0) return;
    (void)hipMemsetAsync((char*)d_ws + WS_CTL, 0, CTL_ZERO_BYTES, stream);
    Args a{};
    for (int i = 0; i < 21; ++i) a.in[i] = (const float*)d_in[i];
    a.out = (float*)d_out; a.ws = (unsigned char*)d_ws;
#if MK_N_LAUNCHES == 1
    a.ph_lo = 0; a.ph_hi = NPH;
    hipLaunchKernelGGL(mk_fwd, dim3(grid), dim3(NWAVES * 64), LDS_BYTES, stream, a);
#else
    for (int p = 0; p < NPH; ++p) { a.ph_lo = p; a.ph_hi = p + 1; hipLaunchKernelGGL(mk_fwd, dim3(grid), dim3(NWAVES * 64), LDS_BYTES, stream, a); }
#endif
}
```

```cpp
#include <hip/hip_runtime.h>
#include <cstdio>
#include <cstdint>
namespace pg8 {
#define PG8_LAS __attribute__((address_space(3)))
typedef unsigned short bf16_t;
typedef short bf16x8 __attribute__((ext_vector_type(8)));
typedef float f32x4 __attribute__((ext_vector_type(4)));
typedef unsigned u32x4 __attribute__((ext_vector_type(4)));
constexpr int BM = 256, BK = 64, HALF = 128, HTB = HALF * BK * 2  , STAGE_BYTES = 8 * HTB, NXCD = 8, WGM = 8;

__host__ __device__ __forceinline__ int lds_byte(int r, int c) { const int st = (r >> 4) * 2 + (c >> 5), rr = r & 15, cc = c & 31, ob = rr * 64 + cc * 2; return st * 1024 + (ob ^ (((ob >> 9) & 1) << 5)); }
__host__ __device__ __forceinline__ void stage_rc(int b, int& R, int& C) { const int st = b / 1024, sb = b % 1024, swz = sb ^ (((sb >> 9) & 1) << 5); R = (st >> 1) * 16 + swz / 64; C = (st & 1) * 32 + (swz % 64) / 2; }
__host__ __device__ __forceinline__ int perm32(int rho) { const int n = rho >> 4, i = rho & 15; return 8 * (i >> 2) + 4 * n + (i & 3); }

struct Unit { int pm, pn; };
struct Gemm { const bf16_t* A; const bf16_t* Bt; int M, N, K, lda; };

struct StaticOrder {
    int nM, nN, nwg, G, c;
    __host__ __device__ void init(int M, int N, int G_, int c_) { nM = M / BM; nN = N / BM; nwg = nM * nN; G = G_; c = c_; }
    __host__ __device__ bool next(int i, Unit& u) const {
        const long L = (long)i * G + c; if (L >= nwg) return false;
        int wgid = (int)L; { const int q = nwg / NXCD, r = nwg % NXCD, xcd = wgid % NXCD, off = wgid / NXCD; wgid = (xcd < r ? xcd * (q + 1) : r * (q + 1) + (xcd - r) * q) + off; }
        const int nig = WGM * nN, gid = wgid / nig, fm = gid * WGM, gsz = (nM - fm) < WGM ? (nM - fm) : WGM;
        u.pm = fm + ((wgid % nig) % gsz); u.pn = (wgid % nig) / gsz; return true;
    }
};

__device__ __forceinline__ unsigned cvt_pk_bf16(float lo, float hi) { unsigned r; asm volatile("v_cvt_pk_bf16_f32 %0, %1, %2" : "=v"(r) : "v"(lo), "v"(hi)); return r; }

template <class F> struct EpiB {
    static constexpr bool PERM = true;
    F f;
    __device__ __forceinline__ void operator()(const f32x4 (&acc)[2][2][4][2], const Unit& u, int wr, int wc, int fr, int fq) const {
        if constexpr (F::TILED) {
            const int lane = fq * 16 + fr, row0 = u.pm * BM + wr * 64 + fr;
#pragma unroll
            for (int ai = 0; ai < 2; ++ai)
#pragma unroll
                for (int m = 0; m < 4; ++m) { const float rsc = f.rowscale(row0 + ai * HALF + m * 16);
#pragma unroll
                    for (int bj = 0; bj < 2; ++bj) { const int q = bj * 2 + (wc >> 1); const int chunk = (((q * 2 + ai) * 4 + m) * 2 + wr) * 2 + (wc & 1);
                        f.tiled(u, chunk * 64 + lane, acc[ai][bj][m][0] * rsc, acc[ai][bj][m][1] * rsc); } }
        } else {
        const int row0 = u.pm * BM + wr * 64 + fr, col0 = u.pn * BM + wc * 32 + 8 * fq;
#pragma unroll
        for (int ai = 0; ai < 2; ++ai)
#pragma unroll
            for (int m = 0; m < 4; ++m) { const int row = row0 + ai * HALF + m * 16; const float rsc = f.rowscale(row);
#pragma unroll
                for (int bj = 0; bj < 2; ++bj) f(row, col0 + bj * HALF, acc[ai][bj][m][0] * rsc, acc[ai][bj][m][1] * rsc); }
        }
    }
};
struct EpiRes {
    static constexpr bool PERM = false;
    const float* base; float* out; int ldc;
    __device__ __forceinline__ void operator()(const f32x4 (&acc)[2][2][4][2], const Unit& u, int wr, int wc, int fr, int fq) const {
        const int row0 = u.pm * BM + wr * 64 + fr, col0 = u.pn * BM + wc * 32 + 4 * fq;
#pragma unroll
        for (int ai = 0; ai < 2; ++ai)
#pragma unroll
            for (int m = 0; m < 4; ++m) { const size_t off = (size_t)(row0 + ai * HALF + m * 16) * ldc + col0;
#pragma unroll
                for (int bj = 0; bj < 2; ++bj)
#pragma unroll
                    for (int n = 0; n < 2; ++n) { const size_t o = off + bj * HALF + n * 16; *(f32x4*)(out + o) = *(const f32x4*)(base + o) + acc[ai][bj][m][n]; } }
    }
};

template <bool BASE_F32, bool SCALE_IN = false> struct EpiResN {
    static constexpr bool PERM = true;
    const float* basef; bf16_t* hb; float* ssqp; const float* ssq_in;
    __device__ __forceinline__ void operator()(const f32x4 (&acc)[2][2][4][2], const Unit& u, int wr, int wc, int fr, int fq) const {
        const int row0 = u.pm * BM + wr * 64 + fr, col0 = u.pn * BM + wc * 32 + 8 * fq;
#pragma unroll
        for (int ai = 0; ai < 2; ++ai)
#pragma unroll
            for (int m = 0; m < 4; ++m) { const int row = row0 + ai * HALF + m * 16; float ss = 0.f; float rs2 = 1.f;
                if (SCALE_IN) { const f32x4* pp = (const f32x4*)(ssq_in + (size_t)row * 16); const f32x4 pa = pp[0], pb = pp[1], pc = pp[2], pd = pp[3];
                    const float sm = (((pa[0] + pa[1]) + (pa[2] + pa[3])) + ((pb[0] + pb[1]) + (pb[2] + pb[3]))) + (((pc[0] + pc[1]) + (pc[2] + pc[3])) + ((pd[0] + pd[1]) + (pd[2] + pd[3])));
                    rs2 = __builtin_amdgcn_rcpf(sm * (1.0f / 1024.0f) + 1e-6f); }
#pragma unroll
                for (int bj = 0; bj < 2; ++bj) { const size_t o = (size_t)row * 1024 + col0 + bj * HALF;
                    f32x4 a, b;
                    if (BASE_F32) { a = *(const f32x4*)(basef + o); b = *(const f32x4*)(basef + o + 4); }
                    else { const u32x4 w = *(const u32x4*)(hb + o);
                        a = (f32x4){__builtin_bit_cast(float, w.x << 16), __builtin_bit_cast(float, w.x & 0xffff0000u), __builtin_bit_cast(float, w.y << 16), __builtin_bit_cast(float, w.y & 0xffff0000u)};
                        b = (f32x4){__builtin_bit_cast(float, w.z << 16), __builtin_bit_cast(float, w.z & 0xffff0000u), __builtin_bit_cast(float, w.w << 16), __builtin_bit_cast(float, w.w & 0xffff0000u)}; }
                    if (SCALE_IN) { a = a + acc[ai][bj][m][0] * rs2; b = b + acc[ai][bj][m][1] * rs2; } else { a = a + acc[ai][bj][m][0]; b = b + acc[ai][bj][m][1]; }
                    u32x4 w2; w2.x = cvt_pk_bf16(a[0], a[1]); w2.y = cvt_pk_bf16(a[2], a[3]); w2.z = cvt_pk_bf16(b[0], b[1]); w2.w = cvt_pk_bf16(b[2], b[3]); *(u32x4*)(hb + o) = w2;
                    ss += ((a[0] * a[0] + a[1] * a[1]) + (a[2] * a[2] + a[3] * a[3])) + ((b[0] * b[0] + b[1] * b[1]) + (b[2] * b[2] + b[3] * b[3])); }
                ss += __shfl_xor(ss, 16); ss += __shfl_xor(ss, 32);
                if (fq == 0) ssqp[(size_t)row * 16 + u.pn * 4 + wc] = ss; }
    }
};

template <class Epi, class Sched, bool ALIGN_EPI, bool A_TILED = false>
__device__ __forceinline__ void gemm_phase(PG8_LAS unsigned char* lds, const Gemm g, const Sched& S, const Epi& E) {
    int tid = threadIdx.x; asm volatile("" : "+v"(tid));
    const int wid = __builtin_amdgcn_readfirstlane(tid >> 6), lane = tid & 63, wr = wid >> 2, wc = wid & 3, fr = lane & 15, fq = lane >> 4;
    const int K = g.K, nt = K / BK;
    unsigned voffA[2], voffB[2];
#pragma unroll
    for (int i = 0; i < 2; ++i) { int R, C; stage_rc(tid * 16 + i * 8192, R, C); const int Rb = Epi::PERM ? ((R & ~31) + perm32(R & 31)) : R;
        voffA[i] = A_TILED ? (unsigned)((((((R >> 4) & 3) * 2 + ((R >> 6) & 1)) * 2 + (C >> 5)) * 1024) + ((((C >> 3) & 3) * 16 + (R & 15)) * 16)) : (unsigned)(R * g.lda + C) * 2u;
        voffB[i] = (unsigned)(Rb * K + C) * 2u; }
    const size_t kstep = (size_t)(BK * 2), kstepA = A_TILED ? (size_t)32768 : kstep;
    const size_t hstepA = A_TILED ? (size_t)16384 : (size_t)HALF * g.lda * 2, hstepB = (size_t)HALF * K * 2;
    const size_t tstepA = A_TILED ? (size_t)(K / 64) * 32768 : 2 * hstepA, tstepB = 2 * hstepB;
    const unsigned ldsw = (unsigned)wid * 1024u;
    const int aoff = lds_byte(wr * 64 + fr, fq * 8), boff = lds_byte(wc * 32 + fr, fq * 8);
#define PG8_SA(b, h) (((b) * 2 + (h)) * HTB)
#define PG8_SB(b, h) ((4 + (b) * 2 + (h)) * HTB)
#define PG8_STAGE(bufoff, gbase, voff) do { _Pragma("unroll") for (int _i = 0; _i < 2; ++_i) \
        __builtin_amdgcn_global_load_lds((const unsigned*)((const char*)(gbase) + (voff)[_i]), (PG8_LAS unsigned*)(lds + (bufoff) + ldsw + _i * 8192), 16, 0, 0); } while (0)
#define PG8_LDA(dst, b, h) do { _Pragma("unroll") for (int m = 0; m < 4; ++m) _Pragma("unroll") for (int k = 0; k < 2; ++k) dst[m][k] = *(const PG8_LAS bf16x8*)(lds + PG8_SA(b, h) + aoff + m * 2048 + k * 1024); } while (0)
#define PG8_LDB(dst, b, h) do { _Pragma("unroll") for (int n = 0; n < 2; ++n) _Pragma("unroll") for (int k = 0; k < 2; ++k) dst[n][k] = *(const PG8_LAS bf16x8*)(lds + PG8_SB(b, h) + boff + n * 2048 + k * 1024); } while (0)
#define PG8_MMA(ai, bj, At, Bt) do { __builtin_amdgcn_s_setprio(1); _Pragma("unroll") for (int m = 0; m < 4; ++m) _Pragma("unroll") for (int n = 0; n < 2; ++n) _Pragma("unroll") for (int k = 0; k < 2; ++k) \
        acc[ai][bj][m][n] = __builtin_amdgcn_mfma_f32_16x16x32_bf16(Bt[n][k], At[m][k], acc[ai][bj][m][n], 0, 0, 0); __builtin_amdgcn_s_setprio(0); } while (0)
#define PG8_WAIT_V(n) asm volatile("s_waitcnt vmcnt(" #n ")" ::: "memory")
#define PG8_WAIT_L(n) asm volatile("s_waitcnt lgkmcnt(" #n ")" ::: "memory")
#define PG8_BAR __builtin_amdgcn_s_barrier()
#define PG8_SCHED __builtin_amdgcn_sched_barrier(0)
    Unit cur, nxt; int ui = 0;
    if (!S.next(0, cur)) return;
    f32x4 acc[2][2][4][2];
#pragma unroll
    for (int a = 0; a < 2; ++a)
#pragma unroll
        for (int b = 0; b < 2; ++b)
#pragma unroll
            for (int m = 0; m < 4; ++m)
#pragma unroll
                for (int n = 0; n < 2; ++n) acc[a][b][m][n] = (f32x4){0.f, 0.f, 0.f, 0.f};
    bf16x8 At[4][2], B0[2][2], B1[2][2];
    const char* cA = (const char*)g.A + (size_t)cur.pm * tstepA; const char* cB = (const char*)g.Bt + (size_t)cur.pn * tstepB;
    PG8_STAGE(PG8_SB(0, 0), cB, voffB); PG8_STAGE(PG8_SB(0, 1), cB + hstepB, voffB); PG8_STAGE(PG8_SA(0, 0), cA, voffA); PG8_STAGE(PG8_SA(0, 1), cA + hstepA, voffA);
    if (wr == 1) PG8_BAR;
    PG8_WAIT_V(2); PG8_BAR;
    PG8_STAGE(PG8_SB(1, 0), cB + kstep, voffB); PG8_STAGE(PG8_SA(1, 0), cA + kstepA, voffA); PG8_STAGE(PG8_SB(1, 1), cB + hstepB + kstep, voffB);
    PG8_WAIT_V(6); PG8_BAR;
    for (;;) {
        const bool has_next = S.next(ui + 1, nxt);
        const char* nA = has_next ? (const char*)g.A + (size_t)nxt.pm * tstepA : cA; const char* nB = has_next ? (const char*)g.Bt + (size_t)nxt.pn * tstepB : cB;
#pragma nounroll
        for (int t = 0; t < nt; t += 2) {
            const bool last = (t == nt - 2);
            const char* a1 = cA + (size_t)(t + 1) * kstepA;
            const char* a2 = last ? nA : cA + (size_t)(t + 2) * kstepA; const char* b2 = last ? nB : cB + (size_t)(t + 2) * kstep;
            const char* a3 = a2 + kstepA; const char* b3 = b2 + kstep;
            PG8_LDB(B0, 0, 0); PG8_LDB(B1, 0, 1); PG8_SCHED; PG8_LDA(At, 0, 0); PG8_STAGE(PG8_SA(1, 1), a1 + hstepA, voffA);
            PG8_WAIT_V(8); PG8_WAIT_L(0); PG8_BAR; PG8_MMA(0, 0, At, B0); PG8_MMA(0, 1, At, B1); PG8_BAR; PG8_SCHED;
            PG8_LDA(At, 0, 1); PG8_STAGE(PG8_SB(0, 0), b2, voffB); PG8_STAGE(PG8_SB(0, 1), b2 + hstepB, voffB); PG8_STAGE(PG8_SA(0, 0), a2, voffA);
            PG8_WAIT_V(8); PG8_WAIT_L(0); PG8_BAR; PG8_MMA(1, 0, At, B0); PG8_MMA(1, 1, At, B1); PG8_BAR; PG8_SCHED;
            PG8_LDB(B0, 1, 0); PG8_LDB(B1, 1, 1); PG8_SCHED; PG8_LDA(At, 1, 0); PG8_STAGE(PG8_SA(0, 1), a2 + hstepA, voffA);
            PG8_WAIT_V(8); PG8_WAIT_L(0); PG8_BAR; PG8_MMA(0, 0, At, B0); PG8_MMA(0, 1, At, B1); PG8_BAR; PG8_SCHED;
            PG8_LDA(At, 1, 1); PG8_STAGE(PG8_SB(1, 0), b3, voffB); PG8_STAGE(PG8_SB(1, 1), b3 + hstepB, voffB); PG8_STAGE(PG8_SA(1, 0), a3, voffA);
            PG8_WAIT_V(8); PG8_WAIT_L(0); PG8_BAR; PG8_MMA(1, 0, At, B0); PG8_MMA(1, 1, At, B1); PG8_BAR; PG8_SCHED;
        }
        if constexpr (ALIGN_EPI) { if (wr == 0) PG8_BAR; }
        E(acc, cur, wr, wc, fr, fq);
        if (!has_next) break;
#pragma unroll
        for (int a = 0; a < 2; ++a)
#pragma unroll
            for (int b = 0; b < 2; ++b)
#pragma unroll
                for (int m = 0; m < 4; ++m)
#pragma unroll
                    for (int n = 0; n < 2; ++n) acc[a][b][m][n] = (f32x4){0.f, 0.f, 0.f, 0.f};
        cur = nxt; cA = nA; cB = nB; ++ui;
        if constexpr (ALIGN_EPI) { if (wr == 1) PG8_BAR; }
    }
    PG8_WAIT_V(0);
    if constexpr (!ALIGN_EPI) { if (wr == 0) PG8_BAR; }
    PG8_BAR;
#undef PG8_SA
#undef PG8_SB
#undef PG8_STAGE
#undef PG8_LDA
#undef PG8_LDB
#undef PG8_MMA
#undef PG8_WAIT_V
#undef PG8_WAIT_L
#undef PG8_BAR
#undef PG8_SCHED
}
}
namespace att {
typedef unsigned short bf16_t;
typedef short bf16x8 __attribute__((ext_vector_type(8)));
typedef short s16x4 __attribute__((ext_vector_type(4)));
typedef float f32x16 __attribute__((ext_vector_type(16)));
typedef float f32x4 __attribute__((ext_vector_type(4)));
typedef unsigned u32x4 __attribute__((ext_vector_type(4)));
#define ATT_LAS __attribute__((address_space(3)))
#ifndef PROBE_NOEXIT
#define PROBE_NOEXIT 0
#endif
constexpr int KVBLK = 64, QBLK = 32, QB = 256;
constexpr int L_K = 0, L_V = 16384, L_PE = 32768, BUFB = 40960, L_WS = 2 * BUFB, L_FLAG = L_WS + 2048, LDS_BYTES = L_FLAG + 64;
enum { MODE_MLA = 0, MODE_CROSS = 1, MODE_SB = 2 };

#define ATT_KSWZ(row, colB) ((row) * 256 + ((colB) ^ (((row) & 7) << 4)))
#define ATT_PESWZ(row, ch) ((row) * 128 + ((((ch) ^ (((row) >> 1) & 7))) << 4))
#define ATT_SBAR() __builtin_amdgcn_sched_barrier(0)
__device__ __forceinline__ int v_st(int k, int c) { const int kk = (k & ~0xC) | ((k & 4) << 1) | ((k & 8) >> 1); return ((kk >> 3) * 4 + (c >> 5)) * 512 + ((kk & 7) * 32 + (c & 31)) * 2; }
__device__ __forceinline__ int v_rd_base(int lane) { return ((lane & 3) << 3) | (((lane >> 2) & 3) << 6) | (((lane >> 4) & 1) << 5) | (((lane >> 5) & 1) << 8); }
__device__ __forceinline__ int crow(int r, int hi) { return (r & 3) + 8 * (r >> 2) + 4 * hi; }
__device__ __forceinline__ unsigned cvtpk(float lo, float hi) { unsigned r; asm volatile("v_cvt_pk_bf16_f32 %0, %1, %2" : "=v"(r) : "v"(lo), "v"(hi)); return r; }
__device__ __forceinline__ float swap_add(float v) { auto rr = __builtin_amdgcn_permlane32_swap(__float_as_uint(v), __float_as_uint(v), false, false); return __uint_as_float(rr[0]) + __uint_as_float(rr[1]); }
__device__ __forceinline__ float swap_max(float v) { auto rr = __builtin_amdgcn_permlane32_swap(__float_as_uint(v), __float_as_uint(v), false, false); return fmaxf(__uint_as_float(rr[0]), __uint_as_float(rr[1])); }
__device__ __forceinline__ float swap_other(float v, int hi) { auto rr = __builtin_amdgcn_permlane32_swap(__float_as_uint(v), __float_as_uint(v), false, false);
    const float a = __uint_as_float(rr[0]), b = __uint_as_float(rr[1]); return hi ? a : b; }

__device__ __forceinline__ void pack_p(const f32x16& p0, const f32x16& p1, bf16x8& pa0, bf16x8& pa1, bf16x8& pa2, bf16x8& pa3) {
#define ATT_PK4(P, B_, OUT) do { unsigned a0 = cvtpk(P[B_+0], P[B_+1]), a1 = cvtpk(P[B_+2], P[B_+3]);                          \
        unsigned b0 = cvtpk(P[B_+4], P[B_+5]), b1 = cvtpk(P[B_+6], P[B_+7]);                                             \
        auto r0 = __builtin_amdgcn_permlane32_swap(a0, b0, false, false); auto r1 = __builtin_amdgcn_permlane32_swap(a1, b1, false, false); \
        u32x4 w = {r0[0], r1[0], r0[1], r1[1]}; OUT = *reinterpret_cast<bf16x8*>(&w); } while (0)
    ATT_PK4(p0, 0, pa0); ATT_PK4(p0, 8, pa1); ATT_PK4(p1, 0, pa2); ATT_PK4(p1, 8, pa3);
#undef ATT_PK4
}
__device__ __forceinline__ void pv_tile(f32x16* o, int vb0, bf16x8 pa0, bf16x8 pa1, bf16x8 pa2, bf16x8 pa3) {
#define ATT_TRRD(dst, off) asm volatile("ds_read_b64_tr_b16 %0, %1 offset:%2" : "=&v"(dst) : "v"(vb0), "i"(off) : "memory")
#define ATT_PV_D0(d0) do { s16x4 l0, l1, l2, l3, h0, h1, h2, h3; constexpr int b_ = (d0) * 512;   \
        ATT_TRRD(l0, b_); ATT_TRRD(h0, b_ + 2048); ATT_TRRD(l1, b_ + 4096); ATT_TRRD(h1, b_ + 6144); ATT_TRRD(l2, b_ + 8192); ATT_TRRD(h2, b_ + 10240); ATT_TRRD(l3, b_ + 12288); ATT_TRRD(h3, b_ + 14336); \
        asm volatile("s_waitcnt lgkmcnt(0)" ::: "memory"); ATT_SBAR();   \
        o[d0] = __builtin_amdgcn_mfma_f32_32x32x16_bf16((bf16x8){l0[0], l0[1], l0[2], l0[3], h0[0], h0[1], h0[2], h0[3]}, pa0, o[d0], 0, 0, 0);   \
        o[d0] = __builtin_amdgcn_mfma_f32_32x32x16_bf16((bf16x8){l1[0], l1[1], l1[2], l1[3], h1[0], h1[1], h1[2], h1[3]}, pa1, o[d0], 0, 0, 0);   \
        o[d0] = __builtin_amdgcn_mfma_f32_32x32x16_bf16((bf16x8){l2[0], l2[1], l2[2], l2[3], h2[0], h2[1], h2[2], h2[3]}, pa2, o[d0], 0, 0, 0);   \
        o[d0] = __builtin_amdgcn_mfma_f32_32x32x16_bf16((bf16x8){l3[0], l3[1], l3[2], l3[3], h3[0], h3[1], h3[2], h3[3]}, pa3, o[d0], 0, 0, 0); } while (0)
    ATT_PV_D0(0); ATT_PV_D0(1); ATT_PV_D0(2); ATT_PV_D0(3);
#undef ATT_PV_D0
#undef ATT_TRRD
}

template <int MODE, bool FUSEQ = false>
__device__ __forceinline__ void attn_unit(ATT_LAS unsigned char* lds, const bf16_t* Qb, const bf16_t* Kn, const bf16_t* Kpe, const bf16_t* Vp, bf16_t* Ob, int ostride, int q0, int nkeys,
                                          const bf16_t* Hrows = nullptr, const bf16_t* Wh = nullptr, const float* ssqp = nullptr, float qscale = 1.0f) {
    constexpr int DKQ = (MODE == MODE_MLA) ? 192 : 128, NQF = DKQ / 16;
    int tid = threadIdx.x; asm volatile("" : "+v"(tid));
    const int wid = __builtin_amdgcn_readfirstlane(tid >> 6), lane = tid & 63, r32 = lane & 31, hi = lane >> 5;
    volatile ATT_LAS int* flags = (volatile ATT_LAS int*)(lds + L_FLAG);
    const int vb0 = (int)(unsigned)(uintptr_t)(lds + L_V) + v_rd_base(lane);
    const int lrow = (MODE == MODE_SB) ? (8 * r32 + wid) : (wid * QBLK + r32);
    bf16x8 qr[NQF];
    if (!FUSEQ) {
#pragma unroll
        for (int d0 = 0; d0 < NQF; ++d0) qr[d0] = *(const bf16x8*)(Qb + (size_t)lrow * DKQ + d0 * 16 + hi * 8);
    } else {
        f32x16 qa[4]; qa[0] = f32x16{}; qa[1] = f32x16{}; qa[2] = f32x16{}; qa[3] = f32x16{};
        const bf16_t* hrow = Hrows + (size_t)(wid * QBLK + r32) * 1024 + hi * 8;
        const int wr0 = tid >> 4, wch = tid & 15;
        const bf16_t* wsrc = Wh + (size_t)wr0 * 1024 + wch * 8;
        const int wws = ATT_KSWZ(wr0, wch * 16);
        u32x4 wv[4];
        bf16x8 hb_[8], hn_[8];
#pragma unroll
        for (int i = 0; i < 4; ++i) wv[i] = *(const u32x4*)(wsrc + (size_t)i * 32 * 1024);
#pragma unroll
        for (int ks = 0; ks < 8; ++ks) hb_[ks] = *(const bf16x8*)(hrow + ks * 16);
#pragma unroll
        for (int i = 0; i < 4; ++i) *(ATT_LAS u32x4*)(lds + wws + i * 32 * 256) = wv[i];
#pragma unroll
        for (int ks = 0; ks < 8; ++ks) asm volatile("" : "+v"(hb_[ks]));
        __syncthreads();
#pragma nounroll
        for (int c = 0; c < 8; ++c) {
            ATT_LAS unsigned char* wb = lds + (c & 1) * 32768;
            const bool morec = (c + 1 < 8);
            if (morec) {
#pragma unroll
                for (int i = 0; i < 4; ++i) wv[i] = *(const u32x4*)(wsrc + (size_t)i * 32 * 1024 + (c + 1) * 128);
#pragma unroll
                for (int ks = 0; ks < 8; ++ks) hn_[ks] = *(const bf16x8*)(hrow + (c + 1) * 128 + ks * 16); }
#pragma unroll
            for (int ks = 0; ks < 8; ++ks) {
#pragma unroll
                for (int blk = 0; blk < 4; ++blk) {
                    const bf16x8 af = *(const ATT_LAS bf16x8*)(wb + ATT_KSWZ(r32, ((ks & 3) * 16 + hi * 8) * 2) + (ks >> 2) * 128 + blk * 32 * 256);
                    qa[blk] = __builtin_amdgcn_mfma_f32_32x32x16_bf16(af, hb_[ks], qa[blk], 0, 0, 0);
                }
            }
            if (morec) {
#pragma unroll
                for (int i = 0; i < 4; ++i) *(ATT_LAS u32x4*)(lds + ((c + 1) & 1) * 32768 + wws + i * 32 * 256) = wv[i];
#pragma unroll
                for (int ks = 0; ks < 8; ++ks) hb_[ks] = hn_[ks]; }
            __syncthreads();
        }
        { const f32x4* pp = (const f32x4*)(ssqp + (size_t)(wid * QBLK + r32) * 16); const f32x4 a = pp[0], b = pp[1], cc = pp[2], d = pp[3];
          const float sm = (((a[0] + a[1]) + (a[2] + a[3])) + ((b[0] + b[1]) + (b[2] + b[3]))) + (((cc[0] + cc[1]) + (cc[2] + cc[3])) + ((d[0] + d[1]) + (d[2] + d[3])));
          const float sc_ = qscale * __builtin_amdgcn_rsqf(sm * (1.0f / 1024.0f) + 1e-6f);
#pragma unroll
          for (int blk = 0; blk < 4; ++blk) qa[blk] = qa[blk] * sc_; }
#define ATT_PK4(P, B_, OUT) do { unsigned a0 = cvtpk(P[B_+0], P[B_+1]), a1 = cvtpk(P[B_+2], P[B_+3]);                          \
        unsigned b0 = cvtpk(P[B_+4], P[B_+5]), b1 = cvtpk(P[B_+6], P[B_+7]);                                             \
        auto r0 = __builtin_amdgcn_permlane32_swap(a0, b0, false, false); auto r1 = __builtin_amdgcn_permlane32_swap(a1, b1, false, false); \
        u32x4 w = {r0[0], r1[0], r0[1], r1[1]}; OUT = *reinterpret_cast<bf16x8*>(&w); } while (0)
#pragma unroll
        for (int blk = 0; blk < 4; ++blk) { ATT_PK4(qa[blk], 0, qr[2 * blk]); ATT_PK4(qa[blk], 8, qr[2 * blk + 1]); }
#undef ATT_PK4
    }
    const int qlo = q0 + ((MODE == MODE_SB) ? wid : wid * QBLK);
    const int qhi = q0 + ((MODE == MODE_SB) ? 248 + wid : wid * QBLK + QBLK - 1);
    const int qpos = q0 + lrow;
    float m_reg = -1e30f, l_reg = 0.f, Rrun = 1.f;
    f32x16 o[4]; o[0] = f32x16{}; o[1] = f32x16{}; o[2] = f32x16{}; o[3] = f32x16{};
    const int sr = tid >> 4, sc = (tid & 15) * 8;
    const int kws = ATT_KSWZ(sr, sc * 2), vst0 = v_st(sr, sc), vst1 = v_st(32 + sr, sc);
    const int per = tid >> 3, pech = tid & 7, pews = ATT_PESWZ(per, pech);
    int NT;
    if (MODE == MODE_CROSS) NT = nkeys / KVBLK; else NT = (q0 + QB) / KVBLK;
    u32x4 k0v, k1v, v0v, v1v, pev;
#define ATT_LOAD(kb_) do { k0v = *(const u32x4*)(Kn + (size_t)((kb_) + sr) * 128 + sc); k1v = *(const u32x4*)(Kn + (size_t)((kb_) + 32 + sr) * 128 + sc); \
        v0v = *(const u32x4*)(Vp + (size_t)((kb_) + sr) * 128 + sc); v1v = *(const u32x4*)(Vp + (size_t)((kb_) + 32 + sr) * 128 + sc); \
        if (MODE == MODE_MLA) pev = *(const u32x4*)(Kpe + (size_t)((kb_) + per) * 64 + pech * 8); } while (0)
#define ATT_WRITE(bo_) do { *(ATT_LAS u32x4*)(lds + (bo_) + L_K + kws) = k0v; *(ATT_LAS u32x4*)(lds + (bo_) + L_K + kws + 32 * 256) = k1v; \
        *(ATT_LAS u32x4*)(lds + (bo_) + L_V + vst0) = v0v; *(ATT_LAS u32x4*)(lds + (bo_) + L_V + vst1) = v1v; \
        if (MODE == MODE_MLA) *(ATT_LAS u32x4*)(lds + (bo_) + L_PE + pews) = pev; } while (0)
#define ATT_TILE(it_) ((MODE == MODE_SB) ? (NT - 1 - (it_)) : (it_))
    ATT_LOAD(ATT_TILE(0) * KVBLK);
    ATT_WRITE(0);
#pragma unroll
    for (int d0 = 0; d0 < NQF; ++d0) asm volatile("" : "+v"(qr[d0]));
    __syncthreads();
    for (int it = 0; it < NT; ++it) {
        const int kb = ATT_TILE(it) * KVBLK;
        const int bo = (it & 1) * BUFB;
        ATT_LAS unsigned char* ldsb = lds + bo;
        const bool more = (it + 1 < NT);
        if (more) ATT_LOAD(ATT_TILE(it + 1) * KVBLK);
        bool act = true;
        if (MODE == MODE_MLA) act = (kb <= qhi);
        if (MODE == MODE_SB) act = (kb < qhi);
        if (act && MODE != MODE_SB) {
            f32x16 p0 = f32x16{}, p1 = f32x16{};
#pragma unroll
            for (int d0 = 0; d0 < 8; ++d0) {
                const int off = ATT_KSWZ(r32, ((d0 & 3) * 16 + hi * 8) * 2) + (d0 >> 2) * 128;
                const bf16x8 b0 = *(const ATT_LAS bf16x8*)(ldsb + L_K + off);
                const bf16x8 b1 = *(const ATT_LAS bf16x8*)(ldsb + L_K + off + 32 * 256);
                p0 = __builtin_amdgcn_mfma_f32_32x32x16_bf16(b0, qr[d0], p0, 0, 0, 0);
                p1 = __builtin_amdgcn_mfma_f32_32x32x16_bf16(b1, qr[d0], p1, 0, 0, 0);
            }
            if (MODE == MODE_MLA) {
#pragma unroll
                for (int d0 = 8; d0 < NQF; ++d0) {
                    const int off = ATT_PESWZ(r32, (d0 - 8) * 2 + hi);
                    const bf16x8 b0 = *(const ATT_LAS bf16x8*)(ldsb + L_PE + off);
                    const bf16x8 b1 = *(const ATT_LAS bf16x8*)(ldsb + L_PE + off + 32 * 128);
                    p0 = __builtin_amdgcn_mfma_f32_32x32x16_bf16(b0, qr[d0], p0, 0, 0, 0);
                    p1 = __builtin_amdgcn_mfma_f32_32x32x16_bf16(b1, qr[d0], p1, 0, 0, 0);
                }
            }
            bf16x8 pa0, pa1, pa2, pa3;
            if (MODE == MODE_MLA && kb + KVBLK - 1 > qlo) {
                const float NEG = -__builtin_inff();
#pragma unroll
                for (int r = 0; r < 16; ++r) { const int key = kb + crow(r, hi); if (key > qpos) p0[r] = NEG; if (key + 32 > qpos) p1[r] = NEG; }
            }
            float pmax = p0[0];
#pragma unroll
            for (int r = 1; r < 16; ++r) pmax = fmaxf(pmax, p0[r]);
#pragma unroll
            for (int r = 0; r < 16; ++r) pmax = fmaxf(pmax, p1[r]);
            pmax = swap_max(pmax);
            const float mn = fmaxf(m_reg, pmax), alpha = __builtin_amdgcn_exp2f(m_reg - mn); m_reg = mn;
            float ps = 0.f;
#pragma unroll
            for (int r = 0; r < 16; ++r) { p0[r] = __builtin_amdgcn_exp2f(p0[r] - mn); ps += p0[r]; }
#pragma unroll
            for (int r = 0; r < 16; ++r) { p1[r] = __builtin_amdgcn_exp2f(p1[r] - mn); ps += p1[r]; }
            ps = swap_add(ps);
            l_reg = l_reg * alpha + ps;
            if (__any(alpha < 1.f)) {
#pragma unroll
                for (int d_ = 0; d_ < 4; ++d_) o[d_] = o[d_] * alpha;
            }
            pack_p(p0, p1, pa0, pa1, pa2, pa3);
            ATT_SBAR();
            pv_tile(o, vb0 + bo, pa0, pa1, pa2, pa3);
        }
        if (act && MODE == MODE_SB) {
            const bool needmask = (kb + KVBLK - 1 >= qlo);
            bf16x8 pa[4];
#pragma unroll
            for (int half = 1; half >= 0; --half) {
                f32x16 p = f32x16{};
#pragma unroll
                for (int d0 = 0; d0 < 8; ++d0) {
                    const int off = ATT_KSWZ(r32, ((d0 & 3) * 16 + hi * 8) * 2) + (d0 >> 2) * 128 + half * 32 * 256;
                    const bf16x8 b0 = *(const ATT_LAS bf16x8*)(ldsb + L_K + off);
                    p = __builtin_amdgcn_mfma_f32_32x32x16_bf16(b0, qr[d0], p, 0, 0, 0);
                }
                f32x16 L;
#pragma unroll
                for (int r = 0; r < 16; ++r) { const float e = __builtin_amdgcn_exp2f(-fmaxf(p[r], -100.f)); const float b = __builtin_amdgcn_rcpf(1.f + e); L[r] = e * b; p[r] = b; }
                if (needmask) {
#pragma unroll
                    for (int r = 0; r < 16; ++r) { const int key = kb + half * 32 + crow(r, hi); if (key >= qpos) { L[r] = 1.f; p[r] = 0.f; } }
                }
                float g[4], h[4];
#pragma unroll
                for (int i = 0; i < 4; ++i) g[i] = (L[4 * i] * L[4 * i + 1]) * (L[4 * i + 2] * L[4 * i + 3]);
#pragma unroll
                for (int i = 0; i < 4; ++i) h[i] = swap_other(g[i], hi);
                float os[4]; float run = Rrun;
#pragma unroll
                for (int i = 3; i >= 0; --i) { os[i] = run; run *= g[i] * h[i]; }
#pragma unroll
                for (int i = 0; i < 4; ++i) {
                    float e = hi == 0 ? os[i] * h[i] : os[i];
#pragma unroll
                    for (int j = 3; j >= 0; --j) { const float b = p[4 * i + j]; p[4 * i + j] = b * e; e *= L[4 * i + j]; }
                }
                Rrun = run;
#define ATT_PK4(P, B_, OUT) do { unsigned a0 = cvtpk(P[B_+0], P[B_+1]), a1 = cvtpk(P[B_+2], P[B_+3]);                          \
        unsigned b0 = cvtpk(P[B_+4], P[B_+5]), b1 = cvtpk(P[B_+6], P[B_+7]);                                             \
        auto r0 = __builtin_amdgcn_permlane32_swap(a0, b0, false, false); auto r1 = __builtin_amdgcn_permlane32_swap(a1, b1, false, false); \
        u32x4 w = {r0[0], r1[0], r0[1], r1[1]}; OUT = *reinterpret_cast<bf16x8*>(&w); } while (0)
                ATT_PK4(p, 0, pa[2 * half]); ATT_PK4(p, 8, pa[2 * half + 1]);
#undef ATT_PK4
            }
            ATT_SBAR();
            pv_tile(o, vb0 + bo, pa[0], pa[1], pa[2], pa[3]);
        }
        if (MODE == MODE_SB) { const int dn = (act && __all(Rrun < 1.17549435e-38f)) ? 1 : 0;   if (lane == 0) flags[(it & 1) * 8 + wid] = dn; }
        if (more) ATT_WRITE(bo ^ BUFB);
        __syncthreads();
        if (MODE == MODE_SB && more) { int alld = 1;
#pragma unroll
            for (int w = 0; w < 8; ++w) alld &= flags[(it & 1) * 8 + w];
            if (alld) break; }
    }
#undef ATT_LOAD
#undef ATT_WRITE
#undef ATT_TILE
    const float inv = (MODE != MODE_SB) ? 1.0f / l_reg : 1.0f;
    bf16_t* Ow = Ob + (size_t)lrow * ostride + hi * 8;
#define ATT_PK4(P, B_, OUT) do { unsigned a0 = cvtpk(P[B_+0] * inv, P[B_+1] * inv), a1 = cvtpk(P[B_+2] * inv, P[B_+3] * inv);                          \
        unsigned b0 = cvtpk(P[B_+4] * inv, P[B_+5] * inv), b1 = cvtpk(P[B_+6] * inv, P[B_+7] * inv);                                             \
        auto r0 = __builtin_amdgcn_permlane32_swap(a0, b0, false, false); auto r1 = __builtin_amdgcn_permlane32_swap(a1, b1, false, false); \
        OUT = (u32x4){r0[0], r1[0], r0[1], r1[1]}; } while (0)
#pragma unroll
    for (int d0 = 0; d0 < 4; ++d0) { u32x4 f0, f1; ATT_PK4(o[d0], 0, f0); ATT_PK4(o[d0], 8, f1);
        *(u32x4*)(Ow + d0 * 32) = f0; *(u32x4*)(Ow + d0 * 32 + 16) = f1; }
#undef ATT_PK4
    __syncthreads();
}
}
constexpr int NWAVES = 8;
constexpr int BATCH = 8, SEQ = 2048, DM = 1024, T = BATCH * SEQ;
constexpr int MEMLEN = 256, TM = BATCH * MEMLEN;
constexpr int QLORA = 384, KVLORA = 256, ROPE = 64, NLAT = 704, NLATP = 768;
constexpr int HEADS = 8, NOPE = 128, DQK = 192, DV = 128;
constexpr int XH = 4, DFF = 4096;
constexpr float EPS = 1e-6f;
constexpr float LOG2E = 1.4426950408889634f;
constexpr float QSCALE_MLA = 0.07216878364870322f * LOG2E;
constexpr float QSCALE_128 = 0.08838834764831845f * LOG2E;

constexpr size_t MiB = 1u << 20;
constexpr size_t WS_CTL = 0, CTL_ZERO_BYTES = 64 * 1024;
constexpr size_t WS_RS = 1 * MiB / 2;
constexpr size_t WS_WDKV = 1 * MiB;
constexpr size_t WS_WUQ = WS_WDKV + (size_t)NLATP * DM * 2;
constexpr size_t WS_WUKV = WS_WUQ + (size_t)1536 * 384 * 2;
constexpr size_t WS_WO0 = WS_WUKV + (size_t)2048 * 256 * 2;
constexpr size_t WS_WXQ = WS_WO0 + (size_t)DM * DM * 2;
constexpr size_t WS_WXKV = WS_WXQ + 2 * (size_t)512 * DM * 2;
constexpr size_t WS_WXO = WS_WXKV + 2 * (size_t)DM * DM * 2;
constexpr size_t WS_WIN = WS_WXO + 2 * (size_t)DM * 512 * 2;
constexpr size_t WS_WOUT = WS_WIN + 2 * (size_t)DFF * DM * 2;
constexpr size_t WS_WQKV = WS_WOUT + 2 * (size_t)DM * DFF * 2;
constexpr size_t WS_WO1 = WS_WQKV + (size_t)3072 * DM * 2;
constexpr size_t WS_WEND = WS_WO1 + (size_t)DM * DM * 2;
static_assert(WS_WEND <= 56 * MiB, "weights");
constexpr size_t WS_HB = 56 * MiB;
constexpr size_t WS_KVX = 88 * MiB;
constexpr size_t WS_CS = 96 * MiB;
constexpr size_t WS_KPE = 100 * MiB;
constexpr size_t WS_MEMB = 102 * MiB;
constexpr size_t WS_SSQ = 106 * MiB;
constexpr size_t WS_X = 108 * MiB;
constexpr size_t WS_LAT = WS_X;
constexpr size_t WS_OB = WS_X;
constexpr size_t WS_Q = WS_X + 32 * MiB;
constexpr size_t WS_KN = WS_X + 80 * MiB;
constexpr size_t WS_V = WS_X + 112 * MiB;
constexpr size_t WS_K1 = WS_X + 64 * MiB, WS_V1 = WS_X + 96 * MiB;
constexpr size_t WS_QX = WS_X, WS_OX = WS_X + 16 * MiB;
constexpr size_t WS_U = WS_X;
constexpr size_t WS_END = WS_X + 144 * MiB;
static_assert(WS_END <= 256 * MiB, "d_ws map");
constexpr int RS_X = 0, RS_Q = T, RS_KV = 2 * T, RS_H = 3 * T, RS_MEM = 4 * T;
constexpr int CW_BAR = 1024;

constexpr int RING_OFF = 0, RING_BYTES = 131072;
constexpr int LDSCTL_OFF = RING_BYTES, MISC_OFF = LDSCTL_OFF + 320;
constexpr int LDS_BYTES = 147456;

#define GAS __attribute__((address_space(1)))
#define LAS __attribute__((address_space(3)))
typedef unsigned short bf16;
typedef unsigned v4u __attribute__((ext_vector_type(4)));
typedef float f32x4 __attribute__((ext_vector_type(4)));
typedef GAS unsigned gu32;
#define RLX_AGENT __ATOMIC_RELAXED, __HIP_MEMORY_SCOPE_AGENT
#define LDS_WAIT() asm volatile("s_waitcnt lgkmcnt(0)" ::: "memory")
#define VM_WAIT() asm volatile("s_waitcnt vmcnt(0)" ::: "memory")
__device__ __forceinline__ unsigned f2bf(float f) { unsigned u = __builtin_bit_cast(unsigned, f); return (u + 0x7fffu + ((u >> 16) & 1u)) >> 16; }
__device__ __forceinline__ unsigned pk2(float lo, float hi) { return f2bf(lo) | (f2bf(hi) << 16); }
__device__ __forceinline__ float bf2f(unsigned short b) { return __builtin_bit_cast(float, (unsigned)b << 16); }
__device__ __forceinline__ void store8nt(bf16* p, f32x4 a, f32x4 b) { v4u w; w.x = pg8::cvt_pk_bf16(a[0], a[1]); w.y = pg8::cvt_pk_bf16(a[2], a[3]); w.z = pg8::cvt_pk_bf16(b[0], b[1]); w.w = pg8::cvt_pk_bf16(b[2], b[3]); __builtin_nontemporal_store(w, (v4u*)p); }
__device__ __forceinline__ void store8(bf16* p, f32x4 a, f32x4 b) {
#ifdef NT_ALL
    store8nt(p, a, b); return;
#endif
    v4u w; w.x = pg8::cvt_pk_bf16(a[0], a[1]); w.y = pg8::cvt_pk_bf16(a[2], a[3]); w.z = pg8::cvt_pk_bf16(b[0], b[1]); w.w = pg8::cvt_pk_bf16(b[2], b[3]); *(v4u*)p = w; }

#define XB_TMO      128
#define XB_XCNT(j)  (256  + 64 * (j))
#define XB_XSUB(j)  (1280 + 64 * (j))
#define XB_XGEN(j)  (2304 + 64 * (j))
#define XB_TOP      3328
#define XB_TOPGEN   3392
#define XCD_BAR_WORDS 3456
#define XB_SPIN_CAP (1u << 18)
__device__ __forceinline__ unsigned xb_ld(unsigned* p)              { return __hip_atomic_load(p, __ATOMIC_RELAXED, __HIP_MEMORY_SCOPE_AGENT); }
__device__ __forceinline__ unsigned xb_add(unsigned* p, unsigned v) { return __hip_atomic_fetch_add(p, v, __ATOMIC_RELAXED, __HIP_MEMORY_SCOPE_AGENT); }
__device__ __forceinline__ unsigned xb_xcc_id() { return (unsigned)__builtin_amdgcn_s_getreg((3 << 11) | 20) & 0xFu; }
#define XB_SPIN(cond, bar) do { unsigned _sp = 0; while (cond) { __builtin_amdgcn_s_sleep(1); \
    if ((++_sp & 255u) == 0u) { if (xb_ld(&(bar)[XB_TMO])) break; if (_sp > XB_SPIN_CAP) { atomicAdd(&(bar)[XB_TMO], 1u); break; } } } } while (0)
struct XcdBarrier { unsigned* bar; unsigned x; volatile LAS unsigned* st; };
__device__ __forceinline__ XcdBarrier xcd_barrier_post(unsigned* bar, volatile LAS unsigned* st) {
    XcdBarrier b; b.bar = bar; b.x = xb_xcc_id(); b.st = st;
    if (threadIdx.x == 0) (void)xb_add(&bar[XB_XCNT(b.x)], 1u);
    return b;
}
__device__ __forceinline__ void xcd_barrier_complete(unsigned* bar, unsigned x, unsigned& nloc, unsigned& nx) {
    const unsigned G = gridDim.x * gridDim.y * gridDim.z;
    unsigned sum, cnt, mine, sp = 0u;
    for (;;) {
        sum = 0u; cnt = 0u; mine = 0u;
#pragma unroll
        for (unsigned j = 0; j < 16; ++j) { const unsigned c = xb_ld(&bar[XB_XCNT(j)]); sum += c; cnt += (c > 0u) ? 1u : 0u; mine = (j == x) ? c : mine; }
        if (sum == G) break;
        __builtin_amdgcn_s_sleep(1);
        if ((++sp & 255u) == 0u) { if (xb_ld(&bar[XB_TMO])) break; if (sp > XB_SPIN_CAP) { atomicAdd(&bar[XB_TMO], 1u); break; } }
    }
    nloc = mine > 0u ? mine : 1u; nx = cnt > 0u ? cnt : 1u;
}
__device__ __forceinline__ void xcd_barrier(const XcdBarrier& b) {
    asm volatile("s_waitcnt vmcnt(0)" ::: "memory");
    __syncthreads();
    if (threadIdx.x == 0) {
        unsigned* bar = b.bar;
        __builtin_amdgcn_s_waitcnt(0);
        unsigned nloc = b.st[0], nx = b.st[1];
        if (nloc == 0u) { xcd_barrier_complete(bar, b.x, nloc, nx); b.st[0] = nloc; b.st[1] = nx; }
        const unsigned old = xb_add(&bar[XB_XSUB(b.x)], 1u);
        const unsigned gen = old / nloc;
        if (old + 1u == (gen + 1u) * nloc) {
            __builtin_amdgcn_fence(__ATOMIC_RELEASE, "agent");
            asm volatile("s_waitcnt vmcnt(0)" ::: "memory");
            const unsigned og = xb_add(&bar[XB_TOP], 1u);
            const unsigned tg = og / nx;
            if (og + 1u == (tg + 1u) * nx) xb_add(&bar[XB_TOPGEN], 1u);
            else XB_SPIN(xb_ld(&bar[XB_TOPGEN]) == tg, bar);
            __builtin_amdgcn_fence(__ATOMIC_ACQUIRE, "agent");
            xb_add(&bar[XB_XGEN(b.x)], 1u);
            asm volatile("s_waitcnt vmcnt(0)" ::: "memory");
        } else {
            XB_SPIN(xb_ld(&bar[XB_XGEN(b.x)]) == gen, bar);
            __builtin_amdgcn_fence(__ATOMIC_ACQUIRE, "agent");
            asm volatile("s_waitcnt vmcnt(0)" ::: "memory");
        }
    }
    __syncthreads();
}

__device__ __forceinline__ float wave_sum(float v) {
#pragma unroll
    for (int o = 1; o < 64; o <<= 1) v += __shfl_xor(v, o);
    return v;
}
__device__ __forceinline__ void transpose_item(const float* W, int K, int N, bf16* WT, const float* gain, int permq, LAS float* scr, int item, int lane) {
    const int nblk = N / 32, kb = item / nblk, nb = item - kb * nblk, k0 = 64 * kb, n0 = 32 * nb;
    const int lr = lane >> 3, lc = (lane & 7) * 4;
    f32x4 v[8];
#pragma unroll
    for (int i = 0; i < 8; ++i) v[i] = *(const GAS f32x4*)(W + (size_t)(k0 + i * 8 + lr) * N + n0 + lc);
    if (gain) {
#pragma unroll
        for (int i = 0; i < 8; ++i) v[i] = v[i] * gain[k0 + i * 8 + lr];
    }
#pragma unroll
    for (int i = 0; i < 8; ++i) { LAS float* d = scr + (i * 8 + lr) * 33 + lc; d[0] = v[i][0]; d[1] = v[i][1]; d[2] = v[i][2]; d[3] = v[i][3]; }
    LDS_WAIT(); asm volatile("" ::: "memory");
    const int c = lane & 7;
#pragma unroll
    for (int j = 0; j < 4; ++j) { const int n = (lane >> 3) + 8 * j; const LAS float* sp = scr + (8 * c) * 33 + n;
        v4u o; o.x = pk2(sp[0 * 33], sp[1 * 33]); o.y = pk2(sp[2 * 33], sp[3 * 33]); o.z = pk2(sp[4 * 33], sp[5 * 33]); o.w = pk2(sp[6 * 33], sp[7 * 33]);
        int drow = n0 + n;
        if (permq == 1) { const int h = drow / DQK, d = drow - h * DQK; if (d >= NOPE) { const int cc = d - NOPE; drow = h * DQK + NOPE + 2 * (cc & 31) + (cc >> 5); } }
        if (permq == 2) { if (drow >= QLORA + KVLORA) { const int cc = drow - (QLORA + KVLORA); drow = QLORA + KVLORA + 2 * (cc & 31) + (cc >> 5); } }
        *(GAS v4u*)(WT + (size_t)drow * K + k0 + 8 * c) = o; }
    LDS_WAIT(); asm volatile("" ::: "memory");
}
__device__ __forceinline__ void rowstat_1024(const float* xrow, bf16* orow, float* rs, int lane) {
    const GAS f32x4* xr = (const GAS f32x4*)xrow + lane;
    f32x4 v[4]; float s = 0.f;
#pragma unroll
    for (int j = 0; j < 4; ++j) { v[j] = xr[64 * j]; s += (v[j].x * v[j].x + v[j].y * v[j].y) + (v[j].z * v[j].z + v[j].w * v[j].w); }
    const float r = 1.0f / sqrtf(wave_sum(s) * (1.0f / 1024.0f) + EPS);
    if (lane == 0) *rs = r;
    GAS unsigned long long* o8 = (GAS unsigned long long*)orow + lane;
#pragma unroll
    for (int j = 0; j < 4; ++j) o8[64 * j] = (unsigned long long)pk2(v[j].x, v[j].y) | ((unsigned long long)pk2(v[j].z, v[j].w) << 32);
}

__device__ __forceinline__ float rs_from_partials(const float* ssqp, int row) {
    const f32x4* p = (const f32x4*)(ssqp + (size_t)row * 16); const f32x4 a = p[0], b = p[1], c = p[2], d = p[3];
    const float s = (((a[0] + a[1]) + (a[2] + a[3])) + ((b[0] + b[1]) + (b[2] + b[3]))) + (((c[0] + c[1]) + (c[2] + c[3])) + ((d[0] + d[1]) + (d[2] + d[3])));
    return __builtin_amdgcn_rsqf(s * (1.0f / 1024.0f) + EPS); }
struct FLat { static constexpr bool TILED = false; bf16* lat; const float* rs; float* latss; bf16* kpe; const float2* cs;
    __device__ __forceinline__ float rowscale(int row) const { return rs[row]; }
    __device__ __forceinline__ void operator()(int row, int col, f32x4 v0, f32x4 v1) const {
        if (col < QLORA + KVLORA) {
            store8(lat + (size_t)row * NLATP + col, v0, v1);
            float ss = ((v0[0] * v0[0] + v0[1] * v0[1]) + (v0[2] * v0[2] + v0[3] * v0[3])) + ((v1[0] * v1[0] + v1[1] * v1[1]) + (v1[2] * v1[2] + v1[3] * v1[3]));
            ss += __shfl_xor(ss, 16); ss += __shfl_xor(ss, 32);
            if ((col & 31) == 0) latss[(size_t)row * 24 + (col >> 5)] = ss;
        } else if (col < NLAT) {
            const float2* c = cs + (size_t)row * 32 + ((col - (QLORA + KVLORA)) >> 1);
            const float2 c0 = c[0], c1 = c[1], c2 = c[2], c3 = c[3];
            const f32x4 a = v0, b = v1;
            v0[0] = a[0] * c0.x - a[1] * c0.y; v0[1] = a[0] * c0.y + a[1] * c0.x; v0[2] = a[2] * c1.x - a[3] * c1.y; v0[3] = a[2] * c1.y + a[3] * c1.x;
            v1[0] = b[0] * c2.x - b[1] * c2.y; v1[1] = b[0] * c2.y + b[1] * c2.x; v1[2] = b[2] * c3.x - b[3] * c3.y; v1[3] = b[2] * c3.y + b[3] * c3.x;
            store8(kpe + (size_t)row * 64 + (col - (QLORA + KVLORA)), v0, v1);
        }
    } };
struct FMemKV { static constexpr bool TILED = false; bf16* kx; bf16* vx; const float* rs;
    __device__ __forceinline__ float rowscale(int row) const { return rs[row]; }
    __device__ __forceinline__ void operator()(int row, int col, f32x4 v0, f32x4 v1) const {
        const int b = row >> 8, m = row & 255, t = col >> 9, c = col & 511, h = c >> 7, d = c & 127;
        bf16* p = (t ? vx : kx) + ((size_t)((b * XH + h) * MEMLEN + m)) * 128 + d; store8(p, v0, v1); } };
struct FQ0 { static constexpr bool TILED = false; bf16* q; const float* latss; const float2* cs;
    __device__ __forceinline__ float rowscale(int row) const { const f32x4* p = (const f32x4*)(latss + (size_t)row * 24); const f32x4 a = p[0], b = p[1], c = p[2];
        const float sm = (((a[0] + a[1]) + (a[2] + a[3])) + ((b[0] + b[1]) + (b[2] + b[3]))) + ((c[0] + c[1]) + (c[2] + c[3]));
        return __builtin_amdgcn_rsqf(sm * (1.0f / QLORA) + EPS) * QSCALE_MLA; }
    __device__ __forceinline__ void operator()(int row, int col, f32x4 v0, f32x4 v1) const {
        const int h = col / DQK, d = col - h * DQK;
        if (d >= NOPE) { const float2* c = cs + (size_t)row * 32 + ((d - NOPE) >> 1);
            const float2 c0 = c[0], c1 = c[1], c2 = c[2], c3 = c[3];
            const f32x4 a = v0, b = v1;
            v0[0] = a[0] * c0.x - a[1] * c0.y; v0[1] = a[0] * c0.y + a[1] * c0.x; v0[2] = a[2] * c1.x - a[3] * c1.y; v0[3] = a[2] * c1.y + a[3] * c1.x;
            v1[0] = b[0] * c2.x - b[1] * c2.y; v1[1] = b[0] * c2.y + b[1] * c2.x; v1[2] = b[2] * c3.x - b[3] * c3.y; v1[3] = b[2] * c3.y + b[3] * c3.x; }
        const int bb = row >> 11, si = row & 2047;
        store8(q + ((size_t)((bb * HEADS + h) * SEQ + si)) * DQK + d, v0, v1); } };
struct FKV0 { static constexpr bool TILED = false; bf16* kn; bf16* v; const float* latss;
    __device__ __forceinline__ float rowscale(int row) const { const f32x4* p = (const f32x4*)(latss + (size_t)row * 24 + 12); const f32x4 a = p[0], b = p[1];
        const float sm = ((a[0] + a[1]) + (a[2] + a[3])) + ((b[0] + b[1]) + (b[2] + b[3]));
        return __builtin_amdgcn_rsqf(sm * (1.0f / KVLORA) + EPS); }
    __device__ __forceinline__ void operator()(int row, int col, f32x4 v0, f32x4 v1) const {
        const int h = col >> 8, j = col & 255, bb = row >> 11, si = row & 2047;
        bf16* p = (j < 128 ? kn : v) + ((size_t)((bb * HEADS + h) * SEQ + si)) * 128 + (j & 127); store8(p, v0, v1); } };
struct FXQ { static constexpr bool TILED = false; bf16* qx; const float* ssqp;
    __device__ __forceinline__ float rowscale(int row) const { return rs_from_partials(ssqp, row) * QSCALE_128; }
    __device__ __forceinline__ void operator()(int row, int col, f32x4 v0, f32x4 v1) const {
        const int h = col >> 7, d = col & 127, bb = row >> 11, si = row & 2047;
        store8(qx + ((size_t)((bb * XH + h) * SEQ + si)) * 128 + d, v0, v1); } };
struct FUp { static constexpr bool TILED = true; bf16* u; const float* ssqp;
    __device__ __forceinline__ float rowscale(int) const { return 1.0f; }
    __device__ __forceinline__ void tiled(const pg8::Unit& un, int piece, f32x4 v0, f32x4 v1) const {
#pragma unroll
        for (int j = 0; j < 4; ++j) { const float a = fmaxf(v0[j], 0.f), b = fmaxf(v1[j], 0.f); v0[j] = a * a; v1[j] = b * b; }
        size_t tz = 0; asm volatile("" : "+s"(tz)); unsigned char* tb = (unsigned char*)(u + (size_t)(un.pm * 16 + un.pn) * 65536) + tz;
        store8nt((bf16*)(tb + (unsigned)(piece * 16)), v0, v1);
#ifdef PROBE_DUPSTORE
        asm volatile("" ::: "memory"); store8((bf16*)(tb + (unsigned)(piece * 16)), v0, v1);
#endif
    } };
struct FQKV1 { static constexpr bool TILED = false; bf16* q; bf16* k; bf16* v; const float* ssqp;
    __device__ __forceinline__ float rowscale(int row) const { return rs_from_partials(ssqp, row); }
    __device__ __forceinline__ void operator()(int row, int col, f32x4 v0, f32x4 v1) const { const int t = col >> 10, c = col & 1023, h = c >> 7, d = c & 127, bb = row >> 11, si = row & 2047;
        const float s = (t == 0 ? QSCALE_128 : 1.0f);
        bf16* p = q + (size_t)t * (32u << 19) + ((size_t)((bb * HEADS + h) * SEQ + si)) * 128 + d; store8(p, v0 * s, v1 * s); } };

struct Args { const float* in[21]; float* out; unsigned char* ws; int ph_lo, ph_hi; };
static_assert(sizeof(Args) == 21 * 8 + 8 + 8 + 8, "Args has no padding");

enum { PH_PRO = 0, PH_DKV, PH_UQKV, PH_ATT0, PH_WO0, PH_XA0, PH_XO0, PH_UP0, PH_DN0,
       PH_QKV1, PH_ATT1, PH_WO1, PH_XA1, PH_XO1, PH_UP1, PH_DN1, PH_FINAL, NPH };

__global__ void __launch_bounds__(NWAVES * 64, 2) mk_fwd(Args args) {
    extern __shared__ __attribute__((aligned(16))) unsigned char lds_raw[];
    LAS unsigned char* lds = (LAS unsigned char*)lds_raw;
    volatile LAS unsigned* MISC = (volatile LAS unsigned*)(lds + MISC_OFF);
    const int tid = threadIdx.x, lane = tid & 63, wave = __builtin_amdgcn_readfirstlane(tid >> 6);
    const int G = gridDim.x; int vcu; { const int bx = blockIdx.x; vcu = (G % 8 == 0) ? (bx % 8) * (G / 8) + bx / 8 : bx; }
    unsigned char* ws = args.ws;
    gu32* ctl = (gu32*)(ws + WS_CTL);
    for (int u = tid; u < (LDS_BYTES - LDSCTL_OFF) / 4; u += NWAVES * 64) ((LAS unsigned*)(lds + LDSCTL_OFF))[u] = 0u;
    __syncthreads();
    const int lo = args.ph_lo, hi = args.ph_hi;
    const bool one_phase = (hi - lo == 1);
    XcdBarrier bar; bar.bar = (unsigned*)(ctl + CW_BAR); bar.x = 0; bar.st = nullptr;
    if (!one_phase) bar = xcd_barrier_post((unsigned*)(ctl + CW_BAR), MISC + 8);
#define IN(k) (lo <= (k) && (k) < hi)
#ifndef PROBE_MASK
#define PROBE_MASK 0u
#endif
#ifndef PROBE_DBLBAR
#define PROBE_DBLBAR 0
#endif
    unsigned long long t_prev = PROBE_MASK ? __builtin_amdgcn_s_memrealtime() : 0ull, t_acc = 0ull;
#define SEAM(k) do { if (IN(k) && IN((k) + 1)) { xcd_barrier(bar); if (PROBE_DBLBAR) xcd_barrier(bar); } \
    if (PROBE_MASK) { const unsigned long long t_now = __builtin_amdgcn_s_memrealtime(); if ((PROBE_MASK >> (k)) & 1u) t_acc += t_now - t_prev; t_prev = t_now; } } while (0)

    const float* x = args.in[0]; const float* mem = args.in[1]; const int* positions = (const int*)args.in[2];
    const float* norm_mix = args.in[3]; const float* norm_cross = args.in[4]; const float* norm_mem = args.in[5]; const float* norm_mlp = args.in[6]; const float* norm_final = args.in[7];
#define WSL() ({ size_t _z = 0; asm volatile("" : "+s"(_z)); ws + _z; })
#define rsb ((float*)(WSL() + WS_RS))
#define HB ((bf16*)(WSL() + WS_HB))
#define MEMB ((bf16*)(WSL() + WS_MEMB))
#define LAT ((bf16*)(WSL() + WS_LAT))
#define CS ((float2*)(WSL() + WS_CS))
#define KPE ((bf16*)(WSL() + WS_KPE))
#define OB ((bf16*)(WSL() + WS_OB))
#define QB_ ((bf16*)(WSL() + WS_Q))
#define KN ((bf16*)(WSL() + WS_KN))
#define VV ((bf16*)(WSL() + WS_V))
#define K1 ((bf16*)(WSL() + WS_K1))
#define V1 ((bf16*)(WSL() + WS_V1))
#define QX ((bf16*)(WSL() + WS_QX))
#define OX ((bf16*)(WSL() + WS_OX))
#define U ((bf16*)(WSL() + WS_U))
#define SSQB(i) ((float*)(WSL() + WS_SSQ + (size_t)(i) * MiB))
    float* hres = args.out;
    const int gw = vcu * NWAVES + wave, NGW = G * NWAVES;

    if (IN(PH_PRO)) {
      {
        LAS float* scr = (LAS float*)(lds + RING_OFF + wave * 16384);
        struct Job { const float* W; int K, N; size_t dst; const float* gain; int permq; };
        constexpr int C0 = 352, C1 = C0 + 288, C2 = C1 + 256, C3 = C2 + 512, C4 = C3 + 256, C5 = C4 + 256, C6 = C5 + 512, C7 = C6 + 512, C8 = C7 + 256, C9 = C8 + 256,
                      C10 = C9 + 2048, C11 = C10 + 2048, C12 = C11 + 2048, C13 = C12 + 2048, C14 = C13 + 1536, C15 = C14 + 512;
        for (int fit = gw; fit < C15; fit += NGW) {
            Job jb; int it;
            if (fit < C0) { it = fit; jb = {args.in[8], DM, NLAT, WS_WDKV, norm_mix, 2}; }
            else if (fit < C1) { it = fit - C0; jb = {args.in[11], QLORA, 1536, WS_WUQ, args.in[9], 1}; }
            else if (fit < C2) { it = fit - C1; jb = {args.in[12], KVLORA, 2048, WS_WUKV, args.in[10], 0}; }
            else if (fit < C3) { it = fit - C2; jb = {args.in[13], DM, DM, WS_WO0, nullptr, 0}; }
            else if (fit < C4) { it = fit - C3; jb = {args.in[16], DM, 512, WS_WXQ, norm_cross, 0}; }
            else if (fit < C5) { it = fit - C4; jb = {args.in[16] + (size_t)DM * 512, DM, 512, WS_WXQ + (size_t)512 * DM * 2, norm_cross + DM, 0}; }
            else if (fit < C6) { it = fit - C5; jb = {args.in[17], DM, DM, WS_WXKV, norm_mem, 0}; }
            else if (fit < C7) { it = fit - C6; jb = {args.in[17] + (size_t)DM * DM, DM, DM, WS_WXKV + (size_t)DM * DM * 2, norm_mem + DM, 0}; }
            else if (fit < C8) { it = fit - C7; jb = {args.in[18], 512, DM, WS_WXO, nullptr, 0}; }
            else if (fit < C9) { it = fit - C8; jb = {args.in[18] + (size_t)512 * DM, 512, DM, WS_WXO + (size_t)DM * 512 * 2, nullptr, 0}; }
            else if (fit < C10) { it = fit - C9; jb = {args.in[19], DM, DFF, WS_WIN, norm_mlp, 0}; }
            else if (fit < C11) { it = fit - C10; jb = {args.in[19] + (size_t)DM * DFF, DM, DFF, WS_WIN + (size_t)DFF * DM * 2, norm_mlp + DM, 0}; }
            else if (fit < C12) { it = fit - C11; jb = {args.in[20], DFF, DM, WS_WOUT, nullptr, 0}; }
            else if (fit < C13) { it = fit - C12; jb = {args.in[20] + (size_t)DFF * DM, DFF, DM, WS_WOUT + (size_t)DM * DFF * 2, nullptr, 0}; }
            else if (fit < C14) { it = fit - C13; jb = {args.in[14], DM, 3072, WS_WQKV, norm_mix + DM, 0}; }
            else { it = fit - C14; jb = {args.in[15], DM, DM, WS_WO1, nullptr, 0}; }
            transpose_item(jb.W, jb.K, jb.N, (bf16*)(WSL() + jb.dst), jb.gain, jb.permq, scr, it, lane);
        }
        { GAS v4u* z = (GAS v4u*)(WSL() + WS_WDKV + (size_t)NLAT * DM * 2); const int n16 = (NLATP - NLAT) * DM * 2 / 16;
            for (int i = blockIdx.x * (NWAVES * 64) + tid; i < n16; i += G * NWAVES * 64) z[i] = (v4u){0u, 0u, 0u, 0u}; }
        for (int i = blockIdx.x * (NWAVES * 64) + tid; i < T * 32; i += G * NWAVES * 64) {
            const int tok = i >> 5, f = i & 31;
            const float inv = powf(10000.0f, -(float)(2 * f) / 64.0f);
            const float ang = (float)positions[tok] * inv;
            CS[i] = make_float2(cosf(ang), sinf(ang));
        }
        for (int m = gw; m < T; m += NGW) rowstat_1024(x + (size_t)m * DM, HB + (size_t)m * DM, rsb + RS_X + m, lane);
        for (int m = gw; m < TM; m += NGW) rowstat_1024(mem + (size_t)m * DM, MEMB + (size_t)m * DM, rsb + RS_MEM + m, lane);
      }
    }
    SEAM(PH_PRO);

    if (IN(PH_DKV)) {
        { pg8::Gemm g{HB, (const bf16*)(WSL() + WS_WDKV), T, NLATP, DM, DM}; pg8::StaticOrder S; S.init(T, NLATP, G, (int)blockIdx.x);
          pg8::EpiB<FLat> E{{LAT, rsb + RS_X, SSQB(0), KPE, CS}}; pg8::gemm_phase<pg8::EpiB<FLat>, pg8::StaticOrder, true>(lds + RING_OFF, g, S, E); }
        for (int l = 0; l < 2; ++l) {
          pg8::Gemm g{MEMB, (const bf16*)(WSL() + WS_WXKV + (size_t)l * DM * DM * 2), TM, DM, DM, DM}; pg8::StaticOrder S; S.init(TM, DM, G, (int)((blockIdx.x + 64 - 32 * l) % G));
          bf16* kx = (bf16*)(WSL() + WS_KVX + (size_t)l * 4 * MiB);
          pg8::EpiB<FMemKV> E{{kx, kx + (size_t)TM * 512, rsb + RS_MEM}}; pg8::gemm_phase<pg8::EpiB<FMemKV>, pg8::StaticOrder, true>(lds + RING_OFF, g, S, E); }
    }
    SEAM(PH_DKV);


    if (IN(PH_UQKV)) {
        { pg8::Gemm g{LAT, (const bf16*)(WSL() + WS_WUQ), T, 1536, QLORA, NLATP}; pg8::StaticOrder S; S.init(T, 1536, G, (int)blockIdx.x);
          pg8::EpiB<FQ0> E{{QB_, SSQB(0), CS}}; pg8::gemm_phase<pg8::EpiB<FQ0>, pg8::StaticOrder, true>(lds + RING_OFF, g, S, E); }
        { pg8::Gemm g{LAT + QLORA, (const bf16*)(WSL() + WS_WUKV), T, 2048, KVLORA, NLATP}; pg8::StaticOrder S; S.init(T, 2048, G, (int)((blockIdx.x + 128) % G));
          pg8::EpiB<FKV0> E{{KN, VV, SSQB(0)}}; pg8::gemm_phase<pg8::EpiB<FKV0>, pg8::StaticOrder, true>(lds + RING_OFF, g, S, E); }
    }
    SEAM(PH_UQKV);

    if (IN(PH_ATT0)) {
        for (int pu = vcu; pu < 256; pu += G) { const int bh = pu >> 2, s = pu & 3, b = bh >> 3, h = bh & 7;
            for (int pass = 0; pass < 2; ++pass) { const int qb = pass ? s : 7 - s;
                att::attn_unit<att::MODE_MLA>(lds + RING_OFF, QB_ + ((size_t)bh * SEQ + qb * 256) * DQK, KN + (size_t)bh * SEQ * 128, KPE + (size_t)b * SEQ * 64, VV + (size_t)bh * SEQ * 128,
                    OB + ((size_t)b * SEQ + qb * 256) * DM + h * 128, DM, qb * 256, 0); } }
    }
    SEAM(PH_ATT0);

    {
        const int PB = 0 ? PH_WO1 : PH_WO0;
        if (0 == 1) {
            if (IN(PH_QKV1)) { pg8::Gemm g{HB, (const bf16*)(WSL() + WS_WQKV), T, 3072, DM, DM}; pg8::StaticOrder S; S.init(T, 3072, G, (int)blockIdx.x);
                pg8::EpiB<FQKV1> E{{QB_, K1, V1, SSQB(0)}}; pg8::gemm_phase<pg8::EpiB<FQKV1>, pg8::StaticOrder, true>(lds + RING_OFF, g, S, E); }
            SEAM(PH_QKV1);
            if (IN(PH_ATT1)) {
                for (int u = vcu; u < 512; u += G) { const int bh = u >> 3, qb = u & 7, b = bh >> 3, h = bh & 7;
                    att::attn_unit<att::MODE_SB>(lds + RING_OFF, QB_ + ((size_t)bh * SEQ + qb * 256) * 128, K1 + (size_t)bh * SEQ * 128, nullptr, V1 + (size_t)bh * SEQ * 128,
                        OB + ((size_t)b * SEQ + qb * 256) * DM + h * 128, DM, qb * 256, 0); }
            }
            SEAM(PH_ATT1);
        }
        if (IN(PB)) { pg8::Gemm g{OB, (const bf16*)(WSL() + (0 ? WS_WO1 : WS_WO0)), T, DM, DM, DM}; pg8::StaticOrder S; S.init(T, DM, G, (int)blockIdx.x);
            if (0 == 0) { pg8::EpiResN<true> E{x, HB, SSQB(0), nullptr}; pg8::gemm_phase<pg8::EpiResN<true>, pg8::StaticOrder, true>(lds + RING_OFF, g, S, E); }
            else { pg8::EpiResN<false> E{nullptr, HB, SSQB(1), nullptr}; pg8::gemm_phase<pg8::EpiResN<false>, pg8::StaticOrder, true>(lds + RING_OFF, g, S, E); } }
        SEAM(PB);
        if (IN(PB + 1)) { const bf16* kx = (const bf16*)(WSL() + WS_KVX + (size_t)0 * 4 * MiB); const bf16* vx = kx + (size_t)TM * 512;
            const bf16* wxq = (const bf16*)(WSL() + WS_WXQ + (size_t)0 * 512 * DM * 2);
            for (int u = vcu; u < 256; u += G) { const int bh = u >> 3, qb = u & 7, b = bh >> 2, h = bh & 3; const size_t row0 = (size_t)b * SEQ + qb * 256;
                att::attn_unit<att::MODE_CROSS, true>(lds + RING_OFF, nullptr, kx + (size_t)bh * MEMLEN * 128, nullptr, vx + (size_t)bh * MEMLEN * 128,
                    OX + row0 * 512 + h * 128, 512, 0, MEMLEN, HB + row0 * DM, wxq + (size_t)h * 128 * DM, SSQB(0) + row0 * 16, QSCALE_128); } }
        SEAM(PB + 1);
        if (IN(PB + 2)) { pg8::Gemm g{OX, (const bf16*)(WSL() + WS_WXO + (size_t)0 * DM * 512 * 2), T, DM, 512, 512}; pg8::StaticOrder S; S.init(T, DM, G, (int)blockIdx.x);
            pg8::EpiResN<false> E{nullptr, HB, SSQB(1 - 0), nullptr}; pg8::gemm_phase<pg8::EpiResN<false>, pg8::StaticOrder, true>(lds + RING_OFF, g, S, E); }
        SEAM(PB + 2);
        if (IN(PB + 3)) { pg8::Gemm g{HB, (const bf16*)(WSL() + WS_WIN + (size_t)0 * DFF * DM * 2), T, DFF, DM, DM}; pg8::StaticOrder S; S.init(T, DFF, G, (int)blockIdx.x);
            pg8::EpiB<FUp> E{{U, nullptr}}; pg8::gemm_phase<pg8::EpiB<FUp>, pg8::StaticOrder, true>(lds + RING_OFF, g, S, E); }
        SEAM(PB + 3);
        if (IN(PB + 4)) { pg8::Gemm g{U, (const bf16*)(WSL() + WS_WOUT + (size_t)0 * DM * DFF * 2), T, DM, DFF, DFF}; pg8::StaticOrder S; S.init(T, DM, G, (int)blockIdx.x);
            pg8::EpiResN<false, true> E{nullptr, HB, SSQB(0), SSQB(1 - 0)}; pg8::gemm_phase<pg8::EpiResN<false, true>, pg8::StaticOrder, true, true>(lds + RING_OFF, g, S, E); }
        SEAM(PB + 4);
        if (0 == 1) {
            if (IN(PH_FINAL)) {
                for (int m = gw; m < T; m += NGW) {
                    const GAS v4u* hr = (const GAS v4u*)(HB + (size_t)m * DM) + lane;
                    GAS f32x4* orow = (GAS f32x4*)(hres + (size_t)m * DM); const GAS f32x4* gr = (const GAS f32x4*)norm_final;
                    f32x4 va[2], vb[2]; float s = 0.f;
#pragma unroll
                    for (int j = 0; j < 2; ++j) { const v4u w = hr[64 * j];
                        va[j] = (f32x4){__builtin_bit_cast(float, w.x << 16), __builtin_bit_cast(float, w.x & 0xffff0000u), __builtin_bit_cast(float, w.y << 16), __builtin_bit_cast(float, w.y & 0xffff0000u)};
                        vb[j] = (f32x4){__builtin_bit_cast(float, w.z << 16), __builtin_bit_cast(float, w.z & 0xffff0000u), __builtin_bit_cast(float, w.w << 16), __builtin_bit_cast(float, w.w & 0xffff0000u)};
                        s += ((va[j].x * va[j].x + va[j].y * va[j].y) + (va[j].z * va[j].z + va[j].w * va[j].w)) + ((vb[j].x * vb[j].x + vb[j].y * vb[j].y) + (vb[j].z * vb[j].z + vb[j].w * vb[j].w)); }
                    const float r = 1.0f / sqrtf(wave_sum(s) * (1.0f / 1024.0f) + EPS);
#pragma unroll
                    for (int j = 0; j < 2; ++j) { const int c4 = 2 * (lane + 64 * j); orow[c4] = va[j] * r * gr[c4]; orow[c4 + 1] = vb[j] * r * gr[c4 + 1]; }
                }
            }
        }
    }
    {
        const int PB = 1 ? PH_WO1 : PH_WO0;
        if (1 == 1) {
            if (IN(PH_QKV1)) { pg8::Gemm g{HB, (const bf16*)(WSL() + WS_WQKV), T, 3072, DM, DM}; pg8::StaticOrder S; S.init(T, 3072, G, (int)blockIdx.x);
                pg8::EpiB<FQKV1> E{{QB_, K1, V1, SSQB(0)}}; pg8::gemm_phase<pg8::EpiB<FQKV1>, pg8::StaticOrder, true>(lds + RING_OFF, g, S, E); }
            SEAM(PH_QKV1);
            if (IN(PH_ATT1)) {
                for (int u = vcu; u < 512; u += G) { const int bh = u >> 3, qb = u & 7, b = bh >> 3, h = bh & 7;
                    att::attn_unit<att::MODE_SB>(lds + RING_OFF, QB_ + ((size_t)bh * SEQ + qb * 256) * 128, K1 + (size_t)bh * SEQ * 128, nullptr, V1 + (size_t)bh * SEQ * 128,
                        OB + ((size_t)b * SEQ + qb * 256) * DM + h * 128, DM, qb * 256, 0); }
            }
            SEAM(PH_ATT1);
        }
        if (IN(PB)) { pg8::Gemm g{OB, (const bf16*)(WSL() + (1 ? WS_WO1 : WS_WO0)), T, DM, DM, DM}; pg8::StaticOrder S; S.init(T, DM, G, (int)blockIdx.x);
            if (1 == 0) { pg8::EpiResN<true> E{x, HB, SSQB(0), nullptr}; pg8::gemm_phase<pg8::EpiResN<true>, pg8::StaticOrder, true>(lds + RING_OFF, g, S, E); }
            else { pg8::EpiResN<false> E{nullptr, HB, SSQB(1), nullptr}; pg8::gemm_phase<pg8::EpiResN<false>, pg8::StaticOrder, true>(lds + RING_OFF, g, S, E); } }
        SEAM(PB);
        if (IN(PB + 1)) { const bf16* kx = (const bf16*)(WSL() + WS_KVX + (size_t)1 * 4 * MiB); const bf16* vx = kx + (size_t)TM * 512;
            const bf16* wxq = (const bf16*)(WSL() + WS_WXQ + (size_t)1 * 512 * DM * 2);
            for (int u = vcu; u < 256; u += G) { const int bh = u >> 3, qb = u & 7, b = bh >> 2, h = bh & 3; const size_t row0 = (size_t)b * SEQ + qb * 256;
                att::attn_unit<att::MODE_CROSS, true>(lds + RING_OFF, nullptr, kx + (size_t)bh * MEMLEN * 128, nullptr, vx + (size_t)bh * MEMLEN * 128,
                    OX + row0 * 512 + h * 128, 512, 0, MEMLEN, HB + row0 * DM, wxq + (size_t)h * 128 * DM, SSQB(1) + row0 * 16, QSCALE_128); } }
        SEAM(PB + 1);
        if (IN(PB + 2)) { pg8::Gemm g{OX, (const bf16*)(WSL() + WS_WXO + (size_t)1 * DM * 512 * 2), T, DM, 512, 512}; pg8::StaticOrder S; S.init(T, DM, G, (int)blockIdx.x);
            pg8::EpiResN<false> E{nullptr, HB, SSQB(1 - 1), nullptr}; pg8::gemm_phase<pg8::EpiResN<false>, pg8::StaticOrder, true>(lds + RING_OFF, g, S, E); }
        SEAM(PB + 2);
        if (IN(PB + 3)) { pg8::Gemm g{HB, (const bf16*)(WSL() + WS_WIN + (size_t)1 * DFF * DM * 2), T, DFF, DM, DM}; pg8::StaticOrder S; S.init(T, DFF, G, (int)blockIdx.x);
            pg8::EpiB<FUp> E{{U, nullptr}}; pg8::gemm_phase<pg8::EpiB<FUp>, pg8::StaticOrder, true>(lds + RING_OFF, g, S, E); }
        SEAM(PB + 3);
        if (IN(PB + 4)) { pg8::Gemm g{U, (const bf16*)(WSL() + WS_WOUT + (size_t)1 * DM * DFF * 2), T, DM, DFF, DFF}; pg8::StaticOrder S; S.init(T, DM, G, (int)blockIdx.x);
            pg8::EpiResN<false, true> E{nullptr, HB, SSQB(1), SSQB(1 - 1)}; pg8::gemm_phase<pg8::EpiResN<false, true>, pg8::StaticOrder, true, true>(lds + RING_OFF, g, S, E); }
        SEAM(PB + 4);
        if (1 == 1) {
            if (IN(PH_FINAL)) {
                for (int m = gw; m < T; m += NGW) {
                    const GAS v4u* hr = (const GAS v4u*)(HB + (size_t)m * DM) + lane;
                    GAS f32x4* orow = (GAS f32x4*)(hres + (size_t)m * DM); const GAS f32x4* gr = (const GAS f32x4*)norm_final;
                    f32x4 va[2], vb[2]; float s = 0.f;
#pragma unroll
                    for (int j = 0; j < 2; ++j) { const v4u w = hr[64 * j];
                        va[j] = (f32x4){__builtin_bit_cast(float, w.x << 16), __builtin_bit_cast(float, w.x & 0xffff0000u), __builtin_bit_cast(float, w.y << 16), __builtin_bit_cast(float, w.y & 0xffff0000u)};
                        vb[j] = (f32x4){__builtin_bit_cast(float, w.z << 16), __builtin_bit_cast(float, w.z & 0xffff0000u), __builtin_bit_cast(float, w.w << 16), __builtin_bit_cast(float, w.w & 0xffff0000u)};
                        s += ((va[j].x * va[j].x + va[j].y * va[j].y) + (va[j].z * va[j].z + va[j].w * va[j].w)) + ((vb[j].x * vb[j].x + vb[j].y * vb[j].y) + (vb[j].z * vb[j].z + vb[j].w * vb[j].w)); }
                    const float r = 1.0f / sqrtf(wave_sum(s) * (1.0f / 1024.0f) + EPS);
#pragma unroll
                    for (int j = 0; j < 2; ++j) { const int c4 = 2 * (lane + 64 * j); orow[c4] = va[j] * r * gr[c4]; orow[c4 + 1] = vb[j] * r * gr[c4 + 1]; }
                }
            }
        }
    }
    if (PROBE_MASK) { const unsigned long long t_now = __builtin_amdgcn_s_memrealtime(); if ((PROBE_MASK >> (NPH - 1)) & 1u) t_acc += t_now - t_prev;
        if (blockIdx.x == 0 && tid == 0) { while (__builtin_amdgcn_s_memrealtime() - t_now < 4ull * t_acc) __builtin_amdgcn_s_sleep(32); } }
#undef IN
#undef SEAM
}

#ifndef MK_N_LAUNCHES
#define MK_N_LAUNCHES 1
#endif
extern "C" void kernel_launch(void* const* d_in, const int* in_sizes, int n_in, void* d_out, int out_size, void* d_ws, size_t ws_size, hipStream_t stream) {
    static int grid = 0;
    if (grid == 0) {
        if (n_in != 21 || in_sizes[0] != T * DM || out_size != T * DM || ws_size < WS_END) { fprintf(stderr, "kernel_launch: unexpected shapes (n_in %d, in0 %d, out %d, ws %zu)\n", n_in, n_in > 0 ? in_sizes[0] : -1, out_size, ws_size); grid = -1; return; }
        int dev = 0, cus = 0, per_cu = 0;
        if (hipGetDevice(&dev) != hipSuccess || hipDeviceGetAttribute(&cus, hipDeviceAttributeMultiprocessorCount, dev) != hipSuccess) { grid = -1; return; }
        if (hipFuncSetAttribute((const void*)mk_fwd, hipFuncAttributeMaxDynamicSharedMemorySize, LDS_BYTES) != hipSuccess) { fprintf(stderr, "kernel_launch: hipFuncSetAttribute failed\n"); grid = -1; return; }
        if (hipOccupancyMaxActiveBlocksPerMultiprocessor(&per_cu, (const void*)mk_fwd, NWAVES * 64, LDS_BYTES) != hipSuccess || per_cu < 1)
            fprintf(stderr, "kernel_launch: note: occupancy query reports %d workgroups per CU\n", per_cu);
        (void)hipGetLastError();
        grid = cus;
    }
    if (grid < 0) return;
    (void)hipMemsetAsync((char*)d_ws + WS_CTL, 0, CTL_ZERO_BYTES, stream);
    Args a{};
    for (int i = 0; i < 21; ++i) a.in[i] = (const float*)d_in[i];
    a.out = (float*)d_out; a.ws = (unsigned char*)d_ws;
#if MK_N_LAUNCHES == 1
    a.ph_lo = 0; a.ph_hi = NPH;
    hipLaunchKernelGGL(mk_fwd, dim3(grid), dim3(NWAVES * 64), LDS_BYTES, stream, a);
#else
    for (int p = 0; p < NPH; ++p) { a.ph_lo = p; a.ph_hi = p + 1; hipLaunchKernelGGL(mk_fwd, dim3(grid), dim3(NWAVES * 64), LDS_BYTES, stream, a); }
#endif
}
```
